# Optimizing an MI355X kernel written in HIP

```python
import jax
import jax.numpy as jnp
from jax import lax
import numpy as np

D_MODEL = 1024
BATCH = 8
SEQ = 2048
DEPTH = 2

GRID_W = 64
CTX_LEN = 256
N_MIXERS = 2
RET_HEADS = 4
RET_DK = 256
RET_DV = 512
RET_QK = RET_HEADS * RET_DK
RET_V = RET_HEADS * RET_DV
RET_IN = 2 * RET_QK + 2 * RET_V
RET_CHUNK = 128
HG_HEADS = 8
HG_DK = 128
HG_DV = D_MODEL // HG_HEADS
HG_K = HG_HEADS * HG_DK
HG_V = HG_HEADS * HG_DV
HG_IN = 3 * HG_K + 2 * HG_V
HG_CHUNK = 64
N_EXPERTS = 16
EC_CAPACITY = 2
EXPERT_FF = 2816
ROPE_THETA = 10000.0
EPS = 1e-6
F32 = jnp.float32

kernel_name = 'hybrid_retention_hgrn2_ec_moe_dit'


def rmsnorm(x, w=None):
    xf = x.astype(F32)
    y = xf * lax.rsqrt(jnp.mean(xf * xf, axis=-1, keepdims=True) + EPS)
    if w is not None:
        y = y * w.astype(F32)
    return y.astype(x.dtype)


def modulate(h, shift, scale):
    return h * (1 + scale) + shift


def split_heads(a, n_heads, d):
    B, T, _ = a.shape
    return a.reshape(B, T, n_heads, d).transpose(0, 2, 1, 3)


def merge_heads(a):
    B, H, T, d = a.shape
    return a.transpose(0, 2, 1, 3).reshape(B, T, H * d)


def grid_angles(n):
    rows = n // GRID_W
    r = jnp.repeat(jnp.arange(rows), GRID_W).astype(F32)
    col = jnp.tile(jnp.arange(GRID_W), rows).astype(F32)
    half = RET_DK // 2
    inv = ROPE_THETA ** (-jnp.arange(0, half, 2, dtype=F32) / half)
    return r[:, None] * inv, col[:, None] * inv


def rope(x, ang):
    x1, x2 = jnp.split(x, 2, axis=-1)
    cos = jnp.cos(ang).astype(x.dtype)
    sin = jnp.sin(ang).astype(x.dtype)
    return jnp.concatenate([x1 * cos - x2 * sin, x1 * sin + x2 * cos], axis=-1)


def rope2d(x, ang_r, ang_c):
    xr, xc = jnp.split(x, 2, axis=-1)
    return jnp.concatenate([rope(xr, ang_r), rope(xc, ang_c)], axis=-1)


def retention_log_decay():
    j = jnp.arange(2 * RET_HEADS, dtype=F32)
    lg = jnp.log1p(-jnp.exp2(-5.0 - j / 2))
    return lg[0::2], lg[1::2]


def chunk_recurrence(q, k, v, g, s0, chunk):
    B, H, T, dk = q.shape
    dv = v.shape[-1]
    dg = g.shape[-1]
    n = T // chunk

    def blocks(a):
        return a.reshape(B, H, n, chunk, a.shape[-1]).transpose(2, 0, 1, 3, 4)

    lower = jnp.tril(jnp.ones((chunk, chunk), dtype=bool))[:, :, None]

    def step(S, blk):
        qc, kc, vc, gc = blk
        b = jnp.cumsum(gc.astype(F32), axis=2)
        b_end = b[:, :, -1:, :]
        o = jnp.einsum('bhik,bhkv->bhiv', qc * jnp.exp(b), S)
        decay = jnp.exp(jnp.where(lower, b[:, :, :, None, :] - b[:, :, None, :, :], -jnp.inf))
        if dg == 1:
            scores = jnp.einsum('bhik,bhjk->bhij', qc, kc) * decay[..., 0]
        else:
            scores = jnp.einsum('bhijk,bhjk->bhij', qc[:, :, :, None, :] * decay, kc)
        o = o + jnp.einsum('bhij,bhjv->bhiv', scores, vc)
        S = S * jnp.exp(jnp.swapaxes(b_end, -1, -2)) + jnp.einsum('bhjk,bhjv->bhkv', kc * jnp.exp(b_end - b), vc)
        return S, o

    S, o = lax.scan(step, s0, (blocks(q), blocks(k), blocks(v), blocks(g)))
    return o.transpose(1, 2, 0, 3, 4).reshape(B, H, T, dv), S


def recurrence_final_state(k, v, g):
    b = jnp.cumsum(g.astype(F32), axis=2)
    return jnp.einsum('bhtk,bhtv->bhkv', k * jnp.exp(b[:, :, -1:, :] - b), v)


def bidirectional_recurrence(lat, ctx, chunk, need_ctx_out):
    rev = lambda a: jnp.flip(a, axis=2)
    q, kf, gf, kb, gb, v = ctx
    B, H, _, dk = q.shape
    dv = v.shape[-1]
    if need_ctx_out:
        s0 = jnp.zeros((B, H, dk, dv), F32)
        oc_f, sf = chunk_recurrence(q, kf, v, gf, s0, chunk)
        oc_b, sb = chunk_recurrence(rev(q), rev(kb), rev(v), rev(gb), s0, chunk)
        oc = oc_f + rev(oc_b)
    else:
        sf = recurrence_final_state(kf, v, gf)
        sb = recurrence_final_state(rev(kb), rev(v), rev(gb))
        oc = None
    q, kf, gf, kb, gb, v = lat
    ox_f, _ = chunk_recurrence(q, kf, v, gf, sf, chunk)
    ox_b, _ = chunk_recurrence(rev(q), rev(kb), rev(v), rev(gb), sb, chunk)
    return ox_f + rev(ox_b), oc


def retention_mixer(hx, hc, w_in, w_out, need_ctx_out):
    ang_r, ang_c = grid_angles(hx.shape[1])
    log_gf, log_gb = retention_log_decay()

    def project(h, rotate):
        B, T, _ = h.shape
        q, k, v, gt = jnp.split(h @ w_in, [RET_QK, 2 * RET_QK, 2 * RET_QK + RET_V], axis=-1)
        q = split_heads(q, RET_HEADS, RET_DK)
        k = split_heads(k, RET_HEADS, RET_DK) * (RET_DK ** -0.5)
        v = split_heads(v, RET_HEADS, RET_DV)
        if rotate:
            q = rope2d(q, ang_r, ang_c)
            k = rope2d(k, ang_r, ang_c)
        gf = jnp.broadcast_to(log_gf[None, :, None, None], (B, RET_HEADS, T, 1))
        gb = jnp.broadcast_to(log_gb[None, :, None, None], (B, RET_HEADS, T, 1))
        return (q, k, gf, k, gb, v), gt

    def readout(o, gt):
        o = merge_heads(rmsnorm(o))
        return (jax.nn.silu(gt) * o.astype(gt.dtype)) @ w_out

    lat, gt_x = project(hx, True)
    ctx, gt_c = project(hc, False)
    ox, oc = bidirectional_recurrence(lat, ctx, RET_CHUNK, need_ctx_out)
    yx = readout(ox, gt_x)
    yc = readout(oc, gt_c) if need_ctx_out else None
    return yx, yc


def hgrn2_mixer(hx, hc, w_in, lb_f, lb_b, g_norm, w_out, need_ctx_out):
    def project(h):
        q, ff, fb, i, gt = jnp.split(h @ w_in, [HG_K, 2 * HG_K, 3 * HG_K, 3 * HG_K + HG_V], axis=-1)
        q = split_heads(jax.nn.silu(q), HG_HEADS, HG_DK)
        v = split_heads(i, HG_HEADS, HG_DV)

        def gate(fl, lb):
            f = lb + (1 - lb) * jax.nn.sigmoid(fl.astype(F32))
            return split_heads(1 - f, HG_HEADS, HG_DK), split_heads(jnp.log(f), HG_HEADS, HG_DK)

        kf, gf = gate(ff, lb_f)
        kb, gb = gate(fb, lb_b)
        return (q, kf, gf, kb, gb, v), gt

    def readout(o, gt):
        o = merge_heads(rmsnorm(o, g_norm))
        return (jax.nn.silu(gt) * o.astype(gt.dtype)) @ w_out

    lat, gt_x = project(hx)
    ctx, gt_c = project(hc)
    ox, oc = bidirectional_recurrence(lat, ctx, HG_CHUNK, need_ctx_out)
    yx = readout(ox, gt_x)
    yc = readout(oc, gt_c) if need_ctx_out else None
    return yx, yc


def expert_choice_ffn(h, w_router, w_gate, w_up, w_down):
    B, N, D = h.shape
    cap = EC_CAPACITY * N // N_EXPERTS
    aff = jax.nn.softmax(jnp.einsum('bnd,de->bne', h, w_router).astype(F32), axis=-1)
    gate, idx = lax.top_k(jnp.swapaxes(aff, 1, 2), cap)
    xe = jax.vmap(lambda hb, ib: hb[ib])(h, idx)
    a = jnp.einsum('becd,edf->becf', xe, w_gate)
    u = jnp.einsum('becd,edf->becf', xe, w_up)
    y = jnp.einsum('becf,efd->becd', jax.nn.silu(a) * u, w_down) * gate[..., None].astype(h.dtype)
    out = jax.vmap(lambda ib, yb: jnp.zeros((N, D), yb.dtype).at[ib].add(yb))(idx, y)
    return out.astype(h.dtype)


def setup_inputs(seed: int = 0) -> dict:
    key = jax.random.key(seed)
    ks = jax.random.split(key, 20)
    n_ret = (DEPTH + N_MIXERS - 1) // N_MIXERS
    n_hg = (DEPTH + N_MIXERS - 2) // N_MIXERS
    nrm = lambda k, shape, scale: jax.random.normal(k, shape, F32) * scale
    D = D_MODEL
    return {
        'x': nrm(ks[0], (BATCH, SEQ, D), 1.0),
        'c': nrm(ks[1], (BATCH, D), 1.0),
        'ctx': nrm(ks[2], (BATCH, CTX_LEN, D), 1.0),
        'c_ctx': nrm(ks[3], (D,), 1.0),
        'w_ada': nrm(ks[4], (DEPTH, D, 6 * D), 0.5 * D ** -0.5),
        'b_ada': nrm(ks[5], (DEPTH, 6 * D), 0.02),
        'norm_mix': 1.0 + nrm(ks[6], (DEPTH, D), 0.02),
        'norm_ffn': 1.0 + nrm(ks[7], (DEPTH, D), 0.02),
        'ret_w_in': nrm(ks[8], (n_ret, D, RET_IN), D ** -0.5),
        'ret_w_out': nrm(ks[9], (n_ret, RET_V, D), RET_V ** -0.5),
        'hg_w_in': nrm(ks[10], (n_hg, D, HG_IN), D ** -0.5),
        'hg_g_norm': 1.0 + nrm(ks[11], (n_hg, HG_DV), 0.02),
        'hg_lower_bounds': nrm(ks[12], (DEPTH, 2, HG_K), 0.1),
        'hg_w_out': nrm(ks[13], (n_hg, HG_V, D), HG_V ** -0.5),
        'moe_router': nrm(ks[14], (DEPTH, D, N_EXPERTS), D ** -0.5),
        'moe_w_gate': nrm(ks[15], (DEPTH, N_EXPERTS, D, EXPERT_FF), D ** -0.5),
        'moe_w_up': nrm(ks[16], (DEPTH, N_EXPERTS, D, EXPERT_FF), D ** -0.5),
        'moe_w_down': nrm(ks[17], (DEPTH, N_EXPERTS, EXPERT_FF, D), EXPERT_FF ** -0.5),
        'norm_final': 1.0 + nrm(ks[18], (D,), 0.02),
    }


def reference(x, c, ctx, c_ctx, w_ada, b_ada, norm_mix, norm_ffn, ret_w_in, ret_w_out,
              hg_w_in, hg_g_norm, hg_lower_bounds, hg_w_out, moe_router, moe_w_gate,
              moe_w_up, moe_w_down, norm_final):
    lb_w = jax.nn.softmax(hg_lower_bounds.astype(F32), axis=0)
    lower_bound = jnp.cumsum(lb_w, axis=0) - lb_w[0]
    cx = ctx
    for layer in range(DEPTH):
        last = layer == DEPTH - 1
        mix_id, slot = layer % N_MIXERS, layer // N_MIXERS
        mod_x = jnp.split((jax.nn.silu(c) @ w_ada[layer] + b_ada[layer])[:, None, :], 6, axis=-1)
        mod_c = jnp.split(jax.nn.silu(c_ctx) @ w_ada[layer] + b_ada[layer], 6, axis=-1)
        hx = modulate(rmsnorm(x, norm_mix[layer]), mod_x[0], mod_x[1])
        hc = modulate(rmsnorm(cx, norm_mix[layer]), mod_c[0], mod_c[1])
        if mix_id == 0:
            ox, oc = retention_mixer(hx, hc, ret_w_in[slot], ret_w_out[slot], not last)
        else:
            ox, oc = hgrn2_mixer(hx, hc, hg_w_in[slot], lower_bound[layer, 0], lower_bound[layer, 1],
                                 hg_g_norm[slot], hg_w_out[slot], not last)
        x = x + mod_x[2] * ox
        hx = modulate(rmsnorm(x, norm_ffn[layer]), mod_x[3], mod_x[4])
        x = x + mod_x[5] * expert_choice_ffn(hx, moe_router[layer], moe_w_gate[layer],
                                              moe_w_up[layer], moe_w_down[layer])
        if not last:
            cx = cx + mod_c[2] * oc
            hc = modulate(rmsnorm(cx, norm_ffn[layer]), mod_c[3], mod_c[4])
            cx = cx + mod_c[5] * expert_choice_ffn(hc, moe_router[layer], moe_w_gate[layer],
                                                    moe_w_up[layer], moe_w_down[layer])
    return rmsnorm(x, norm_final)
```

```cpp
#include <hip/hip_runtime.h>
#include <cstdio>
#include <cstdint>
#ifndef MK_PER_PHASE
#define MK_PER_PHASE 0
#endif
namespace pg8 {
#define PG8_LAS __attribute__((address_space(3)))
typedef unsigned short bf16_t;
typedef short bf16x8 __attribute__((ext_vector_type(8)));
typedef float f32x4 __attribute__((ext_vector_type(4)));
typedef unsigned u32x4 __attribute__((ext_vector_type(4)));
constexpr int BM = 256, BK = 64, HALF = 128, HTB = HALF * BK * 2  , STAGE_BYTES = 8 * HTB, NXCD = 8, WGM = 8;

__host__ __device__ __forceinline__ int lds_byte(int r, int c) { const int st = (r >> 4) * 2 + (c >> 5), rr = r & 15, cc = c & 31, ob = rr * 64 + cc * 2; return st * 1024 + (ob ^ (((ob >> 9) & 1) << 5)); }
__host__ __device__ __forceinline__ void stage_rc(int b, int& R, int& C) { const int st = b / 1024, sb = b % 1024, swz = sb ^ (((sb >> 9) & 1) << 5); R = (st >> 1) * 16 + swz / 64; C = (st & 1) * 32 + (swz % 64) / 2; }
__host__ __device__ __forceinline__ int perm32(int rho) { const int n = rho >> 4, i = rho & 15; return 8 * (i >> 2) + 4 * n + (i & 3); }

struct Unit { int pm, pn; };
struct Gemm { const bf16_t* A; const bf16_t* Bt; int M, N, K; int pmg; size_t bgs; };

struct StaticOrder {
    int nM, nN, nwg, G, c;
    __host__ __device__ void init(int M, int N, int G_, int c_) { nM = M / BM; nN = N / BM; nwg = nM * nN; G = G_; c = c_; }
    __host__ __device__ bool next(int i, Unit& u) const {
        const long L = (long)i * G + c; if (L >= nwg) return false;
        int wgid = (int)L; { const int q = nwg / NXCD, r = nwg % NXCD, xcd = wgid % NXCD, off = wgid / NXCD; wgid = (xcd < r ? xcd * (q + 1) : r * (q + 1) + (xcd - r) * q) + off; }
        const int nig = WGM * nN, gid = wgid / nig, fm = gid * WGM, gsz = (nM - fm) < WGM ? (nM - fm) : WGM;
        u.pm = fm + ((wgid % nig) % gsz); u.pn = (wgid % nig) / gsz; return true;
    }
    __device__ __forceinline__ void a_ready(const Unit&) const {}
    __device__ __forceinline__ void done(const Unit&) const {}
};
__device__ __forceinline__ unsigned cvt_pk_bf16(float lo, float hi) { unsigned r; asm volatile("v_cvt_pk_bf16_f32 %0, %1, %2" : "=v"(r) : "v"(lo), "v"(hi)); return r; }

template <class Epi, class Sched, bool STAMP = false>
__device__ __forceinline__ void gemm_phase(PG8_LAS unsigned char* lds, const Gemm g, const Sched& S, const Epi& E, unsigned long long* stamps) {
    const int tid = threadIdx.x, wid = __builtin_amdgcn_readfirstlane(tid >> 6), lane = tid & 63, wr = wid >> 2, wc = wid & 3, fr = lane & 15, fq = lane >> 4;
    const int K = g.K, nt = K / BK;
    int ts_lo = 0, ts_hi = 0, nts = 0; const unsigned long long rt_entry = STAMP ? (unsigned long long)wall_clock64() : 0ull;
#define PG8_STAMP() do { if (STAMP && wid == 0 && nts < 64) { const unsigned long long _c = (unsigned long long)clock64(); \
        ts_lo = (lane == nts) ? (int)(unsigned)_c : ts_lo; ts_hi = (lane == nts) ? (int)(unsigned)(_c >> 32) : ts_hi; ++nts; } } while (0)
    PG8_STAMP();
    unsigned voffA[2], voffB[2];
#pragma unroll
    for (int i = 0; i < 2; ++i) { int R, C; stage_rc(tid * 16 + i * 8192, R, C); const int Rb = Epi::PERM ? ((R & ~31) + perm32(R & 31)) : R;
        voffA[i] = (unsigned)(R * K + C) * 2u; voffB[i] = (unsigned)(Rb * K + C) * 2u; }
    const size_t kstep = (size_t)(BK * 2);
    const size_t hstep = (size_t)HALF * K * 2;
    const size_t tstep = 2 * hstep;
    const unsigned ldsw = (unsigned)wid * 1024u;
    const int aoff = lds_byte(wr * 64 + fr, fq * 8), boff = lds_byte(wc * 32 + fr, fq * 8);
#define PG8_SA(b, h) (((b) * 2 + (h)) * HTB)
#define PG8_SB(b, h) ((4 + (b) * 2 + (h)) * HTB)
#define PG8_STAGE(bufoff, gbase, voff) do { _Pragma("unroll") for (int _i = 0; _i < 2; ++_i) \
        __builtin_amdgcn_global_load_lds((const unsigned*)((const char*)(gbase) + (voff)[_i]), (PG8_LAS unsigned*)(lds + (bufoff) + ldsw + _i * 8192), 16, 0, 0); } while (0)
#define PG8_LDA(dst, b, h) do { _Pragma("unroll") for (int m = 0; m < 4; ++m) _Pragma("unroll") for (int k = 0; k < 2; ++k) dst[m][k] = *(const PG8_LAS bf16x8*)(lds + PG8_SA(b, h) + aoff + m * 2048 + k * 1024); } while (0)
#define PG8_LDB(dst, b, h) do { _Pragma("unroll") for (int n = 0; n < 2; ++n) _Pragma("unroll") for (int k = 0; k < 2; ++k) dst[n][k] = *(const PG8_LAS bf16x8*)(lds + PG8_SB(b, h) + boff + n * 2048 + k * 1024); } while (0)
#define PG8_MMA(ai, bj, At, Bt) do { __builtin_amdgcn_s_setprio(1); _Pragma("unroll") for (int m = 0; m < 4; ++m) _Pragma("unroll") for (int n = 0; n < 2; ++n) _Pragma("unroll") for (int k = 0; k < 2; ++k) \
        acc[ai][bj][m][n] = __builtin_amdgcn_mfma_f32_16x16x32_bf16(Bt[n][k], At[m][k], acc[ai][bj][m][n], 0, 0, 0); __builtin_amdgcn_s_setprio(0); } while (0)
#define PG8_WAIT_V(n) asm volatile("s_waitcnt vmcnt(" #n ")" ::: "memory")
#define PG8_WAIT_L(n) asm volatile("s_waitcnt lgkmcnt(" #n ")" ::: "memory")
#define PG8_BAR __builtin_amdgcn_s_barrier()
#define PG8_SCHED __builtin_amdgcn_sched_barrier(0)
    Unit cur, nxt; int ui = 0;
    if (!S.next(0, cur)) return;
    f32x4 acc[2][2][4][2];
#pragma unroll
    for (int a = 0; a < 2; ++a)
#pragma unroll
        for (int b = 0; b < 2; ++b)
#pragma unroll
            for (int m = 0; m < 4; ++m)
#pragma unroll
                for (int n = 0; n < 2; ++n) acc[a][b][m][n] = (f32x4){0.f, 0.f, 0.f, 0.f};
    bf16x8 At[4][2], B0[2][2], B1[2][2];
    const char* cA = (const char*)g.A + (size_t)cur.pm * tstep; const char* cB = (const char*)g.Bt + (size_t)(cur.pm / g.pmg) * g.bgs + (size_t)cur.pn * tstep;
    S.a_ready(cur);
    PG8_STAGE(PG8_SB(0, 0), cB, voffB); PG8_STAGE(PG8_SA(0, 0), cA, voffA); PG8_STAGE(PG8_SB(0, 1), cB + hstep, voffB); PG8_STAGE(PG8_SA(0, 1), cA + hstep, voffA);
    if (wr == 1) PG8_BAR;
    PG8_WAIT_V(4); PG8_BAR;
    PG8_STAGE(PG8_SB(1, 0), cB + kstep, voffB); PG8_STAGE(PG8_SA(1, 0), cA + kstep, voffA); PG8_STAGE(PG8_SB(1, 1), cB + hstep + kstep, voffB);
    PG8_WAIT_V(6); PG8_BAR;
    PG8_STAMP();
    for (;;) {
        const bool has_next = S.next(ui + 1, nxt);
        const char* nA = has_next ? (const char*)g.A + (size_t)nxt.pm * tstep : cA; const char* nB = has_next ? (const char*)g.Bt + (size_t)(nxt.pm / g.pmg) * g.bgs + (size_t)nxt.pn * tstep : cB;
        for (int t = 0; t < nt; t += 2) {
            const bool last = (t == nt - 2);
            const char* a1 = cA + (size_t)(t + 1) * kstep;
            const char* a2 = last ? nA : cA + (size_t)(t + 2) * kstep; const char* b2 = last ? nB : cB + (size_t)(t + 2) * kstep;
            const char* a3 = a2 + kstep; const char* b3 = b2 + kstep;
            if (last && has_next) S.a_ready(nxt);
            PG8_LDB(B0, 0, 0); PG8_SCHED; PG8_LDA(At, 0, 0); PG8_STAGE(PG8_SA(1, 1), a1 + hstep, voffA);
            PG8_WAIT_L(8); PG8_BAR; PG8_WAIT_L(0); PG8_MMA(0, 0, At, B0); PG8_BAR; PG8_SCHED;
            PG8_LDB(B1, 0, 1); PG8_STAGE(PG8_SB(0, 0), b2, voffB);
            PG8_BAR; PG8_WAIT_L(0); PG8_MMA(0, 1, At, B1); PG8_BAR;
            PG8_LDA(At, 0, 1); PG8_STAGE(PG8_SA(0, 0), a2, voffA);
            PG8_BAR; PG8_WAIT_L(0); PG8_MMA(1, 0, At, B0); PG8_BAR; PG8_SCHED;
            PG8_STAGE(PG8_SB(0, 1), b2 + hstep, voffB);
            PG8_WAIT_V(6); PG8_BAR; PG8_MMA(1, 1, At, B1); PG8_BAR;
            PG8_LDB(B0, 1, 0); PG8_SCHED; PG8_LDA(At, 1, 0); PG8_STAGE(PG8_SA(0, 1), a2 + hstep, voffA);
            PG8_WAIT_L(8); PG8_BAR; PG8_WAIT_L(0); PG8_MMA(0, 0, At, B0); PG8_BAR; PG8_SCHED;
            PG8_LDB(B1, 1, 1); PG8_STAGE(PG8_SB(1, 0), b3, voffB);
            PG8_BAR; PG8_WAIT_L(0); PG8_MMA(0, 1, At, B1); PG8_BAR;
            PG8_LDA(At, 1, 1); PG8_STAGE(PG8_SA(1, 0), a3, voffA);
            PG8_BAR; PG8_WAIT_L(0); PG8_MMA(1, 0, At, B0); PG8_BAR; PG8_SCHED;
            PG8_STAGE(PG8_SB(1, 1), b3 + hstep, voffB);
            PG8_WAIT_V(6); PG8_BAR; PG8_MMA(1, 1, At, B1); PG8_BAR;
        }
        PG8_STAMP();
        if constexpr (!Epi::AFTER_DRAIN) { E(acc, cur, wr, wc, fr, fq); S.done(cur); }
        PG8_STAMP();
        if (!has_next) break;
#pragma unroll
        for (int a = 0; a < 2; ++a)
#pragma unroll
            for (int b = 0; b < 2; ++b)
#pragma unroll
                for (int m = 0; m < 4; ++m)
#pragma unroll
                    for (int n = 0; n < 2; ++n) acc[a][b][m][n] = (f32x4){0.f, 0.f, 0.f, 0.f};
        cur = nxt; cA = nA; cB = nB; ++ui;
    }
    PG8_WAIT_V(0);
    if (wr == 0) PG8_BAR;
    PG8_BAR;
    if constexpr (Epi::AFTER_DRAIN) { E.fused(acc, cur, wr, wc, fr, fq, lds, wid, lane); S.done(cur); }
    PG8_STAMP();
    if (STAMP && wid == 0) { stamps[lane] = lane < nts ? (((unsigned long long)(unsigned)ts_hi << 32) | (unsigned)ts_lo) : 0ull;
        if (lane == 62) stamps[62] = rt_entry; if (lane == 63) stamps[63] = (unsigned long long)wall_clock64(); }
#undef PG8_STAMP
#undef PG8_SA
#undef PG8_SB
#undef PG8_STAGE
#undef PG8_LDA
#undef PG8_LDB
#undef PG8_MMA
#undef PG8_WAIT_V
#undef PG8_WAIT_L
#undef PG8_BAR
#undef PG8_SCHED
}
}
#define XB_TMO      128
#define XB_XCNT(j)  (256  + 64 * (j))
#define XB_XSUB(j)  (1280 + 64 * (j))
#define XB_XGEN(j)  (2304 + 64 * (j))
#define XB_TOP      3328
#define XB_TOPGEN   3392
#define XCD_BAR_WORDS 3456
#define XB_SPIN_CAP (1u << 18)
#define LAS __attribute__((address_space(3)))

__device__ __forceinline__ unsigned xb_ld(unsigned* p)              { return __hip_atomic_load(p, __ATOMIC_RELAXED, __HIP_MEMORY_SCOPE_AGENT); }
__device__ __forceinline__ unsigned xb_add(unsigned* p, unsigned v) { return __hip_atomic_fetch_add(p, v, __ATOMIC_RELAXED, __HIP_MEMORY_SCOPE_AGENT); }
__device__ __forceinline__ unsigned xb_xcc_id() { return (unsigned)__builtin_amdgcn_s_getreg((3 << 11) | 20) & 0xFu; }
#define XB_SPIN(cond, bar) do { unsigned _sp = 0; while (cond) { __builtin_amdgcn_s_sleep(1); \
    if ((++_sp & 255u) == 0u) { if (xb_ld(&(bar)[XB_TMO])) break; if (_sp > XB_SPIN_CAP) { atomicAdd(&(bar)[XB_TMO], 1u); break; } } } } while (0)

struct XcdBarrier {
    unsigned* bar; unsigned x;
    volatile LAS unsigned* st;
};

__device__ __forceinline__ XcdBarrier xcd_barrier_post(unsigned* bar, volatile LAS unsigned* st) {
    XcdBarrier b; b.bar = bar; b.x = xb_xcc_id(); b.st = st;
    if (threadIdx.x == 0) (void)xb_add(&bar[XB_XCNT(b.x)], 1u);
    return b;
}
__device__ __forceinline__ void xcd_barrier_complete(unsigned* bar, unsigned x, unsigned& nloc, unsigned& nx) {
    const unsigned G = gridDim.x * gridDim.y * gridDim.z;
    unsigned sum, cnt, mine, sp = 0u;
    for (;;) {
        sum = 0u; cnt = 0u; mine = 0u;
#pragma unroll
        for (unsigned j = 0; j < 16; ++j) { const unsigned c = xb_ld(&bar[XB_XCNT(j)]); sum += c; cnt += (c > 0u) ? 1u : 0u; mine = (j == x) ? c : mine; }
        if (sum == G) break;
        __builtin_amdgcn_s_sleep(1);
        if ((++sp & 255u) == 0u) { if (xb_ld(&bar[XB_TMO])) break; if (sp > XB_SPIN_CAP) { atomicAdd(&bar[XB_TMO], 1u); break; } }
    }
    nloc = mine > 0u ? mine : 1u; nx = cnt > 0u ? cnt : 1u;
}

__device__ __forceinline__ void xcd_barrier(const XcdBarrier& b) {
    asm volatile("s_waitcnt vmcnt(0)" ::: "memory");
    __syncthreads();
    if (threadIdx.x == 0) {
        unsigned* bar = b.bar;
        __builtin_amdgcn_s_waitcnt(0);
        unsigned nloc = b.st[0], nx = b.st[1];
        if (nloc == 0u) { xcd_barrier_complete(bar, b.x, nloc, nx); b.st[0] = nloc; b.st[1] = nx; }
        const unsigned old = xb_add(&bar[XB_XSUB(b.x)], 1u);
        const unsigned gen = old / nloc;
        if (old + 1u == (gen + 1u) * nloc) {
            __builtin_amdgcn_fence(__ATOMIC_RELEASE, "agent");
            asm volatile("s_waitcnt vmcnt(0)" ::: "memory");
            const unsigned og = xb_add(&bar[XB_TOP], 1u);
            const unsigned tg = og / nx;
            if (og + 1u == (tg + 1u) * nx) xb_add(&bar[XB_TOPGEN], 1u);
            else XB_SPIN(xb_ld(&bar[XB_TOPGEN]) == tg, bar);
            __builtin_amdgcn_fence(__ATOMIC_ACQUIRE, "agent");
            xb_add(&bar[XB_XGEN(b.x)], 1u);
            asm volatile("s_waitcnt vmcnt(0)" ::: "memory");
        } else {
            XB_SPIN(xb_ld(&bar[XB_XGEN(b.x)]) == gen, bar);
            __builtin_amdgcn_fence(__ATOMIC_ACQUIRE, "agent");
            asm volatile("s_waitcnt vmcnt(0)" ::: "memory");
        }
    }
    __syncthreads();
}


typedef unsigned short bf16_t;
typedef float f32x4 __attribute__((ext_vector_type(4)));
typedef float f32x2 __attribute__((ext_vector_type(2)));
typedef unsigned u32x4 __attribute__((ext_vector_type(4)));
typedef unsigned u32x2 __attribute__((ext_vector_type(2)));
typedef __bf16 bf16x2_t __attribute__((ext_vector_type(2)));
#define DI __device__ __forceinline__

constexpr int D = 1024, NB = 8, SEQ = 2048, CTXL = 256;
constexpr int NLAT = NB * SEQ, NCTX = NB * CTXL, NTOK = NLAT + NCTX;
constexpr int RET_IN = 6144, HG_IN = 5120, HG_PITCH = 7168;
constexpr int NE = 16, FF = 2816, N1 = 2 * FF;
constexpr int MPER0 = 2304, MPER1 = 2048;
constexpr float EPS = 1e-6f;
constexpr int NTHREADS = 512;
constexpr int LDS_BYTES = 131072 + 256;
constexpr int MISC_OFF = 131072;

constexpr size_t al256(size_t x) { return (x + 255) & ~(size_t)255; }
constexpr size_t WS_BAR  = 0;
constexpr size_t WS_MOD  = 16384;
constexpr size_t WS_ROPE = WS_MOD + al256(2 * 9 * 6144 * 4);
constexpr size_t WS_LB   = WS_ROPE + al256((32 * 64 + 64 * 64) * 8);
constexpr size_t WS_AFF  = WS_LB + al256(2 * 1024 * 4);
constexpr size_t WS_SLOT = WS_AFF + al256((size_t)NTOK * 16 * 4);
constexpr size_t WS_WRI  = WS_SLOT + al256((size_t)NTOK * 16 * 4);
constexpr size_t WS_WRO  = WS_WRI + al256((size_t)6144 * 1024 * 2);
constexpr size_t WS_WHI  = WS_WRO + al256((size_t)1024 * 2048 * 2);
constexpr size_t WS_WHO  = WS_WHI + al256((size_t)5120 * 1024 * 2);
constexpr size_t WS_WM1  = WS_WHO + al256((size_t)1024 * 1024 * 2);
constexpr size_t WS_WM2  = WS_WM1 + al256((size_t)32 * N1 * 1024 * 2);
constexpr size_t WS_X    = WS_WM2 + al256((size_t)32 * 1024 * FF * 2);
constexpr size_t WS_H    = WS_X + al256((size_t)NTOK * 1024 * 4);
constexpr size_t WS_R1   = WS_H + al256((size_t)NTOK * 1024 * 2);
constexpr size_t WS_R2   = WS_R1 + al256((size_t)NTOK * HG_PITCH * 2);
constexpr size_t WS_A2   = WS_R2 + al256((size_t)NTOK * 2048 * 2 * 2);
constexpr size_t WS_END  = WS_A2 + al256((size_t)NTOK * 2048 * 2);
constexpr size_t R2_HALF = (size_t)NTOK * 2048 * 2;

struct Args { const float* in[19]; float* out; unsigned char* ws; int ph_lo, ph_hi; };
enum { I_X = 0, I_C, I_CTX, I_CCTX, I_WADA, I_BADA, I_NMIX, I_NFFN, I_RWIN, I_RWOUT, I_HWIN, I_HGN, I_HLB, I_HWOUT, I_ROUTER, I_WG, I_WU, I_WD, I_NFIN };

DI unsigned pk_bf16(float lo, float hi) { f32x2 v = {lo, hi}; bf16x2_t b = __builtin_convertvector(v, bf16x2_t); return __builtin_bit_cast(unsigned, b); }
DI float bf_lo(unsigned u) { return __uint_as_float(u << 16); }
DI float bf_hi(unsigned u) { return __uint_as_float(u & 0xffff0000u); }
DI float bf2f(bf16_t h) { return __uint_as_float(((unsigned)h) << 16); }
DI bf16_t f2bf(float f) { return (bf16_t)(pk_bf16(f, 0.f) & 0xffffu); }
DI float fast_sigmoid(float x) { return __builtin_amdgcn_rcpf(1.0f + __expf(-x)); }
DI float silu_f(float x) { return x * fast_sigmoid(x); }
DI float wave_sum(float v) {
#pragma unroll
    for (int o = 32; o >= 1; o >>= 1) v += __shfl_xor(v, o);
    return v;
}
DI int mod_row(int row) { return row < NLAT ? (row >> 11) : 8; }

struct EpiRetIn {
    static constexpr bool PERM = true, AFTER_DRAIN = false;
    bf16_t* O; const f32x2* ropeR; const f32x2* ropeC;
    DI void operator()(const f32x4 (&acc)[2][2][4][2], const pg8::Unit& u, int wr, int wc, int fr, int fq) const {
        const int row0 = u.pm * 256 + wr * 64 + fr, col0 = u.pn * 256 + wc * 32 + 8 * fq;
        const bool rot = (u.pn < 8) && (u.pm < 64);
#pragma unroll
        for (int ai = 0; ai < 2; ++ai)
#pragma unroll
            for (int m = 0; m < 4; ++m) {
                const int row = row0 + ai * 128 + m * 16; bf16_t* rowp = O + (size_t)row * RET_IN + col0;
                const int t = row & 2047;
#pragma unroll
                for (int bj = 0; bj < 2; ++bj) {
                    f32x4 v0 = acc[ai][bj][m][0], v1 = acc[ai][bj][m][1];
                    if (rot) {
                        const f32x2* tb = bj ? (ropeC + (size_t)(t & 63) * 64) : (ropeR + (size_t)(t >> 6) * 64);
                        const int i0 = 16 * wc + 4 * fq;
                        const f32x4 cs0 = *(const f32x4*)(tb + i0), cs1 = *(const f32x4*)(tb + i0 + 2);
                        f32x4 o0, o1;
                        o0[0] = v0[0] * cs0[0] - v0[1] * cs0[1]; o0[1] = v0[0] * cs0[1] + v0[1] * cs0[0];
                        o0[2] = v0[2] * cs0[2] - v0[3] * cs0[3]; o0[3] = v0[2] * cs0[3] + v0[3] * cs0[2];
                        o1[0] = v1[0] * cs1[0] - v1[1] * cs1[1]; o1[1] = v1[0] * cs1[1] + v1[1] * cs1[0];
                        o1[2] = v1[2] * cs1[2] - v1[3] * cs1[3]; o1[3] = v1[2] * cs1[3] + v1[3] * cs1[2];
                        v0 = o0; v1 = o1;
                    }
                    u32x4 w; w.x = pk_bf16(v0[0], v0[1]); w.y = pk_bf16(v0[2], v0[3]); w.z = pk_bf16(v1[0], v1[1]); w.w = pk_bf16(v1[2], v1[3]);
                    *(u32x4*)(rowp + bj * 128) = w;
                }
            }
    }
};
struct EpiHgIn {
    static constexpr bool PERM = true, AFTER_DRAIN = false;
    bf16_t* O; const float* lb;
    DI void operator()(const f32x4 (&acc)[2][2][4][2], const pg8::Unit& u, int wr, int wc, int fr, int fq) const {
        const int row0 = u.pm * 256 + wr * 64 + fr, col0 = u.pn * 256 + wc * 32 + 8 * fq;
        const int region = u.pn >> 2;
        f32x4 lbv[2][2];
        if (region == 1 || region == 2) {
#pragma unroll
            for (int bj = 0; bj < 2; ++bj)
#pragma unroll
                for (int n = 0; n < 2; ++n) lbv[bj][n] = *(const f32x4*)(lb + (col0 - 1024) + bj * 128 + 4 * n);
        }
#pragma unroll
        for (int ai = 0; ai < 2; ++ai)
#pragma unroll
            for (int m = 0; m < 4; ++m) {
                const int row = row0 + ai * 128 + m * 16; bf16_t* rowp = O + (size_t)row * HG_PITCH + col0;
#pragma unroll
                for (int bj = 0; bj < 2; ++bj) {
                    f32x4 v0 = acc[ai][bj][m][0], v1 = acc[ai][bj][m][1];
                    if (region == 0) {
#pragma unroll
                        for (int j = 0; j < 4; ++j) { v0[j] = silu_f(v0[j]); v1[j] = silu_f(v1[j]); }
                    } else if (region == 1 || region == 2) {
                        f32x4 g0, g1;
#pragma unroll
                        for (int j = 0; j < 4; ++j) {
                            const float l0 = lbv[bj][0][j], l1 = lbv[bj][1][j];
                            const float s0 = fast_sigmoid(v0[j]), s1 = fast_sigmoid(v1[j]);
                            const float f0 = l0 + (1.f - l0) * s0, f1 = l1 + (1.f - l1) * s1;
                            g0[j] = __logf(f0); g1[j] = __logf(f1);
                            v0[j] = (1.f - l0) * (1.f - s0); v1[j] = (1.f - l1) * (1.f - s1);
                        }
                        u32x4 wg; wg.x = pk_bf16(g0[0], g0[1]); wg.y = pk_bf16(g0[2], g0[3]); wg.z = pk_bf16(g1[0], g1[1]); wg.w = pk_bf16(g1[2], g1[3]);
                        *(u32x4*)(rowp + 4096 + bj * 128) = wg;
                    }
                    u32x4 w; w.x = pk_bf16(v0[0], v0[1]); w.y = pk_bf16(v0[2], v0[3]); w.z = pk_bf16(v1[0], v1[1]); w.w = pk_bf16(v1[2], v1[3]);
                    *(u32x4*)(rowp + bj * 128) = w;
                }
            }
    }
};
struct EpiResid {
    static constexpr bool PERM = false, AFTER_DRAIN = false;
    const float* src_lat; const float* src_ctx; float* X; const float* mod; int goff;
    DI void operator()(const f32x4 (&acc)[2][2][4][2], const pg8::Unit& u, int wr, int wc, int fr, int fq) const {
        const int row0 = u.pm * 256 + wr * 64 + fr, col0 = u.pn * 256 + wc * 32 + 4 * fq;
        const int mr = (u.pm < 64) ? (u.pm >> 3) : 8;
        f32x4 gv[2][2];
#pragma unroll
        for (int bj = 0; bj < 2; ++bj)
#pragma unroll
            for (int n = 0; n < 2; ++n) gv[bj][n] = *(const f32x4*)(mod + (size_t)mr * 6144 + goff + col0 + bj * 128 + n * 16);
#pragma unroll
        for (int ai = 0; ai < 2; ++ai)
#pragma unroll
            for (int m = 0; m < 4; ++m) {
                const int row = row0 + ai * 128 + m * 16;
                const float* sp = (row < NLAT ? src_lat + (size_t)row * D : src_ctx + (size_t)(row - NLAT) * D) + col0;
                float* xp = X + (size_t)row * D + col0;
#pragma unroll
                for (int bj = 0; bj < 2; ++bj)
#pragma unroll
                    for (int n = 0; n < 2; ++n) { const f32x4 s = *(const f32x4*)(sp + bj * 128 + n * 16); *(f32x4*)(xp + bj * 128 + n * 16) = s + gv[bj][n] * acc[ai][bj][m][n]; }
            }
    }
};
struct EpiMoe1 {
    static constexpr bool PERM = true, AFTER_DRAIN = false;
    bf16_t* O;
    DI void operator()(const f32x4 (&acc)[2][2][4][2], const pg8::Unit& u, int wr, int wc, int fr, int fq) const {
        const int row0 = u.pm * 256 + wr * 64 + fr, col0 = u.pn * 128 + wc * 32 + 8 * fq;
#pragma unroll
        for (int ai = 0; ai < 2; ++ai)
#pragma unroll
            for (int m = 0; m < 4; ++m) {
                bf16_t* rowp = O + (size_t)(row0 + ai * 128 + m * 16) * FF + col0;
                f32x4 a0 = acc[ai][0][m][0], a1 = acc[ai][0][m][1]; const f32x4 u0 = acc[ai][1][m][0], u1 = acc[ai][1][m][1];
#pragma unroll
                for (int j = 0; j < 4; ++j) { a0[j] = silu_f(a0[j]) * u0[j]; a1[j] = silu_f(a1[j]) * u1[j]; }
                u32x4 w; w.x = pk_bf16(a0[0], a0[1]); w.y = pk_bf16(a0[2], a0[3]); w.z = pk_bf16(a1[0], a1[1]); w.w = pk_bf16(a1[2], a1[3]);
                *(u32x4*)rowp = w;
            }
    }
};
struct EpiPlainBf16 {
    static constexpr bool PERM = true, AFTER_DRAIN = false;
    bf16_t* O; int ldc;
    DI void operator()(const f32x4 (&acc)[2][2][4][2], const pg8::Unit& u, int wr, int wc, int fr, int fq) const {
        const int row0 = u.pm * 256 + wr * 64 + fr, col0 = u.pn * 256 + wc * 32 + 8 * fq;
#pragma unroll
        for (int ai = 0; ai < 2; ++ai)
#pragma unroll
            for (int m = 0; m < 4; ++m) {
                bf16_t* rowp = O + (size_t)(row0 + ai * 128 + m * 16) * ldc + col0;
#pragma unroll
                for (int bj = 0; bj < 2; ++bj) {
                    const f32x4 v0 = acc[ai][bj][m][0], v1 = acc[ai][bj][m][1];
                    u32x4 w; w.x = pk_bf16(v0[0], v0[1]); w.y = pk_bf16(v0[2], v0[3]); w.z = pk_bf16(v1[0], v1[1]); w.w = pk_bf16(v1[2], v1[3]);
                    *(u32x4*)(rowp + bj * 128) = w;
                }
            }
    }
};

DI void convert_tile(const float* __restrict__ src, int ldsrc, int col0, int kind, float scale, bf16_t* __restrict__ dst, int lddst, int n0, int k0, LAS unsigned* L) {
    const int tid = threadIdx.x, lane = tid & 63, w = tid >> 6;
    int col = col0 + lane;
    if (kind == 1) { const int np = n0 + lane, p = np & 255, hh = p >> 7, i = (p & 127) >> 1, wh = p & 1; col = (np - p) + hh * 128 + wh * 64 + i; }
    const float* sp = src + (size_t)k0 * ldsrc + col;
    float a[8], b[8];
#pragma unroll
    for (int it = 0; it < 8; ++it) { const int k = 16 * it + 2 * w; a[it] = sp[(size_t)k * ldsrc]; b[it] = sp[(size_t)(k + 1) * ldsrc]; }
#pragma unroll
    for (int it = 0; it < 8; ++it) L[lane * 65 + 8 * it + w] = pk_bf16(a[it] * scale, b[it] * scale);
    __syncthreads();
#pragma unroll
    for (int j = 0; j < 2; ++j) {
        const int id = tid + 512 * j, row = id >> 4, ch = id & 15;
        u32x4 v; v.x = L[row * 65 + 4 * ch]; v.y = L[row * 65 + 4 * ch + 1]; v.z = L[row * 65 + 4 * ch + 2]; v.w = L[row * 65 + 4 * ch + 3];
        *(u32x4*)(dst + (size_t)(n0 + row) * lddst + k0 + 8 * ch) = v;
    }
    __syncthreads();
}
constexpr int CT0 = 0, CT1 = CT0 + 96 * 8, CT2 = CT1 + 16 * 16, CT3 = CT2 + 80 * 8, CT4 = CT3 + 16 * 8, CT5 = CT4 + 32 * 88 * 8, CT_END = CT5 + 32 * 16 * 22;
constexpr int GEMV_UNITS = 192;

DI void p0_prologue(const Args& A, LAS unsigned char* lds) {
    const int tid = threadIdx.x, lane = tid & 63, w = tid >> 6, G = gridDim.x;
    unsigned char* ws = A.ws;
    bool have_s = false;
    LAS float* S = (LAS float*)lds;
    LAS float* RED = (LAS float*)(lds + 9 * 1024 * 4);
    for (int u = blockIdx.x; u < GEMV_UNITS; u += G) {
        if (!have_s) {
            for (int i = tid; i < 9 * 1024; i += NTHREADS) { const int r = i >> 10, k = i & 1023; const float c = (r < 8) ? A.in[I_C][r * 1024 + k] : A.in[I_CCTX][k]; S[i] = silu_f(c); }
            have_s = true;
        }
        __syncthreads();
        const int l = u / 96, n0 = (u % 96) * 64;
        const float* W = A.in[I_WADA] + (size_t)l * 1024 * 6144 + n0 + lane;
        float acc[9];
#pragma unroll
        for (int r = 0; r < 9; ++r) acc[r] = 0.f;
        for (int k = 128 * w; k < 128 * w + 128; k += 4) {
            const float w0 = W[(size_t)k * 6144], w1 = W[(size_t)(k + 1) * 6144], w2 = W[(size_t)(k + 2) * 6144], w3 = W[(size_t)(k + 3) * 6144];
#pragma unroll
            for (int r = 0; r < 9; ++r) { const f32x4 s = *(const LAS f32x4*)(S + r * 1024 + k); acc[r] += s[0] * w0 + s[1] * w1 + s[2] * w2 + s[3] * w3; }
        }
#pragma unroll
        for (int r = 0; r < 9; ++r) RED[(w * 9 + r) * 64 + lane] = acc[r];
        __syncthreads();
        for (int i = tid; i < 9 * 64; i += NTHREADS) {
            const int r = i >> 6, c = i & 63; float s = 0.f;
#pragma unroll
            for (int ww = 0; ww < 8; ++ww) s += RED[(ww * 9 + r) * 64 + c];
            ((float*)(ws + WS_MOD))[(size_t)(l * 9 + r) * 6144 + n0 + c] = s + A.in[I_BADA][l * 6144 + n0 + c];
        }
        __syncthreads();
    }
    if (blockIdx.x == (unsigned)(G - 1)) {
        f32x2* R = (f32x2*)(ws + WS_ROPE);
        for (int i = tid; i < (32 + 64) * 64; i += NTHREADS) {
            const int pos = (i < 2048) ? (i >> 6) : ((i - 2048) >> 6), f = i & 63;
            const float inv = exp2f(-(float)f * (13.287712379549449f / 64.0f));
            float s, c; sincosf((float)pos * inv, &s, &c); R[i] = (f32x2){c, s};
        }
    }
    if (blockIdx.x == (unsigned)(G - 2 >= 0 ? G - 2 : 0)) {
        float* LB = (float*)(ws + WS_LB);
        for (int i = tid; i < 2048; i += NTHREADS) { const float h0 = A.in[I_HLB][i], h1 = A.in[I_HLB][2048 + i]; LB[i] = 1.0f / (1.0f + __expf(h0 - h1)); }
    }
    __syncthreads();
    LAS unsigned* L = (LAS unsigned*)lds;
    for (int t = blockIdx.x; t < CT_END; t += G) {
        if (t < CT1) {
            const int nt = t % 96, kt = t / 96, n0 = nt * 64;
            convert_tile(A.in[I_RWIN], 6144, n0, n0 < 2048 ? 1 : 0, (n0 >= 1024 && n0 < 2048) ? 0.0625f : 1.0f, (bf16_t*)(ws + WS_WRI), 1024, n0, kt * 128, L);
        } else if (t < CT2) {
            const int q = t - CT1, nt = q % 16, kt = q / 16;
            convert_tile(A.in[I_RWOUT], 1024, nt * 64, 0, 1.0f, (bf16_t*)(ws + WS_WRO), 2048, nt * 64, kt * 128, L);
        } else if (t < CT3) {
            const int q = t - CT2, nt = q % 80, kt = q / 80;
            convert_tile(A.in[I_HWIN], 5120, nt * 64, 0, 1.0f, (bf16_t*)(ws + WS_WHI), 1024, nt * 64, kt * 128, L);
        } else if (t < CT4) {
            const int q = t - CT3, nt = q % 16, kt = q / 16;
            convert_tile(A.in[I_HWOUT], 1024, nt * 64, 0, 1.0f, (bf16_t*)(ws + WS_WHO), 1024, nt * 64, kt * 128, L);
        } else if (t < CT5) {
            const int q = t - CT4, le = q / 704, r = q % 704, nt = r % 88, kt = r / 88, n0 = nt * 64;
            const int tt = n0 >> 8, j0 = n0 & 255;
            const float* src = ((j0 < 128) ? A.in[I_WG] : A.in[I_WU]) + (size_t)le * 1024 * FF;
            convert_tile(src, FF, tt * 128 + (j0 & 127), 0, 1.0f, (bf16_t*)(ws + WS_WM1) + (size_t)le * N1 * 1024, 1024, n0, kt * 128, L);
        } else {
            const int q = t - CT5, le = q / 352, r = q % 352, nt = r % 16, kt = r / 16;
            convert_tile(A.in[I_WD] + (size_t)le * FF * 1024, 1024, nt * 64, 0, 1.0f, (bf16_t*)(ws + WS_WM2) + (size_t)le * 1024 * FF, FF, nt * 64, kt * 128, L);
        }
    }
}

template <int MODE>
DI void row_phase(const Args& A, LAS unsigned char* lds, int nrows, const float* src_lat, const float* src_ctx, const float* normw, const float* mod, int sh_off, int sc_off,
                  const float* cmod, int mper, const float* wrouter) {
    const int tid = threadIdx.x, lane = tid & 63, w = tid >> 6, G = gridDim.x;
    unsigned char* ws = A.ws;
    float* X = (float*)(ws + WS_X); bf16_t* H = (bf16_t*)(ws + WS_H); float* AFF = (float*)(ws + WS_AFF); const int* SLOT = (const int*)(ws + WS_SLOT);
    const bf16_t* Y = (const bf16_t*)(ws + WS_R2 + R2_HALF);
    LAS float* WR = (LAS float*)lds;
    if (MODE & 2) { for (int i = tid; i < 1024 * 16; i += NTHREADS) WR[i] = wrouter[i]; __syncthreads(); }
    f32x4 nw[4];
#pragma unroll
    for (int j = 0; j < 4; ++j) nw[j] = *(const f32x4*)(normw + 256 * j + 4 * lane);
    for (int row = blockIdx.x * 8 + w; row < nrows; row += G * 8) {
        const float* sp = (row < NLAT) ? src_lat + (size_t)row * D : src_ctx + (size_t)(row - NLAT) * D;
        const int mr = mod_row(row);
        f32x4 x[4];
#pragma unroll
        for (int j = 0; j < 4; ++j) x[j] = *(const f32x4*)(sp + 256 * j + 4 * lane);
        if (MODE & 1) {
            f32x4 acc[4];
#pragma unroll
            for (int j = 0; j < 4; ++j) acc[j] = (f32x4){0.f, 0.f, 0.f, 0.f};
            const int base = (row < NLAT) ? ((row >> 11) * 256) : (2048 + ((row - NLAT) >> 8) * 32);
            for (int e = 0; e < NE; ++e) {
                const int slot = SLOT[(size_t)row * 16 + e];
                if (slot >= 0) {
                    const float gte = AFF[(size_t)row * 16 + e];
                    const bf16_t* yp = Y + ((size_t)e * mper + base + slot) * D;
#pragma unroll
                    for (int j = 0; j < 4; ++j) { const u32x2 y = *(const u32x2*)(yp + 256 * j + 4 * lane); acc[j][0] += gte * bf_lo(y.x); acc[j][1] += gte * bf_hi(y.x); acc[j][2] += gte * bf_lo(y.y); acc[j][3] += gte * bf_hi(y.y); }
                }
            }
#pragma unroll
            for (int j = 0; j < 4; ++j) { const f32x4 g = *(const f32x4*)(cmod + (size_t)mr * 6144 + 5 * 1024 + 256 * j + 4 * lane); x[j] += g * acc[j]; }
            if (!(MODE & 4)) {
#pragma unroll
                for (int j = 0; j < 4; ++j) *(f32x4*)(X + (size_t)row * D + 256 * j + 4 * lane) = x[j];
            }
        }
        float ss = 0.f;
#pragma unroll
        for (int j = 0; j < 4; ++j) ss += x[j][0] * x[j][0] + x[j][1] * x[j][1] + x[j][2] * x[j][2] + x[j][3] * x[j][3];
        ss = wave_sum(ss);
        const float rs = rsqrtf(ss * (1.0f / 1024.0f) + EPS);
        if (MODE & 4) {
#pragma unroll
            for (int j = 0; j < 4; ++j) *(f32x4*)(A.out + (size_t)row * D + 256 * j + 4 * lane) = x[j] * rs * nw[j];
            continue;
        }
        f32x4 h[4];
#pragma unroll
        for (int j = 0; j < 4; ++j) {
            const f32x4 sh = *(const f32x4*)(mod + (size_t)mr * 6144 + sh_off + 256 * j + 4 * lane), sc = *(const f32x4*)(mod + (size_t)mr * 6144 + sc_off + 256 * j + 4 * lane);
            h[j] = (x[j] * rs * nw[j]) * (1.0f + sc) + sh;
            u32x2 o; o.x = pk_bf16(h[j][0], h[j][1]); o.y = pk_bf16(h[j][2], h[j][3]);
            *(u32x2*)(H + (size_t)row * D + 256 * j + 4 * lane) = o;
        }
        if (MODE & 2) {
            float lg[16];
#pragma unroll
            for (int e = 0; e < 16; ++e) lg[e] = 0.f;
#pragma unroll
            for (int j = 0; j < 4; ++j)
#pragma unroll
                for (int q = 0; q < 4; ++q) {
                    const int k = 256 * j + 4 * lane + q; const float hv = h[j][q];
#pragma unroll
                    for (int e4 = 0; e4 < 4; ++e4) { const f32x4 wv = *(const LAS f32x4*)(WR + k * 16 + 4 * e4); lg[4 * e4] += hv * wv[0]; lg[4 * e4 + 1] += hv * wv[1]; lg[4 * e4 + 2] += hv * wv[2]; lg[4 * e4 + 3] += hv * wv[3]; }
                    asm volatile("" ::: "memory");
                }
            float mx = -3.0e38f;
#pragma unroll
            for (int e = 0; e < 16; ++e) { lg[e] = wave_sum(lg[e]); mx = fmaxf(mx, lg[e]); }
            float den = 0.f;
#pragma unroll
            for (int e = 0; e < 16; ++e) { lg[e] = __expf(lg[e] - mx); den += lg[e]; }
            const float inv = 1.0f / den;
            float mine = 0.f;
#pragma unroll
            for (int e = 0; e < 16; ++e) mine = (lane == e) ? lg[e] * inv : mine;
            if (lane < 16) AFF[(size_t)row * 16 + lane] = mine;
        }
    }
    if (MODE & 2) __syncthreads();
}

DI void topk_phase(const Args& A, LAS unsigned char* lds, int nprob, int mper) {
    const int tid = threadIdx.x, lane = tid & 63, w = tid >> 6, G = gridDim.x;
    unsigned char* ws = A.ws;
    const float* AFF = (const float*)(ws + WS_AFF); int* SLOT = (int*)(ws + WS_SLOT); const bf16_t* H = (const bf16_t*)(ws + WS_H); bf16_t* XE = (bf16_t*)(ws + WS_R2);
    LAS float* V = (LAS float*)lds;
    LAS int* SEL = (LAS int*)(lds + 8192);
    for (int p = blockIdx.x; p < nprob; p += G) {
        const bool lat = p < 128; const int b = lat ? (p >> 4) : ((p - 128) >> 4), e = p & 15;
        const int N = lat ? 2048 : 256, cap = lat ? 256 : 32, row0 = lat ? b * 2048 : NLAT + b * 256, base = lat ? b * 256 : 2048 + b * 32;
        for (int t = tid; t < N; t += NTHREADS) V[t] = AFF[(size_t)(row0 + t) * 16 + e];
        __syncthreads();
        for (int t0 = 0; t0 < N; t0 += 4 * NTHREADS) {
            float v[4]; int cnt[4]; int tt[4];
#pragma unroll
            for (int j = 0; j < 4; ++j) { tt[j] = t0 + tid + NTHREADS * j; v[j] = (tt[j] < N) ? V[tt[j]] : 0.f; cnt[j] = 0; }
            for (int s = 0; s < N; s += 4) {
                const f32x4 o = *(const LAS f32x4*)(V + s);
#pragma unroll
                for (int j = 0; j < 4; ++j)
#pragma unroll
                    for (int q = 0; q < 4; ++q) cnt[j] += (o[q] > v[j] || (o[q] == v[j] && (s + q) < tt[j])) ? 1 : 0;
            }
#pragma unroll
            for (int j = 0; j < 4; ++j) if (tt[j] < N) {
                const bool sel = cnt[j] < cap;
                SLOT[(size_t)(row0 + tt[j]) * 16 + e] = sel ? cnt[j] : -1;
                if (sel) SEL[cnt[j]] = row0 + tt[j];
            }
        }
        __syncthreads();
        for (int s = w; s < cap; s += 8) {
            const bf16_t* hp = H + (size_t)SEL[s] * D; bf16_t* xp = XE + ((size_t)e * mper + base + s) * D;
#pragma unroll
            for (int j = 0; j < 2; ++j) *(u32x4*)(xp + 512 * j + 8 * lane) = *(const u32x4*)(hp + 512 * j + 8 * lane);
        }
        __syncthreads();
    }
}

template <bool RET>
DI void readout_phase(const Args& A, int nrows) {
    const int tid = threadIdx.x, lane = tid & 63, w = tid >> 6, G = gridDim.x;
    unsigned char* ws = A.ws;
    constexpr int HD = RET ? 2048 : 1024, PITCH = RET ? RET_IN : HG_PITCH, NJ = HD / 512;
    const bf16_t* OF = (const bf16_t*)(ws + WS_R2); const bf16_t* OB = (const bf16_t*)(ws + WS_R2 + R2_HALF);
    const bf16_t* P = (const bf16_t*)(ws + WS_R1); bf16_t* A2 = (bf16_t*)(ws + WS_A2);
    for (int row = blockIdx.x * 8 + w; row < nrows; row += G * 8) {
#pragma unroll
        for (int j = 0; j < NJ; ++j) {
            const int col = 512 * j + 8 * lane;
            const u32x4 a = *(const u32x4*)(OF + (size_t)row * HD + col), b = *(const u32x4*)(OB + (size_t)row * HD + col), g = *(const u32x4*)(P + (size_t)row * PITCH + 4096 + col);
            float o[8];
            o[0] = bf_lo(a.x) + bf_lo(b.x); o[1] = bf_hi(a.x) + bf_hi(b.x); o[2] = bf_lo(a.y) + bf_lo(b.y); o[3] = bf_hi(a.y) + bf_hi(b.y);
            o[4] = bf_lo(a.z) + bf_lo(b.z); o[5] = bf_hi(a.z) + bf_hi(b.z); o[6] = bf_lo(a.w) + bf_lo(b.w); o[7] = bf_hi(a.w) + bf_hi(b.w);
            float ss = 0.f;
#pragma unroll
            for (int q = 0; q < 8; ++q) ss += o[q] * o[q];
            float rs;
            if (RET) { ss = wave_sum(ss); rs = rsqrtf(ss * (1.0f / 512.0f) + EPS); }
            else { ss += __shfl_xor(ss, 1); ss += __shfl_xor(ss, 2); ss += __shfl_xor(ss, 4); ss += __shfl_xor(ss, 8); rs = rsqrtf(ss * (1.0f / 128.0f) + EPS); }
            float gn[8];
            if (RET) {
#pragma unroll
                for (int q = 0; q < 8; ++q) gn[q] = 1.0f;
            } else {
                const f32x4 g0 = *(const f32x4*)(A.in[I_HGN] + (col & 127)), g1 = *(const f32x4*)(A.in[I_HGN] + (col & 127) + 4);
                gn[0] = g0[0]; gn[1] = g0[1]; gn[2] = g0[2]; gn[3] = g0[3]; gn[4] = g1[0]; gn[5] = g1[1]; gn[6] = g1[2]; gn[7] = g1[3];
            }
            const float gt[8] = {bf_lo(g.x), bf_hi(g.x), bf_lo(g.y), bf_hi(g.y), bf_lo(g.z), bf_hi(g.z), bf_lo(g.w), bf_hi(g.w)};
            float r[8];
#pragma unroll
            for (int q = 0; q < 8; ++q) r[q] = silu_f(gt[q]) * (o[q] * rs * gn[q]);
            u32x4 wv; wv.x = pk_bf16(r[0], r[1]); wv.y = pk_bf16(r[2], r[3]); wv.z = pk_bf16(r[4], r[5]); wv.w = pk_bf16(r[6], r[7]);
            *(u32x4*)(A2 + (size_t)row * HD + col) = wv;
        }
    }
}

template <bool RET>
DI void scan_naive_phase(const Args& A, LAS unsigned char* lds, bool ctx_out) {
    constexpr int DK = RET ? 256 : 128, DVS = RET ? 64 : 128, NKG = NTHREADS / DVS, PITCH = RET ? RET_IN : HG_PITCH, HD = RET ? 2048 : 1024;
    constexpr int NUNITS = RET ? 8 * 4 * 2 * 8 : 8 * 8 * 2;
    const int tid = threadIdx.x, G = gridDim.x;
    unsigned char* ws = A.ws;
    const bf16_t* P = (const bf16_t*)(ws + WS_R1);
    LAS bf16_t* Lq = (LAS bf16_t*)lds;
    LAS bf16_t* Lk = Lq + 64 * DK;
    LAS bf16_t* Lg = Lk + 64 * DK;
    LAS bf16_t* Lv = Lg + (RET ? 0 : 64 * DK);
    LAS float* Lp = (LAS float*)(Lv + 64 * DVS);
    const int v = tid % DVS, kg = tid / DVS;
    for (int u = blockIdx.x; u < NUNITS; u += G) {
        int b, h, dir, dvs = 0;
        if (RET) { dvs = u & 7; dir = (u >> 3) & 1; h = (u >> 4) & 3; b = u >> 6; } else { dir = u & 1; h = (u >> 1) & 7; b = u >> 4; }
        const int qoff = RET ? h * 256 : h * 128;
        const int koff = RET ? 1024 + h * 256 : 1024 + dir * 1024 + h * 128;
        const int goff = RET ? 0 : 5120 + dir * 1024 + h * 128;
        const int voff = RET ? 2048 + h * 512 + dvs * 64 : 3072 + h * 128;
        const int ooff = RET ? h * 512 + dvs * 64 : h * 128;
        bf16_t* O = (bf16_t*)(ws + WS_R2 + (dir ? R2_HALF : 0));
        float gam = 1.f;
        if (RET) { const float j = (float)(2 * h + dir); gam = 1.0f - exp2f(-5.0f - 0.5f * j); }
        float S[32];
#pragma unroll
        for (int d = 0; d < 32; ++d) S[d] = 0.f;
        for (int st = 0; st < 36; ++st) {
            const bool isctx = st < 4;
            const int c = isctx ? st : st - 4;
            const int len = isctx ? 256 : 2048, rbase = isctx ? NLAT + b * 256 : b * 2048;
            const int tlo = dir ? (len - 64 - 64 * c) : 64 * c;
            for (int id = tid; id < 64 * DK / 8; id += NTHREADS) {
                const int i = id / (DK / 8), ch = id % (DK / 8); const size_t grow = (size_t)(rbase + tlo + (dir ? 63 - i : i)) * PITCH;
                *(LAS u32x4*)(Lq + i * DK + 8 * ch) = *(const u32x4*)(P + grow + qoff + 8 * ch);
                *(LAS u32x4*)(Lk + i * DK + 8 * ch) = *(const u32x4*)(P + grow + koff + 8 * ch);
                if (!RET) *(LAS u32x4*)(Lg + i * DK + 8 * ch) = *(const u32x4*)(P + grow + goff + 8 * ch);
            }
            for (int id = tid; id < 64 * DVS / 8; id += NTHREADS) {
                const int i = id / (DVS / 8), ch = id % (DVS / 8); const size_t grow = (size_t)(rbase + tlo + (dir ? 63 - i : i)) * PITCH;
                *(LAS u32x4*)(Lv + i * DVS + 8 * ch) = *(const u32x4*)(P + grow + voff + 8 * ch);
            }
            __syncthreads();
            const bool wr_out = ctx_out || !isctx;
            for (int i = 0; i < 64; ++i) {
                const float vv = bf2f(Lv[i * DVS + v]);
                float part = 0.f;
#pragma unroll
                for (int d8 = 0; d8 < 4; ++d8) {
                    const u32x4 qq = *(const LAS u32x4*)(Lq + i * DK + kg * 32 + 8 * d8), kk = *(const LAS u32x4*)(Lk + i * DK + kg * 32 + 8 * d8);
                    u32x4 gg = (u32x4){0u, 0u, 0u, 0u};
                    if (!RET) gg = *(const LAS u32x4*)(Lg + i * DK + kg * 32 + 8 * d8);
                    const unsigned qa[4] = {qq.x, qq.y, qq.z, qq.w}, ka[4] = {kk.x, kk.y, kk.z, kk.w}, ga[4] = {gg.x, gg.y, gg.z, gg.w};
#pragma unroll
                    for (int e = 0; e < 4; ++e) {
                        const float d0 = RET ? gam : __expf(bf_lo(ga[e])), d1 = RET ? gam : __expf(bf_hi(ga[e]));
                        float& s0 = S[8 * d8 + 2 * e]; float& s1 = S[8 * d8 + 2 * e + 1];
                        s0 = d0 * s0 + bf_lo(ka[e]) * vv; s1 = d1 * s1 + bf_hi(ka[e]) * vv;
                        part += s0 * bf_lo(qa[e]) + s1 * bf_hi(qa[e]);
                    }
                }
                Lp[((i & 1) * NKG + kg) * DVS + v] = part;
                __syncthreads();
                if (kg == 0 && wr_out) {
                    float o = 0.f;
#pragma unroll
                    for (int g2 = 0; g2 < NKG; ++g2) o += Lp[((i & 1) * NKG + g2) * DVS + v];
                    O[(size_t)(rbase + tlo + (dir ? 63 - i : i)) * HD + ooff + v] = f2bf(o);
                }
            }
            __syncthreads();
        }
    }
}

constexpr int NPHASES = 20;
template <class Epi>
DI void run_gemm(LAS unsigned char* lds, const bf16_t* Aop, const bf16_t* Bt, int M, int N, int K, int pmg, size_t bgs, const Epi& E) {
    pg8::Gemm g{Aop, Bt, M, N, K, pmg, bgs};
    pg8::StaticOrder S; S.init(M, N, (int)gridDim.x, (int)blockIdx.x);
    pg8::gemm_phase<Epi, pg8::StaticOrder, false>((PG8_LAS unsigned char*)lds, g, S, E, nullptr);
}

__global__ void __launch_bounds__(NTHREADS, 2) mk_fwd(Args A) {
    extern __shared__ __attribute__((aligned(16))) unsigned char lds_raw[];
    LAS unsigned char* lds = (LAS unsigned char*)lds_raw;
    unsigned char* ws = A.ws;
    const int lo = A.ph_lo, hi = A.ph_hi;
    XcdBarrier bar; bar.bar = (unsigned*)(ws + WS_BAR); bar.x = 0; bar.st = nullptr;
    if (hi - lo > 1) {
        volatile LAS unsigned* st = (volatile LAS unsigned*)(lds + MISC_OFF);
        if (threadIdx.x == 0) { st[0] = 0u; st[1] = 0u; st[2] = 0u; st[3] = 0u; }
        __syncthreads();
        bar = xcd_barrier_post((unsigned*)(ws + WS_BAR), st);
    }
#ifdef ONLY_PHASE
#define IN(k) ((k) == ONLY_PHASE && lo <= (k) && (k) < hi)
#else
#define IN(k) (lo <= (k) && (k) < hi)
#endif
#define SEAM(k) do { if (IN(k) && IN((k) + 1)) xcd_barrier(bar); } while (0)
    const float* MOD0 = (const float*)(ws + WS_MOD); const float* MOD1 = MOD0 + 9 * 6144;
    float* X = (float*)(ws + WS_X); bf16_t* H = (bf16_t*)(ws + WS_H); bf16_t* PROJ = (bf16_t*)(ws + WS_R1); bf16_t* A2 = (bf16_t*)(ws + WS_A2);
    bf16_t* XE = (bf16_t*)(ws + WS_R2); bf16_t* Y = (bf16_t*)(ws + WS_R2 + R2_HALF); bf16_t* ACT = (bf16_t*)(ws + WS_R1);

    if (IN(0)) p0_prologue(A, lds);
    SEAM(0);
    if (IN(1)) row_phase<0>(A, lds, NTOK, A.in[I_X], A.in[I_CTX], A.in[I_NMIX], MOD0, 0, 1024, nullptr, 0, nullptr);
    SEAM(1);
    if (IN(2)) { EpiRetIn E{PROJ, (const f32x2*)(ws + WS_ROPE), (const f32x2*)(ws + WS_ROPE) + 2048}; run_gemm(lds, H, (const bf16_t*)(ws + WS_WRI), NTOK, RET_IN, 1024, 1 << 20, 0, E); }
    SEAM(2);
    if (IN(3)) scan_naive_phase<true>(A, lds, true);
    SEAM(3);
    if (IN(4)) readout_phase<true>(A, NTOK);
    SEAM(4);
    if (IN(5)) { EpiResid E{A.in[I_X], A.in[I_CTX], X, MOD0, 2048}; run_gemm(lds, A2, (const bf16_t*)(ws + WS_WRO), NTOK, 1024, 2048, 1 << 20, 0, E); }
    SEAM(5);
    if (IN(6)) row_phase<2>(A, lds, NTOK, X, X + (size_t)NLAT * D, A.in[I_NFFN], MOD0, 3 * 1024, 4 * 1024, nullptr, 0, A.in[I_ROUTER]);
    SEAM(6);
    if (IN(7)) topk_phase(A, lds, 256, MPER0);
    SEAM(7);
    if (IN(8)) { EpiMoe1 E{ACT}; run_gemm(lds, XE, (const bf16_t*)(ws + WS_WM1), NE * MPER0, N1, 1024, MPER0 / 256, (size_t)N1 * 1024 * 2, E); }
    SEAM(8);
    if (IN(9)) { EpiPlainBf16 E{Y, 1024}; run_gemm(lds, ACT, (const bf16_t*)(ws + WS_WM2), NE * MPER0, 1024, FF, MPER0 / 256, (size_t)1024 * FF * 2, E); }
    SEAM(9);
    if (IN(10)) row_phase<1>(A, lds, NTOK, X, X + (size_t)NLAT * D, A.in[I_NMIX] + 1024, MOD1, 0, 1024, MOD0, MPER0, nullptr);
    SEAM(10);
    if (IN(11)) { EpiHgIn E{PROJ, (const float*)(ws + WS_LB)}; run_gemm(lds, H, (const bf16_t*)(ws + WS_WHI), NTOK, HG_IN, 1024, 1 << 20, 0, E); }
    SEAM(11);
    if (IN(12)) scan_naive_phase<false>(A, lds, false);
    SEAM(12);
    if (IN(13)) readout_phase<false>(A, NLAT);
    SEAM(13);
    if (IN(14)) { EpiResid E{X, X + (size_t)NLAT * D, X, MOD1, 2048}; run_gemm(lds, A2, (const bf16_t*)(ws + WS_WHO), NLAT, 1024, 1024, 1 << 20, 0, E); }
    SEAM(14);
    if (IN(15)) row_phase<2>(A, lds, NLAT, X, X + (size_t)NLAT * D, A.in[I_NFFN] + 1024, MOD1, 3 * 1024, 4 * 1024, nullptr, 0, A.in[I_ROUTER] + 1024 * 16);
    SEAM(15);
    if (IN(16)) topk_phase(A, lds, 128, MPER1);
    SEAM(16);
    if (IN(17)) { EpiMoe1 E{ACT}; run_gemm(lds, XE, (const bf16_t*)(ws + WS_WM1) + (size_t)16 * N1 * 1024, NE * MPER1, N1, 1024, MPER1 / 256, (size_t)N1 * 1024 * 2, E); }
    SEAM(17);
    if (IN(18)) { EpiPlainBf16 E{Y, 1024}; run_gemm(lds, ACT, (const bf16_t*)(ws + WS_WM2) + (size_t)16 * 1024 * FF, NE * MPER1, 1024, FF, MPER1 / 256, (size_t)1024 * FF * 2, E); }
    SEAM(18);
    if (IN(19)) row_phase<5>(A, lds, NLAT, X, X + (size_t)NLAT * D, A.in[I_NFIN], nullptr, 0, 0, MOD1, MPER1, nullptr);
#undef IN
#undef SEAM
}

extern "C" void kernel_launch(void* const* d_in, const int* in_sizes, int n_in, void* d_out, int out_size, void* d_ws, size_t ws_size, hipStream_t stream) {
    static int grid = 0;
    if (grid == 0) {
        if (n_in != 19 || out_size != NLAT * D || ws_size < WS_END) { fprintf(stderr, "kernel_launch: unexpected shapes (n_in %d, out %d, ws %zu < %zu)\n", n_in, out_size, ws_size, (size_t)WS_END); grid = -1; return; }
        int dev = 0, cus = 0, per_cu = 0;
        if (hipGetDevice(&dev) != hipSuccess || hipDeviceGetAttribute(&cus, hipDeviceAttributeMultiprocessorCount, dev) != hipSuccess) { grid = -1; return; }
        if (hipFuncSetAttribute((const void*)mk_fwd, hipFuncAttributeMaxDynamicSharedMemorySize, LDS_BYTES) != hipSuccess) { fprintf(stderr, "kernel_launch: hipFuncSetAttribute failed\n"); grid = -1; return; }
        if (hipOccupancyMaxActiveBlocksPerMultiprocessor(&per_cu, (const void*)mk_fwd, NTHREADS, LDS_BYTES) != hipSuccess || per_cu < 1) { fprintf(stderr, "kernel_launch: occupancy query says %d\n", per_cu); }
        (void)hipGetLastError();
        grid = cus;
    }
    if (grid < 0) return;
    (void)hipMemsetAsync((char*)d_ws + WS_BAR, 0, 16384, stream);
    Args a{};
    for (int i = 0; i < 19; ++i) a.in[i] = (const float*)d_in[i];
    a.out = (float*)d_out; a.ws = (unsigned char*)d_ws;
#if MK_PER_PHASE
    for (int p = 0; p < NPHASES; ++p) { a.ph_lo = p; a.ph_hi = p + 1; hipLaunchKernelGGL(mk_fwd, dim3(grid), dim3(NTHREADS), LDS_BYTES, stream, a); }
#else
    a.ph_lo = 0; a.ph_hi = NPHASES;
    hipLaunchKernelGGL(mk_fwd, dim3(grid), dim3(NTHREADS), LDS_BYTES, stream, a);
#endif
}
```

```cpp
#include <hip/hip_runtime.h>
#include <cstdio>
#include <cstdint>
#ifndef MK_PER_PHASE
#define MK_PER_PHASE 0
#endif
namespace pg8 {
#define PG8_LAS __attribute__((address_space(3)))
typedef unsigned short bf16_t;
typedef short bf16x8 __attribute__((ext_vector_type(8)));
typedef float f32x4 __attribute__((ext_vector_type(4)));
typedef unsigned u32x4 __attribute__((ext_vector_type(4)));
constexpr int BM = 256, BK = 64, HALF = 128, HTB = HALF * BK * 2  , STAGE_BYTES = 8 * HTB, NXCD = 8, WGM = 8;

__host__ __device__ __forceinline__ int lds_byte(int r, int c) { const int st = (r >> 4) * 2 + (c >> 5), rr = r & 15, cc = c & 31, ob = rr * 64 + cc * 2; return st * 1024 + (ob ^ (((ob >> 9) & 1) << 5)); }
__host__ __device__ __forceinline__ void stage_rc(int b, int& R, int& C) { const int st = b / 1024, sb = b % 1024, swz = sb ^ (((sb >> 9) & 1) << 5); R = (st >> 1) * 16 + swz / 64; C = (st & 1) * 32 + (swz % 64) / 2; }
__host__ __device__ __forceinline__ int perm32(int rho) { const int n = rho >> 4, i = rho & 15; return 8 * (i >> 2) + 4 * n + (i & 3); }

struct Unit { int pm, pn; };
struct Gemm { const bf16_t* A; const bf16_t* Bt; int M, N, K; int pmg; size_t bgs; };

struct StaticOrder {
    int ib = 0, ie = 1 << 30;
    int nM, nN, nwg, G, c, wgm;
    __host__ __device__ void init(int M, int N, int G_, int c_, int wgm_ = WGM) { nM = M / BM; nN = N / BM; nwg = nM * nN; G = G_; c = c_; wgm = wgm_; }
    __host__ __device__ bool next(int i, Unit& u) const {
        const long ii = (long)i + ib; if (ii >= ie) return false;
        const long L = ii * G + c; if (L >= nwg) return false;
        int wgid = (int)L; { const int q = nwg / NXCD, r = nwg % NXCD, xcd = wgid % NXCD, off = wgid / NXCD; wgid = (xcd < r ? xcd * (q + 1) : r * (q + 1) + (xcd - r) * q) + off; }
        const int nig = wgm * nN, gid = wgid / nig, fm = gid * wgm, gsz = (nM - fm) < wgm ? (nM - fm) : wgm;
        u.pm = fm + ((wgid % nig) % gsz); u.pn = (wgid % nig) / gsz; return true;
    }
    __device__ __forceinline__ void a_ready(const Unit&) const {}
    __device__ __forceinline__ void done(const Unit&) const {}
};
__device__ __forceinline__ unsigned cvt_pk_bf16(float lo, float hi) { unsigned r; asm volatile("v_cvt_pk_bf16_f32 %0, %1, %2" : "=v"(r) : "v"(lo), "v"(hi)); return r; }

template <class Epi, class Sched, bool STAMP = false, bool F8 = false>
__device__ __forceinline__ void gemm_phase(PG8_LAS unsigned char* lds, const Gemm g, const Sched& S, const Epi& E, unsigned long long* stamps) {
    const int tid = threadIdx.x, wid = __builtin_amdgcn_readfirstlane(tid >> 6), lane = tid & 63, wr = wid >> 2, wc = wid & 3, fr = lane & 15, fq = lane >> 4;
    int K_ = g.K; if constexpr (F8) { asm volatile("" : "+s"(K_)); }
    const int K = K_, nt = K / BK;
    const int f8_scale_w = 0x79797979, f8_scale_a = 0x7f7f7f7f;
    int ts_lo = 0, ts_hi = 0, nts = 0; const unsigned long long rt_entry = STAMP ? (unsigned long long)wall_clock64() : 0ull;
#define PG8_STAMP() do { if (STAMP && wid == 0 && nts < 64) { const unsigned long long _c = (unsigned long long)clock64(); \
        ts_lo = (lane == nts) ? (int)(unsigned)_c : ts_lo; ts_hi = (lane == nts) ? (int)(unsigned)(_c >> 32) : ts_hi; ++nts; } } while (0)
    PG8_STAMP();
    unsigned voffA[2], voffB[2];
#pragma unroll
    for (int i = 0; i < 2; ++i) { int R, C; stage_rc(tid * 16 + i * 8192, R, C); const int Rb = Epi::PERM ? ((R & ~31) + perm32(R & 31)) : R;
        voffA[i] = (unsigned)(R * K + C) * 2u; voffB[i] = (unsigned)(Rb * K + C) * 2u; }
    const size_t kstep = (size_t)(BK * 2);
    const size_t hstep = (size_t)HALF * K * 2;
    const size_t tstep = 2 * hstep;
    const unsigned ldsw = (unsigned)wid * 1024u;
    const int aoff = lds_byte(wr * 64 + fr, fq * 8), boff = lds_byte(wc * 32 + fr, fq * 8);
#define PG8_SA(b, h) (((b) * 2 + (h)) * HTB)
#define PG8_SB(b, h) ((4 + (b) * 2 + (h)) * HTB)
#define PG8_STAGE(bufoff, gbase, voff) do { _Pragma("unroll") for (int _i = 0; _i < 2; ++_i) \
        __builtin_amdgcn_global_load_lds((const unsigned*)((const char*)(gbase) + (voff)[_i]), (PG8_LAS unsigned*)(lds + (bufoff) + ldsw + _i * 8192), 16, 0, 0); } while (0)
#define PG8_LDA(dst, b, h) do { _Pragma("unroll") for (int m = 0; m < 4; ++m) { const bf16x8 lo_ = *(const PG8_LAS bf16x8*)(lds + PG8_SA(b, h) + aoff + m * 2048), hi_ = *(const PG8_LAS bf16x8*)(lds + PG8_SA(b, h) + aoff + m * 2048 + 1024); \
        dst[m] = __builtin_shufflevector(lo_, hi_, 0, 1, 2, 3, 4, 5, 6, 7, 8, 9, 10, 11, 12, 13, 14, 15); } } while (0)
#define PG8_LDB(dst, b, h) do { _Pragma("unroll") for (int n = 0; n < 2; ++n) { const bf16x8 lo_ = *(const PG8_LAS bf16x8*)(lds + PG8_SB(b, h) + boff + n * 2048), hi_ = *(const PG8_LAS bf16x8*)(lds + PG8_SB(b, h) + boff + n * 2048 + 1024); \
        dst[n] = __builtin_shufflevector(lo_, hi_, 0, 1, 2, 3, 4, 5, 6, 7, 8, 9, 10, 11, 12, 13, 14, 15); } } while (0)
#define PG8_MMA(ai, bj, At, Bt) do { __builtin_amdgcn_s_setprio(1); _Pragma("unroll") for (int m = 0; m < 4; ++m) _Pragma("unroll") for (int n = 0; n < 2; ++n) { \
        if constexpr (F8) { asm volatile("v_mfma_scale_f32_16x16x128_f8f6f4 %0, %1, %2, %0, %3, %4 op_sel_hi:[0,0,0]" : "+v"(acc[ai][bj][m][n]) : "v"(__builtin_bit_cast(i32x8_, Bt[n])), "v"(__builtin_bit_cast(i32x8_, At[m])), "v"(f8_scale_w), "v"(f8_scale_a)); } \
        else { acc[ai][bj][m][n] = __builtin_amdgcn_mfma_f32_16x16x32_bf16(__builtin_shufflevector(Bt[n], Bt[n], 0, 1, 2, 3, 4, 5, 6, 7), __builtin_shufflevector(At[m], At[m], 0, 1, 2, 3, 4, 5, 6, 7), acc[ai][bj][m][n], 0, 0, 0); \
               acc[ai][bj][m][n] = __builtin_amdgcn_mfma_f32_16x16x32_bf16(__builtin_shufflevector(Bt[n], Bt[n], 8, 9, 10, 11, 12, 13, 14, 15), __builtin_shufflevector(At[m], At[m], 8, 9, 10, 11, 12, 13, 14, 15), acc[ai][bj][m][n], 0, 0, 0); } } \
        __builtin_amdgcn_s_setprio(0); } while (0)
#define PG8_WAIT_V(n) asm volatile("s_waitcnt vmcnt(" #n ")" ::: "memory")
#define PG8_WAIT_L(n) asm volatile("s_waitcnt lgkmcnt(" #n ")" ::: "memory")
#define PG8_BAR __builtin_amdgcn_s_barrier()
#define PG8_SCHED __builtin_amdgcn_sched_barrier(0)
    Unit cur, nxt; int ui = 0;
    if (!S.next(0, cur)) return;
    f32x4 acc[2][2][4][2];
#pragma unroll
    for (int a = 0; a < 2; ++a)
#pragma unroll
        for (int b = 0; b < 2; ++b)
#pragma unroll
            for (int m = 0; m < 4; ++m)
#pragma unroll
                for (int n = 0; n < 2; ++n) acc[a][b][m][n] = (f32x4){0.f, 0.f, 0.f, 0.f};
    typedef short s16x16_ __attribute__((ext_vector_type(16))); typedef int i32x8_ __attribute__((ext_vector_type(8)));
    s16x16_ At[4], B0[2], B1[2];
    const char* cA = (const char*)g.A + (size_t)cur.pm * tstep; const char* cB = (const char*)g.Bt + (size_t)(cur.pm / g.pmg) * g.bgs + (size_t)cur.pn * tstep;
    S.a_ready(cur);
    PG8_STAGE(PG8_SB(0, 0), cB, voffB); PG8_STAGE(PG8_SA(0, 0), cA, voffA); PG8_STAGE(PG8_SB(0, 1), cB + hstep, voffB); PG8_STAGE(PG8_SA(0, 1), cA + hstep, voffA);
    if (wr == 1) PG8_BAR;
    PG8_WAIT_V(4); PG8_BAR;
    PG8_STAGE(PG8_SB(1, 0), cB + kstep, voffB); PG8_STAGE(PG8_SA(1, 0), cA + kstep, voffA); PG8_STAGE(PG8_SB(1, 1), cB + hstep + kstep, voffB);
    PG8_WAIT_V(6); PG8_BAR;
    PG8_STAMP();
    for (;;) {
        const bool has_next = S.next(ui + 1, nxt);
        const char* nA = has_next ? (const char*)g.A + (size_t)nxt.pm * tstep : cA; const char* nB = has_next ? (const char*)g.Bt + (size_t)(nxt.pm / g.pmg) * g.bgs + (size_t)nxt.pn * tstep : cB;
        for (int t = 0; t < nt; t += 2) {
            const bool last = (t == nt - 2);
            const char* a1 = cA + (size_t)(t + 1) * kstep;
            const char* a2 = last ? nA : cA + (size_t)(t + 2) * kstep; const char* b2 = last ? nB : cB + (size_t)(t + 2) * kstep;
            const char* a3 = a2 + kstep; const char* b3 = b2 + kstep;
            if (last && has_next) S.a_ready(nxt);
            PG8_LDB(B0, 0, 0); PG8_SCHED; PG8_LDA(At, 0, 0); PG8_STAGE(PG8_SA(1, 1), a1 + hstep, voffA);
            PG8_WAIT_L(8); PG8_BAR; PG8_WAIT_L(0); PG8_MMA(0, 0, At, B0); PG8_BAR; PG8_SCHED;
            PG8_LDB(B1, 0, 1); PG8_STAGE(PG8_SB(0, 0), b2, voffB);
            PG8_BAR; PG8_WAIT_L(0); PG8_MMA(0, 1, At, B1); PG8_BAR;
            PG8_LDA(At, 0, 1); PG8_STAGE(PG8_SA(0, 0), a2, voffA);
            PG8_BAR; PG8_WAIT_L(0); PG8_MMA(1, 0, At, B0); PG8_BAR; PG8_SCHED;
            PG8_STAGE(PG8_SB(0, 1), b2 + hstep, voffB);
            PG8_WAIT_V(6); PG8_BAR; PG8_MMA(1, 1, At, B1); PG8_BAR;
            PG8_LDB(B0, 1, 0); PG8_SCHED; PG8_LDA(At, 1, 0); PG8_STAGE(PG8_SA(0, 1), a2 + hstep, voffA);
            PG8_WAIT_L(8); PG8_BAR; PG8_WAIT_L(0); PG8_MMA(0, 0, At, B0); PG8_BAR; PG8_SCHED;
            PG8_LDB(B1, 1, 1); PG8_STAGE(PG8_SB(1, 0), b3, voffB);
            PG8_BAR; PG8_WAIT_L(0); PG8_MMA(0, 1, At, B1); PG8_BAR;
            PG8_LDA(At, 1, 1); PG8_STAGE(PG8_SA(1, 0), a3, voffA);
            PG8_BAR; PG8_WAIT_L(0); PG8_MMA(1, 0, At, B0); PG8_BAR; PG8_SCHED;
            PG8_STAGE(PG8_SB(1, 1), b3 + hstep, voffB);
            PG8_WAIT_V(6); PG8_BAR; PG8_MMA(1, 1, At, B1); PG8_BAR;
        }
        PG8_STAMP();
        if constexpr (!Epi::AFTER_DRAIN) { E(acc, cur, wr, wc, fr, fq); S.done(cur); }
        PG8_STAMP();
        if (!has_next) break;
#pragma unroll
        for (int a = 0; a < 2; ++a)
#pragma unroll
            for (int b = 0; b < 2; ++b)
#pragma unroll
                for (int m = 0; m < 4; ++m)
#pragma unroll
                    for (int n = 0; n < 2; ++n) acc[a][b][m][n] = (f32x4){0.f, 0.f, 0.f, 0.f};
        cur = nxt; cA = nA; cB = nB; ++ui;
    }
    PG8_WAIT_V(0);
    if (wr == 0) PG8_BAR;
    PG8_BAR;
    if constexpr (Epi::AFTER_DRAIN) { E.fused(acc, cur, wr, wc, fr, fq, lds, wid, lane); S.done(cur); }
    PG8_STAMP();
    if (STAMP && wid == 0) { stamps[lane] = lane < nts ? (((unsigned long long)(unsigned)ts_hi << 32) | (unsigned)ts_lo) : 0ull;
        if (lane == 62) stamps[62] = rt_entry; if (lane == 63) stamps[63] = (unsigned long long)wall_clock64(); }
#undef PG8_STAMP
#undef PG8_SA
#undef PG8_SB
#undef PG8_STAGE
#undef PG8_LDA
#undef PG8_LDB
#undef PG8_MMA
#undef PG8_WAIT_V
#undef PG8_WAIT_L
#undef PG8_BAR
#undef PG8_SCHED
}
}
#define XB_TMO      128
#define XB_XCNT(j)  (256  + 64 * (j))
#define XB_XSUB(j)  (1280 + 64 * (j))
#define XB_XGEN(j)  (2304 + 64 * (j))
#define XB_TOP      3328
#define XB_TOPGEN   3392
#define XCD_BAR_WORDS 3456
#define XB_SPIN_CAP (1u << 18)
#define LAS __attribute__((address_space(3)))

__device__ __forceinline__ unsigned xb_ld(unsigned* p)              { return __hip_atomic_load(p, __ATOMIC_RELAXED, __HIP_MEMORY_SCOPE_AGENT); }
__device__ __forceinline__ unsigned xb_add(unsigned* p, unsigned v) { return __hip_atomic_fetch_add(p, v, __ATOMIC_RELAXED, __HIP_MEMORY_SCOPE_AGENT); }
__device__ __forceinline__ unsigned xb_xcc_id() { return (unsigned)__builtin_amdgcn_s_getreg((3 << 11) | 20) & 0xFu; }
#define XB_SPIN(cond, bar) do { unsigned _sp = 0; while (cond) { __builtin_amdgcn_s_sleep(1); \
    if ((++_sp & 255u) == 0u) { if (xb_ld(&(bar)[XB_TMO])) break; if (_sp > XB_SPIN_CAP) { atomicAdd(&(bar)[XB_TMO], 1u); break; } } } } while (0)

struct XcdBarrier {
    unsigned* bar; unsigned x;
    volatile LAS unsigned* st;
};

__device__ __forceinline__ XcdBarrier xcd_barrier_post(unsigned* bar, volatile LAS unsigned* st) {
    XcdBarrier b; b.bar = bar; b.x = xb_xcc_id(); b.st = st;
    if (threadIdx.x == 0) (void)xb_add(&bar[XB_XCNT(b.x)], 1u);
    return b;
}
__device__ __forceinline__ void xcd_barrier_complete(unsigned* bar, unsigned x, unsigned& nloc, unsigned& nx) {
    const unsigned G = gridDim.x * gridDim.y * gridDim.z;
    unsigned sum, cnt, mine, sp = 0u;
    for (;;) {
        sum = 0u; cnt = 0u; mine = 0u;
#pragma unroll
        for (unsigned j = 0; j < 16; ++j) { const unsigned c = xb_ld(&bar[XB_XCNT(j)]); sum += c; cnt += (c > 0u) ? 1u : 0u; mine = (j == x) ? c : mine; }
        if (sum == G) break;
        __builtin_amdgcn_s_sleep(1);
        if ((++sp & 255u) == 0u) { if (xb_ld(&bar[XB_TMO])) break; if (sp > XB_SPIN_CAP) { atomicAdd(&bar[XB_TMO], 1u); break; } }
    }
    nloc = mine > 0u ? mine : 1u; nx = cnt > 0u ? cnt : 1u;
}

__device__ __forceinline__ void xcd_barrier(const XcdBarrier& b) {
    asm volatile("s_waitcnt vmcnt(0)" ::: "memory");
    __syncthreads();
    if (threadIdx.x == 0) {
        unsigned* bar = b.bar;
        __builtin_amdgcn_s_waitcnt(0);
        unsigned nloc = b.st[0], nx = b.st[1];
        if (nloc == 0u) { xcd_barrier_complete(bar, b.x, nloc, nx); b.st[0] = nloc; b.st[1] = nx; }
        const unsigned old = xb_add(&bar[XB_XSUB(b.x)], 1u);
        const unsigned gen = old / nloc;
        if (old + 1u == (gen + 1u) * nloc) {
            __builtin_amdgcn_fence(__ATOMIC_RELEASE, "agent");
            asm volatile("s_waitcnt vmcnt(0)" ::: "memory");
            const unsigned og = xb_add(&bar[XB_TOP], 1u);
            const unsigned tg = og / nx;
            if (og + 1u == (tg + 1u) * nx) xb_add(&bar[XB_TOPGEN], 1u);
            else XB_SPIN(xb_ld(&bar[XB_TOPGEN]) == tg, bar);
            __builtin_amdgcn_fence(__ATOMIC_ACQUIRE, "agent");
            xb_add(&bar[XB_XGEN(b.x)], 1u);
            asm volatile("s_waitcnt vmcnt(0)" ::: "memory");
        } else {
            XB_SPIN(xb_ld(&bar[XB_XGEN(b.x)]) == gen, bar);
            __builtin_amdgcn_fence(__ATOMIC_ACQUIRE, "agent");
            asm volatile("s_waitcnt vmcnt(0)" ::: "memory");
        }
    }
    __syncthreads();
}


typedef unsigned short bf16_t;
typedef float f32x4 __attribute__((ext_vector_type(4)));
typedef float f32x2 __attribute__((ext_vector_type(2)));
typedef unsigned u32x4 __attribute__((ext_vector_type(4)));
typedef unsigned u32x2 __attribute__((ext_vector_type(2)));
typedef __bf16 bf16x2_t __attribute__((ext_vector_type(2)));
#define DI __device__ __forceinline__

constexpr int D = 1024, NB = 8, SEQ = 2048, CTXL = 256;
constexpr int NLAT = NB * SEQ, NCTX = NB * CTXL, NTOK = NLAT + NCTX;
constexpr int RET_IN = 6144, HG_IN = 5120, HG_PITCH = 7168;
constexpr int NE = 16, FF = 2816, N1 = 2 * FF;
constexpr int MPER0 = 2304, MPER1 = 2048;
constexpr float EPS = 1e-6f;
constexpr int NTHREADS = 512;
constexpr int LDS_BYTES = 131072 + 256;
constexpr int MISC_OFF = 131072;

constexpr size_t al256(size_t x) { return (x + 255) & ~(size_t)255; }
constexpr size_t WS_BAR  = 0;
constexpr size_t WS_MOD  = 16384;
constexpr size_t WS_ROPE = WS_MOD + al256(2 * 9 * 6144 * 4);
constexpr size_t WS_LB   = WS_ROPE + al256((32 * 64 + 64 * 64) * 8);
constexpr size_t WS_AFF  = WS_LB + al256(2 * 1024 * 4);
constexpr size_t WS_SLOT = WS_AFF + al256((size_t)NTOK * 16 * 4);
constexpr size_t WS_WRI  = WS_SLOT + al256((size_t)NTOK * 16 * 4);
constexpr size_t WS_WRO  = WS_WRI + al256((size_t)6144 * 1024 * 2);
constexpr size_t WS_WHI  = WS_WRO + al256((size_t)1024 * 2048 * 2);
constexpr size_t WS_WHO  = WS_WHI + al256((size_t)5120 * 1024 * 2);
constexpr size_t WS_WM1  = WS_WHO + al256((size_t)1024 * 1024 * 2);
constexpr size_t WS_WM2  = WS_WM1 + al256((size_t)32 * N1 * 1024 * 2);
constexpr size_t WS_X    = WS_WM2 + al256((size_t)32 * 1024 * FF * 2);
constexpr size_t WS_H    = WS_X + al256((size_t)NTOK * 1024 * 4);
constexpr size_t WS_R1   = WS_H + al256((size_t)NTOK * 1024 * 2);
constexpr size_t WS_R2   = WS_R1 + al256((size_t)NTOK * HG_PITCH * 2);
constexpr size_t WS_A2   = WS_R2 + al256((size_t)NTOK * 2048 * 2 * 2);
constexpr size_t WS_END  = WS_A2 + al256((size_t)NTOK * 2048 * 2);
constexpr size_t R2_HALF = (size_t)NTOK * 2048 * 2;

struct Args { const float* in[19]; float* out; unsigned char* ws; int ph_lo, ph_hi; };
enum { I_X = 0, I_C, I_CTX, I_CCTX, I_WADA, I_BADA, I_NMIX, I_NFFN, I_RWIN, I_RWOUT, I_HWIN, I_HGN, I_HLB, I_HWOUT, I_ROUTER, I_WG, I_WU, I_WD, I_NFIN };

DI unsigned pk_bf16(float lo, float hi) { f32x2 v = {lo, hi}; bf16x2_t b = __builtin_convertvector(v, bf16x2_t); return __builtin_bit_cast(unsigned, b); }
DI unsigned pk4_fp8(float a, float b, float c, float d) { int p = __builtin_amdgcn_cvt_pk_fp8_f32(a, b, 0, false); p = __builtin_amdgcn_cvt_pk_fp8_f32(c, d, p, true); return (unsigned)p; }
DI float bf_lo(unsigned u) { return __uint_as_float(u << 16); }
DI float bf_hi(unsigned u) { return __uint_as_float(u & 0xffff0000u); }
DI float bf2f(bf16_t h) { return __uint_as_float(((unsigned)h) << 16); }
DI bf16_t f2bf(float f) { return (bf16_t)(pk_bf16(f, 0.f) & 0xffffu); }
DI float fast_sigmoid(float x) { return __builtin_amdgcn_rcpf(1.0f + __expf(-x)); }
DI float silu_f(float x) { return x * fast_sigmoid(x); }
DI float wave_sum(float v) {
#pragma unroll
    for (int o = 32; o >= 1; o >>= 1) v += __shfl_xor(v, o);
    return v;
}
DI int mod_row(int row) { return row < NLAT ? (row >> 11) : 8; }

struct EpiRetIn {
    static constexpr bool PERM = true, AFTER_DRAIN = false;
    bf16_t* O; const f32x2* ropeR; const f32x2* ropeC;
    DI void operator()(const f32x4 (&acc)[2][2][4][2], const pg8::Unit& u, int wr, int wc, int fr, int fq) const {
        const int row0 = u.pm * 256 + wr * 64 + fr, col0 = u.pn * 256 + wc * 32 + 8 * fq;
        const bool rot = (u.pn < 8) && (u.pm < 64);
#pragma unroll
        for (int ai = 0; ai < 2; ++ai)
#pragma unroll
            for (int m = 0; m < 4; ++m) {
                const int row = row0 + ai * 128 + m * 16; bf16_t* rowp = O + (size_t)row * RET_IN + col0;
                const int t = row & 2047;
#pragma unroll
                for (int bj = 0; bj < 2; ++bj) {
                    f32x4 v0 = acc[ai][bj][m][0], v1 = acc[ai][bj][m][1];
                    if (rot) {
                        const f32x2* tb = bj ? (ropeC + (size_t)(t & 63) * 64) : (ropeR + (size_t)(t >> 6) * 64);
                        const int i0 = 16 * wc + 4 * fq;
                        const f32x4 cs0 = *(const f32x4*)(tb + i0), cs1 = *(const f32x4*)(tb + i0 + 2);
                        f32x4 o0, o1;
                        o0[0] = v0[0] * cs0[0] - v0[1] * cs0[1]; o0[1] = v0[0] * cs0[1] + v0[1] * cs0[0];
                        o0[2] = v0[2] * cs0[2] - v0[3] * cs0[3]; o0[3] = v0[2] * cs0[3] + v0[3] * cs0[2];
                        o1[0] = v1[0] * cs1[0] - v1[1] * cs1[1]; o1[1] = v1[0] * cs1[1] + v1[1] * cs1[0];
                        o1[2] = v1[2] * cs1[2] - v1[3] * cs1[3]; o1[3] = v1[2] * cs1[3] + v1[3] * cs1[2];
                        v0 = o0; v1 = o1;
                    }
                    u32x4 w; w.x = pk_bf16(v0[0], v0[1]); w.y = pk_bf16(v0[2], v0[3]); w.z = pk_bf16(v1[0], v1[1]); w.w = pk_bf16(v1[2], v1[3]);
                    *(u32x4*)(rowp + bj * 128) = w;
                }
            }
    }
};
struct EpiHgIn {
    static constexpr bool PERM = true, AFTER_DRAIN = false;
    bf16_t* O; const float* lb; int pn_off;
    DI void operator()(const f32x4 (&acc)[2][2][4][2], const pg8::Unit& u, int wr, int wc, int fr, int fq) const {
        const int pn = u.pn + pn_off;
        const int row0 = u.pm * 256 + wr * 64 + fr, col0 = pn * 256 + wc * 32 + 8 * fq;
        const int region = pn >> 2;
        f32x4 lbv[2][2];
        if (region == 1 || region == 2) {
#pragma unroll
            for (int bj = 0; bj < 2; ++bj)
#pragma unroll
                for (int n = 0; n < 2; ++n) lbv[bj][n] = *(const f32x4*)(lb + (col0 - 1024) + bj * 128 + 4 * n);
        }
#pragma unroll
        for (int ai = 0; ai < 2; ++ai)
#pragma unroll
            for (int m = 0; m < 4; ++m) {
                const int row = row0 + ai * 128 + m * 16; bf16_t* rowp = O + (size_t)row * HG_PITCH + col0;
#pragma unroll
                for (int bj = 0; bj < 2; ++bj) {
                    f32x4 v0 = acc[ai][bj][m][0], v1 = acc[ai][bj][m][1];
                    if (region == 0) {
#pragma unroll
                        for (int j = 0; j < 4; ++j) { v0[j] = silu_f(v0[j]); v1[j] = silu_f(v1[j]); }
                    } else if (region == 1 || region == 2) {
                        f32x4 g0, g1;
#pragma unroll
                        for (int j = 0; j < 4; ++j) {
                            const float l0 = lbv[bj][0][j], l1 = lbv[bj][1][j];
                            const float s0 = fast_sigmoid(v0[j]), s1 = fast_sigmoid(v1[j]);
                            const float f0 = l0 + (1.f - l0) * s0, f1 = l1 + (1.f - l1) * s1;
                            g0[j] = __logf(f0); g1[j] = __logf(f1);
                            v0[j] = (1.f - l0) * (1.f - s0); v1[j] = (1.f - l1) * (1.f - s1);
                        }
                        u32x4 wg; wg.x = pk_bf16(g0[0], g0[1]); wg.y = pk_bf16(g0[2], g0[3]); wg.z = pk_bf16(g1[0], g1[1]); wg.w = pk_bf16(g1[2], g1[3]);
                        *(u32x4*)(rowp + 4096 + bj * 128) = wg;
                    }
                    u32x4 w; w.x = pk_bf16(v0[0], v0[1]); w.y = pk_bf16(v0[2], v0[3]); w.z = pk_bf16(v1[0], v1[1]); w.w = pk_bf16(v1[2], v1[3]);
                    *(u32x4*)(rowp + bj * 128) = w;
                }
            }
    }
};
template <bool SRC16>
struct EpiResidT {
    static constexpr bool PERM = false, AFTER_DRAIN = false;
    const float* src_lat; const float* src_ctx; bf16_t* X; const float* mod; int goff;
    DI void operator()(const f32x4 (&acc)[2][2][4][2], const pg8::Unit& u, int wr, int wc, int fr, int fq) const {
        const int row0 = u.pm * 256 + wr * 64 + fr, col0 = u.pn * 256 + wc * 32 + 4 * fq;
        const int mr = (u.pm < 64) ? (u.pm >> 3) : 8;
        f32x4 gv[2][2];
#pragma unroll
        for (int bj = 0; bj < 2; ++bj)
#pragma unroll
            for (int n = 0; n < 2; ++n) gv[bj][n] = *(const f32x4*)(mod + (size_t)mr * 6144 + goff + col0 + bj * 128 + n * 16);
#pragma unroll
        for (int ai = 0; ai < 2; ++ai)
#pragma unroll
            for (int m = 0; m < 4; ++m) {
                const int row = row0 + ai * 128 + m * 16;
                bf16_t* xp = X + (size_t)row * D + col0;
                if constexpr (SRC16) {
#pragma unroll
                    for (int bj = 0; bj < 2; ++bj)
#pragma unroll
                        for (int n = 0; n < 2; ++n) { const u32x2 t = *(const u32x2*)(xp + bj * 128 + n * 16); const f32x4 s = {bf_lo(t.x), bf_hi(t.x), bf_lo(t.y), bf_hi(t.y)};
                            const f32x4 v = s + gv[bj][n] * acc[ai][bj][m][n]; u32x2 o; o.x = pk_bf16(v[0], v[1]); o.y = pk_bf16(v[2], v[3]); *(u32x2*)(xp + bj * 128 + n * 16) = o; }
                } else {
                    const float* sp = (row < NLAT ? src_lat + (size_t)row * D : src_ctx + (size_t)(row - NLAT) * D) + col0;
#pragma unroll
                    for (int bj = 0; bj < 2; ++bj)
#pragma unroll
                        for (int n = 0; n < 2; ++n) { const f32x4 s = *(const f32x4*)(sp + bj * 128 + n * 16);
                            const f32x4 v = s + gv[bj][n] * acc[ai][bj][m][n]; u32x2 o; o.x = pk_bf16(v[0], v[1]); o.y = pk_bf16(v[2], v[3]); *(u32x2*)(xp + bj * 128 + n * 16) = o; }
                }
            }
    }
};
struct EpiMoe1 {
    static constexpr bool PERM = true, AFTER_DRAIN = false;
    unsigned char* O;
    DI void operator()(const f32x4 (&acc)[2][2][4][2], const pg8::Unit& u, int wr, int wc, int fr, int fq) const {
        const int row0 = u.pm * 256 + wr * 64 + fr, col0 = u.pn * 128 + wc * 32 + 8 * fq;
#pragma unroll
        for (int ai = 0; ai < 2; ++ai)
#pragma unroll
            for (int m = 0; m < 4; ++m) {
                unsigned char* rowp = O + (size_t)(row0 + ai * 128 + m * 16) * FF + col0;
                f32x4 a0 = acc[ai][0][m][0], a1 = acc[ai][0][m][1]; const f32x4 u0 = acc[ai][1][m][0], u1 = acc[ai][1][m][1];
#pragma unroll
                for (int j = 0; j < 4; ++j) { a0[j] = silu_f(a0[j]) * u0[j]; a1[j] = silu_f(a1[j]) * u1[j]; }
                u32x2 w; w.x = pk4_fp8(a0[0], a0[1], a0[2], a0[3]); w.y = pk4_fp8(a1[0], a1[1], a1[2], a1[3]);
                *(u32x2*)rowp = w;
            }
    }
};
struct EpiPlainBf16 {
    static constexpr bool PERM = true, AFTER_DRAIN = false;
    bf16_t* O; int ldc;
    DI void operator()(const f32x4 (&acc)[2][2][4][2], const pg8::Unit& u, int wr, int wc, int fr, int fq) const {
        const int row0 = u.pm * 256 + wr * 64 + fr, col0 = u.pn * 256 + wc * 32 + 8 * fq;
#pragma unroll
        for (int ai = 0; ai < 2; ++ai)
#pragma unroll
            for (int m = 0; m < 4; ++m) {
                bf16_t* rowp = O + (size_t)(row0 + ai * 128 + m * 16) * ldc + col0;
#pragma unroll
                for (int bj = 0; bj < 2; ++bj) {
                    const f32x4 v0 = acc[ai][bj][m][0], v1 = acc[ai][bj][m][1];
                    u32x4 w; w.x = pk_bf16(v0[0], v0[1]); w.y = pk_bf16(v0[2], v0[3]); w.z = pk_bf16(v1[0], v1[1]); w.w = pk_bf16(v1[2], v1[3]);
                    *(u32x4*)(rowp + bj * 128) = w;
                }
            }
    }
};

struct EpiPlainF8 {
    static constexpr bool PERM = true, AFTER_DRAIN = false;
    unsigned char* O; int ldc; float sc;
    DI void operator()(const f32x4 (&acc)[2][2][4][2], const pg8::Unit& u, int wr, int wc, int fr, int fq) const {
        const int row0 = u.pm * 256 + wr * 64 + fr, col0 = u.pn * 256 + wc * 32 + 8 * fq;
#pragma unroll
        for (int ai = 0; ai < 2; ++ai)
#pragma unroll
            for (int m = 0; m < 4; ++m) {
                unsigned char* rowp = O + (size_t)(row0 + ai * 128 + m * 16) * ldc + col0;
#pragma unroll
                for (int bj = 0; bj < 2; ++bj) {
                    const f32x4 v0 = acc[ai][bj][m][0] * sc, v1 = acc[ai][bj][m][1] * sc;
                    u32x2 w; w.x = pk4_fp8(v0[0], v0[1], v0[2], v0[3]); w.y = pk4_fp8(v1[0], v1[1], v1[2], v1[3]);
                    *(u32x2*)(rowp + bj * 128) = w;
                }
            }
    }
};
constexpr float Y_SCALE = 8.0f;

struct CvtTile { const float* src; unsigned char* dst; int ldsrc, rowbytes, col0, kind, n0, k0, f8; float scale; };
constexpr int CT0 = 0, CT1 = CT0 + 96 * 4, CT2 = CT1 + 16 * 8, CT3 = CT2 + 80 * 4, CT4 = CT3 + 16 * 4, CT5 = CT4 + 32 * 88 * 4, CT_END = CT5 + 32 * 16 * 11;
constexpr int GEMV_UNITS = 256;
DI CvtTile cvt_decode(const Args& A, int t) {
    unsigned char* ws = A.ws; CvtTile c;
    if (t < CT1) {
        const int nt = t < 128 ? (t & 31) : 32 + ((t - 128) & 63), kt = t < 128 ? (t >> 5) : ((t - 128) >> 6), n0 = nt * 64;
        c.src = A.in[I_RWIN]; c.ldsrc = 6144; c.col0 = n0; c.kind = n0 < 2048 ? 1 : 0; c.scale = (n0 >= 1024 && n0 < 2048) ? 0.0625f : 1.0f; c.dst = ws + WS_WRI; c.rowbytes = 2048; c.n0 = n0; c.k0 = kt * 256; c.f8 = 0;
    } else if (t < CT2) {
        const int q = t - CT1, nt = q % 16, kt = q / 16;
        c.src = A.in[I_RWOUT]; c.ldsrc = 1024; c.col0 = nt * 64; c.kind = 0; c.scale = 64.0f; c.dst = ws + WS_WRO; c.rowbytes = 2048; c.n0 = nt * 64; c.k0 = kt * 256; c.f8 = 1;
    } else if (t < CT3) {
        const int q = t - CT2, nt = q % 80, kt = q / 80;
        c.src = A.in[I_HWIN]; c.ldsrc = 5120; c.col0 = nt * 64; c.kind = 0; c.scale = 1.0f; c.dst = ws + WS_WHI; c.rowbytes = 2048; c.n0 = nt * 64; c.k0 = kt * 256; c.f8 = 0;
    } else if (t < CT4) {
        const int q = t - CT3, nt = q % 16, kt = q / 16;
        c.src = A.in[I_HWOUT]; c.ldsrc = 1024; c.col0 = nt * 64; c.kind = 0; c.scale = 1.0f; c.dst = ws + WS_WHO; c.rowbytes = 2048; c.n0 = nt * 64; c.k0 = kt * 256; c.f8 = 0;
    } else if (t < CT5) {
        const int q = t - CT4, le = q / 352, r = q % 352, nt = r % 88, kt = r / 88, n0 = nt * 64;
        const int tt = n0 >> 8, j0 = n0 & 255;
        c.src = ((j0 < 128) ? A.in[I_WG] : A.in[I_WU]) + (size_t)le * 1024 * FF; c.ldsrc = FF; c.col0 = tt * 128 + (j0 & 127); c.kind = 0; c.scale = 64.0f;
        c.dst = ws + WS_WM1 + (size_t)le * N1 * 1024; c.rowbytes = 1024; c.n0 = n0; c.k0 = kt * 256; c.f8 = 1;
    } else {
        const int q = t - CT5, le = q / 176, r = q % 176, nt = r % 16, kt = r / 16;
        c.src = A.in[I_WD] + (size_t)le * FF * 1024; c.ldsrc = 1024; c.col0 = nt * 64; c.kind = 0; c.scale = 64.0f; c.dst = ws + WS_WM2 + (size_t)le * 1024 * FF; c.rowbytes = FF; c.n0 = nt * 64; c.k0 = kt * 256; c.f8 = 1;
    }
    return c;
}
#define CVT_LOAD(c, rr) do { int col_ = (c).col0 + lane; if ((c).kind == 1) { const int np = (c).n0 + lane, p = np & 255, hh = p >> 7, i = (p & 127) >> 1, wh = p & 1; col_ = (np - p) + hh * 128 + wh * 64 + i; } \
        const float* sp_ = (c).src + (size_t)(c).k0 * (c).ldsrc + col_; \
        if ((c).f8) { _Pragma("unroll") for (int it = 0; it < 8; ++it) _Pragma("unroll") for (int q = 0; q < 4; ++q) rr[4 * it + q] = __builtin_nontemporal_load(sp_ + (size_t)(32 * it + 4 * w + q) * (c).ldsrc); } \
        else { _Pragma("unroll") for (int it = 0; it < 16; ++it) { const int k = 16 * it + 2 * w; rr[2 * it] = __builtin_nontemporal_load(sp_ + (size_t)k * (c).ldsrc); rr[2 * it + 1] = __builtin_nontemporal_load(sp_ + (size_t)(k + 1) * (c).ldsrc); } } } while (0)

constexpr int WM2L0 = CT5, WM1L1 = CT4 + 5632, WM2L1 = CT5 + 2816;
constexpr int T2_B = WM2L0,  T2_N = 320;
constexpr int T5_B = T2_B + T2_N, T5_N = 2016;
constexpr int T8_B = T5_B + T5_N, T8_N = 480;
constexpr int T9_B = WM1L1, T9_N = 1920;
constexpr int T11_B = T9_B + T9_N, T11_N = 768;
constexpr int T12A_B = T11_B + T11_N, T12A_N = 384;
constexpr int T12B_B = WM2L1, T12B_N = CT_END - WM2L1;
constexpr int T7_N = 640, T7_B = WM1L1 - T7_N;
constexpr int T16_B = T12A_B + T12A_N, T16_N = 768;
constexpr int I2_B = CT1, I2_N = T7_B - CT1;
constexpr int I8_B = T16_B + T16_N, I8_N = CT5 - I8_B;
constexpr int PRO_N0 = CT1, PRO_B1 = CT5, PRO_N1 = 0, PRO_B2 = T8_B + T8_N, PRO_N2 = WM2L1 - PRO_B2;
static_assert(T8_B + T8_N <= WM2L1 && T12A_B + T12A_N <= CT5 && PRO_N1 >= 0 && PRO_N2 >= 0, "conversion schedule");
DI int cvt_map(int mode, int base, int v) {
    if (mode == 0) return base + v;
    return v < PRO_N0 ? v : (v < PRO_N0 + PRO_N1 ? PRO_B1 + (v - PRO_N0) : PRO_B2 + (v - PRO_N0 - PRO_N1));
}
#define CVT_STEP(rr, cur, vload)  do { \
        if ((cur).f8) { _Pragma("unroll") for (int it = 0; it < 8; ++it) L[lane * 129 + 8 * it + w] = pk4_fp8(rr[4 * it] * (cur).scale, rr[4 * it + 1] * (cur).scale, rr[4 * it + 2] * (cur).scale, rr[4 * it + 3] * (cur).scale); } \
        else { _Pragma("unroll") for (int it = 0; it < 16; ++it) L[lane * 129 + 8 * it + w] = pk_bf16(rr[2 * it] * (cur).scale, rr[2 * it + 1] * (cur).scale); } \
        __syncthreads(); \
        const CvtTile old_ = (cur); \
        (cur) = cvt_decode(A, cvt_map(mode, base, (vload) < count ? (vload) : 0)); \
        if ((vload) < count) CVT_LOAD((cur), rr); \
        if (old_.f8) { _Pragma("unroll") for (int j = 0; j < 2; ++j) { const int id = tid + 512 * j, row = id >> 4, ch = id & 15; \
                u32x4 vv; vv.x = L[row * 129 + 4 * ch]; vv.y = L[row * 129 + 4 * ch + 1]; vv.z = L[row * 129 + 4 * ch + 2]; vv.w = L[row * 129 + 4 * ch + 3]; \
                __builtin_nontemporal_store(vv, (u32x4*)(old_.dst + (size_t)(old_.n0 + row) * old_.rowbytes + old_.k0 + 16 * ch)); } } \
        else { _Pragma("unroll") for (int j = 0; j < 4; ++j) { const int id = tid + 512 * j, row = id >> 5, ch = id & 31; \
                u32x4 vv; vv.x = L[row * 129 + 4 * ch]; vv.y = L[row * 129 + 4 * ch + 1]; vv.z = L[row * 129 + 4 * ch + 2]; vv.w = L[row * 129 + 4 * ch + 3]; \
                __builtin_nontemporal_store(vv, (u32x4*)(old_.dst + (size_t)(old_.n0 + row) * old_.rowbytes + 2 * old_.k0 + 16 * ch)); } } \
        __syncthreads(); } while (0)
DI void convert_range(const Args& A, LAS unsigned char* lds, int mode, int base, int count, int first, int stride) {
    const int tid = threadIdx.x, lane = tid & 63, w = tid >> 6;
    LAS unsigned* L = (LAS unsigned*)lds;
    float ra[32], rb[32];
    int v = first;
    CvtTile ca = cvt_decode(A, cvt_map(mode, base, v < count ? v : 0));
    CvtTile cb = cvt_decode(A, cvt_map(mode, base, v + stride < count ? v + stride : 0));
    if (v < count) CVT_LOAD(ca, ra);
    if (v + stride < count) CVT_LOAD(cb, rb);
    while (v < count) {
        CVT_STEP(ra, ca, v + 2 * stride);
        if (v + stride < count) CVT_STEP(rb, cb, v + 3 * stride);
        v += 2 * stride;
    }
}
#undef CVT_STEP
#define CVTF_LOAD(c, rr) do { const float* sp_ = (c).src + (size_t)(c).k0 * (c).ldsrc + (c).col0 + 4 * l16; \
        if ((c).f8) { _Pragma("unroll") for (int it = 0; it < 2; ++it) _Pragma("unroll") for (int q = 0; q < 4; ++q) rr[4 * it + q] = __builtin_nontemporal_load((const f32x4*)(sp_ + (size_t)(128 * it + 4 * kq + q) * (c).ldsrc)); } \
        else { _Pragma("unroll") for (int it = 0; it < 4; ++it) _Pragma("unroll") for (int q = 0; q < 2; ++q) rr[2 * it + q] = __builtin_nontemporal_load((const f32x4*)(sp_ + (size_t)(64 * it + 2 * kq + q) * (c).ldsrc)); } } while (0)
#define CVTF_STEP(rr, cur, vload)  do { const float sc_ = (cur).scale; \
        if ((cur).f8) { _Pragma("unroll") for (int it = 0; it < 2; ++it) _Pragma("unroll") for (int j = 0; j < 4; ++j) \
                L[(4 * l16 + j) * 129 + 32 * it + kq] = pk4_fp8(rr[4 * it][j] * sc_, rr[4 * it + 1][j] * sc_, rr[4 * it + 2][j] * sc_, rr[4 * it + 3][j] * sc_); } \
        else { _Pragma("unroll") for (int it = 0; it < 4; ++it) _Pragma("unroll") for (int j = 0; j < 4; ++j) L[(4 * l16 + j) * 129 + 32 * it + kq] = pk_bf16(rr[2 * it][j] * sc_, rr[2 * it + 1][j] * sc_); } \
        __syncthreads(); \
        const CvtTile old_ = (cur); \
        (cur) = cvt_decode(A, base + ((vload) < count ? (vload) : 0)); \
        if ((vload) < count) CVTF_LOAD((cur), rr); \
        if (old_.f8) { _Pragma("unroll") for (int j = 0; j < 2; ++j) { const int id = tid + 512 * j, row = id >> 4, ch = id & 15; \
                u32x4 vv; vv.x = L[row * 129 + 4 * ch]; vv.y = L[row * 129 + 4 * ch + 1]; vv.z = L[row * 129 + 4 * ch + 2]; vv.w = L[row * 129 + 4 * ch + 3]; \
                __builtin_nontemporal_store(vv, (u32x4*)(old_.dst + (size_t)(old_.n0 + row) * old_.rowbytes + old_.k0 + 16 * ch)); } } \
        else { _Pragma("unroll") for (int j = 0; j < 4; ++j) { const int id = tid + 512 * j, row = id >> 5, ch = id & 31; \
                u32x4 vv; vv.x = L[row * 129 + 4 * ch]; vv.y = L[row * 129 + 4 * ch + 1]; vv.z = L[row * 129 + 4 * ch + 2]; vv.w = L[row * 129 + 4 * ch + 3]; \
                __builtin_nontemporal_store(vv, (u32x4*)(old_.dst + (size_t)(old_.n0 + row) * old_.rowbytes + 2 * old_.k0 + 16 * ch)); } } \
        __syncthreads(); } while (0)
DI void convert_range_fast(const Args& A, LAS unsigned char* lds, int base, int count, int first, int stride) {
    const int tid = threadIdx.x, l16 = tid & 15, kq = tid >> 4;
    LAS unsigned* L = (LAS unsigned*)lds;
    f32x4 ra[8], rb[8];
    int v = first;
    CvtTile ca = cvt_decode(A, base + (v < count ? v : 0));
    CvtTile cb = cvt_decode(A, base + (v + stride < count ? v + stride : 0));
    if (v < count) CVTF_LOAD(ca, ra);
    if (v + stride < count) CVTF_LOAD(cb, rb);
    while (v < count) {
        CVTF_STEP(ra, ca, v + 2 * stride);
        if (v + stride < count) CVTF_STEP(rb, cb, v + 3 * stride);
        v += 2 * stride;
    }
}
#undef CVTF_STEP
#undef CVTF_LOAD
DI void tail_convert(const Args& A, LAS unsigned char* lds, int nwg, int base, int count) {
    const int G = (int)gridDim.x, c = (int)blockIdx.x, rem = nwg % G;
    __syncthreads();
    if (rem == 0) convert_range_fast(A, lds, base, count, c, G);
    else if (c >= rem) convert_range_fast(A, lds, base, count, c - rem, G - rem);
}
#undef CVT_LOAD

DI void p0_prologue(const Args& A, LAS unsigned char* lds) {
    const int tid = threadIdx.x, lane = tid & 63, w = tid >> 6, G = gridDim.x;
    unsigned char* ws = A.ws;
    bool have_s = false;
    LAS float* S = (LAS float*)lds;
    LAS float* RED = (LAS float*)(lds + 9 * 1024 * 4);
    for (int u = blockIdx.x; u < GEMV_UNITS; u += G) {
        if (!have_s) {
            for (int i = tid; i < 9 * 1024; i += NTHREADS) { const int r = i >> 10, k = i & 1023; const float c = (r < 8) ? A.in[I_C][r * 1024 + k] : A.in[I_CCTX][k]; S[i] = silu_f(c); }
            have_s = true;
        }
        __syncthreads();
        const int l = u >> 7, n0 = (u & 127) * 48, cl = lane < 48 ? lane : 47;
        const float* W = A.in[I_WADA] + (size_t)l * 1024 * 6144 + n0 + cl;
        float acc[9];
#pragma unroll
        for (int r = 0; r < 9; ++r) acc[r] = 0.f;
        for (int k0 = 128 * w; k0 < 128 * w + 128; k0 += 16) {
            float wv[16];
#pragma unroll
            for (int q = 0; q < 16; ++q) wv[q] = __builtin_nontemporal_load(W + (size_t)(k0 + q) * 6144);
#pragma unroll
            for (int q4 = 0; q4 < 4; ++q4)
#pragma unroll
                for (int r = 0; r < 9; ++r) { const f32x4 s = *(const LAS f32x4*)(S + r * 1024 + k0 + 4 * q4); acc[r] += s[0] * wv[4 * q4] + s[1] * wv[4 * q4 + 1] + s[2] * wv[4 * q4 + 2] + s[3] * wv[4 * q4 + 3]; }
        }
#pragma unroll
        for (int r = 0; r < 9; ++r) RED[(w * 9 + r) * 64 + lane] = acc[r];
        __syncthreads();
        for (int i = tid; i < 9 * 64; i += NTHREADS) {
            const int r = i >> 6, c = i & 63;
            if (c < 48) {
                float s = 0.f;
#pragma unroll
                for (int ww = 0; ww < 8; ++ww) s += RED[(ww * 9 + r) * 64 + c];
                ((float*)(ws + WS_MOD))[(size_t)(l * 9 + r) * 6144 + n0 + c] = s + A.in[I_BADA][l * 6144 + n0 + c];
            }
        }
        __syncthreads();
    }
    if (blockIdx.x == (unsigned)(G - 1)) {
        f32x2* R = (f32x2*)(ws + WS_ROPE);
        for (int i = tid; i < (32 + 64) * 64; i += NTHREADS) {
            const int pos = (i < 2048) ? (i >> 6) : ((i - 2048) >> 6), f = i & 63;
            const float inv = exp2f(-(float)f * (13.287712379549449f / 64.0f));
            float s, c; sincosf((float)pos * inv, &s, &c); R[i] = (f32x2){c, s};
        }
    }
    if (blockIdx.x == (unsigned)(G - 2 >= 0 ? G - 2 : 0)) {
        float* LB = (float*)(ws + WS_LB);
        for (int i = tid; i < 2048; i += NTHREADS) { const float h0 = A.in[I_HLB][i], h1 = A.in[I_HLB][2048 + i]; LB[i] = 1.0f / (1.0f + __expf(h0 - h1)); }
    }
    __syncthreads();
    const int Gh = (G + 1) >> 1, c = (int)blockIdx.x;
    if (c < Gh) convert_range(A, lds, 0, 0, 128, c, Gh);
    __syncthreads();
    if (G == 1 || c >= Gh) convert_range_fast(A, lds, 128, 256, G == 1 ? 0 : c - Gh, G == 1 ? 1 : G - Gh);
}

template <int MODE, int NR = 2>
DI void row_phase(const Args& A, LAS unsigned char* lds, int nrows, const float* src_lat, const float* src_ctx, const float* normw, const float* mod, int sh_off, int sc_off,
                  const float* cmod, int mper, const float* wrouter) {
    const int tid = threadIdx.x, lane = tid & 63, w = tid >> 6, G = gridDim.x;
    unsigned char* ws = A.ws;
    bf16_t* XB = (bf16_t*)(ws + WS_X); bf16_t* H = (bf16_t*)(ws + WS_H); float* AFF = (float*)(ws + WS_AFF); const int* SLOT = (const int*)(ws + WS_SLOT);
    const unsigned char* Y = ws + WS_R2 + R2_HALF;
    LAS float* WR = (LAS float*)lds;
    if (MODE & 2) {
        for (int i = tid; i < 1024 * 4; i += NTHREADS) { const int k = i >> 2, e4 = i & 3; *(LAS f32x4*)(WR + 4 * (((((k >> 8) * 4 + (k & 3)) * 4 + e4) * 64) + ((k >> 2) & 63))) = *(const f32x4*)(wrouter + 4 * i); }
        __syncthreads();
    }
    f32x4 nw[4];
#pragma unroll
    for (int j = 0; j < 4; ++j) nw[j] = *(const f32x4*)(normw + 256 * j + 4 * lane);
    for (int r0 = (blockIdx.x * 8 + w) * NR; r0 < nrows; r0 += G * 8 * NR) {
        f32x4 x[NR][4]; int sv[NR]; float av[NR];
#pragma unroll
        for (int r = 0; r < NR; ++r) {
            const int row = r0 + r;
            if (MODE == 0) {
                const float* sp = (row < NLAT) ? src_lat + (size_t)row * D : src_ctx + (size_t)(row - NLAT) * D;
#pragma unroll
                for (int j = 0; j < 4; ++j) x[r][j] = *(const f32x4*)(sp + 256 * j + 4 * lane);
            } else {
                const bf16_t* sp = XB + (size_t)row * D;
#pragma unroll
                for (int j = 0; j < 4; ++j) { const u32x2 t = *(const u32x2*)(sp + 256 * j + 4 * lane); x[r][j] = (f32x4){bf_lo(t.x), bf_hi(t.x), bf_lo(t.y), bf_hi(t.y)}; }
            }
            if (MODE & 1) { sv[r] = SLOT[(size_t)row * 16 + (lane & 15)]; av[r] = AFF[(size_t)row * 16 + (lane & 15)]; }
        }
#pragma unroll
        for (int r = 0; r < NR; ++r) {
            const int row = r0 + r;
            const int mr = mod_row(row);
            if (MODE & 1) {
                f32x4 acc[4];
#pragma unroll
                for (int j = 0; j < 4; ++j) acc[j] = (f32x4){0.f, 0.f, 0.f, 0.f};
                const int base = (row < NLAT) ? ((row >> 11) * 256) : (2048 + ((row - NLAT) >> 8) * 32);
                unsigned m = (unsigned)__builtin_amdgcn_readfirstlane((int)(__ballot(sv[r] >= 0) & 0xffffull));
                while (m) {
                    float gts[4]; const unsigned char* yps[4];
#pragma unroll
                    for (int q = 0; q < 4; ++q) {
                        if (m) { const int e = __builtin_ctz(m); m &= m - 1u; const int slot = __builtin_amdgcn_readlane(sv[r], e); gts[q] = (1.0f / Y_SCALE) * __int_as_float(__builtin_amdgcn_readlane(__float_as_int(av[r]), e)); yps[q] = Y + ((size_t)e * mper + base + slot) * D; }
                        else { gts[q] = 0.f; yps[q] = Y; }
                    }
                    unsigned yv[4][4];
#pragma unroll
                    for (int q = 0; q < 4; ++q)
#pragma unroll
                        for (int j = 0; j < 4; ++j) yv[q][j] = __builtin_nontemporal_load((const unsigned*)(yps[q] + 256 * j + 4 * lane));
#pragma unroll
                    for (int q = 0; q < 4; ++q)
#pragma unroll
                        for (int j = 0; j < 4; ++j) { const f32x2 lo = __builtin_amdgcn_cvt_pk_f32_fp8((int)yv[q][j], false), hi = __builtin_amdgcn_cvt_pk_f32_fp8((int)yv[q][j], true);
                            acc[j][0] += gts[q] * lo[0]; acc[j][1] += gts[q] * lo[1]; acc[j][2] += gts[q] * hi[0]; acc[j][3] += gts[q] * hi[1]; }
                }
#pragma unroll
                for (int j = 0; j < 4; ++j) { const f32x4 g = *(const f32x4*)(cmod + (size_t)mr * 6144 + 5 * 1024 + 256 * j + 4 * lane); x[r][j] += g * acc[j]; }
                if (!(MODE & 4)) {
#pragma unroll
                    for (int j = 0; j < 4; ++j) { u32x2 o; o.x = pk_bf16(x[r][j][0], x[r][j][1]); o.y = pk_bf16(x[r][j][2], x[r][j][3]); *(u32x2*)(XB + (size_t)row * D + 256 * j + 4 * lane) = o; }
                }
            }
            float ss = 0.f;
#pragma unroll
            for (int j = 0; j < 4; ++j) ss += x[r][j][0] * x[r][j][0] + x[r][j][1] * x[r][j][1] + x[r][j][2] * x[r][j][2] + x[r][j][3] * x[r][j][3];
            ss = wave_sum(ss);
            const float rs = rsqrtf(ss * (1.0f / 1024.0f) + EPS);
            if (MODE & 4) {
#pragma unroll
                for (int j = 0; j < 4; ++j) __builtin_nontemporal_store(x[r][j] * rs * nw[j], (f32x4*)(A.out + (size_t)row * D + 256 * j + 4 * lane));
            } else {
                f32x4 h[4];
#pragma unroll
                for (int j = 0; j < 4; ++j) {
                    const f32x4 sh = *(const f32x4*)(mod + (size_t)mr * 6144 + sh_off + 256 * j + 4 * lane), sc = *(const f32x4*)(mod + (size_t)mr * 6144 + sc_off + 256 * j + 4 * lane);
                    h[j] = (x[r][j] * rs * nw[j]) * (1.0f + sc) + sh;
                    if (MODE & 2) { *(unsigned*)((unsigned char*)H + (size_t)row * D + 256 * j + 4 * lane) = pk4_fp8(h[j][0], h[j][1], h[j][2], h[j][3]); }
                    else { u32x2 o; o.x = pk_bf16(h[j][0], h[j][1]); o.y = pk_bf16(h[j][2], h[j][3]); *(u32x2*)(H + (size_t)row * D + 256 * j + 4 * lane) = o; }
                }
                if (MODE & 2) {
                    float lg[16];
#pragma unroll
                    for (int e = 0; e < 16; ++e) lg[e] = 0.f;
#pragma unroll
                    for (int j = 0; j < 4; ++j)
#pragma unroll
                        for (int q = 0; q < 4; ++q) {
                            const float hv = h[j][q];
#pragma unroll
                            for (int e4 = 0; e4 < 4; ++e4) { const f32x4 wv = *(const LAS f32x4*)(WR + 4 * ((((j * 4 + q) * 4 + e4) * 64) + lane)); lg[4 * e4] += hv * wv[0]; lg[4 * e4 + 1] += hv * wv[1]; lg[4 * e4 + 2] += hv * wv[2]; lg[4 * e4 + 3] += hv * wv[3]; }
                            asm volatile("" ::: "memory");
                        }
                    const bool b5 = lane & 32, b4 = lane & 16, b3 = lane & 8, b2 = lane & 4;
                    float l8[8], l4[4], l2[2];
#pragma unroll
                    for (int e = 0; e < 8; ++e) { const float snd = b5 ? lg[e] : lg[e + 8], kp = b5 ? lg[e + 8] : lg[e]; l8[e] = kp + __shfl_xor(snd, 32); }
#pragma unroll
                    for (int e = 0; e < 4; ++e) { const float snd = b4 ? l8[e] : l8[e + 4], kp = b4 ? l8[e + 4] : l8[e]; l4[e] = kp + __shfl_xor(snd, 16); }
#pragma unroll
                    for (int e = 0; e < 2; ++e) { const float snd = b3 ? l4[e] : l4[e + 2], kp = b3 ? l4[e + 2] : l4[e]; l2[e] = kp + __shfl_xor(snd, 8); }
                    float l1; { const float snd = b2 ? l2[0] : l2[1], kp = b2 ? l2[1] : l2[0]; l1 = kp + __shfl_xor(snd, 4); }
                    l1 += __shfl_xor(l1, 2); l1 += __shfl_xor(l1, 1);
                    float mx = l1;
                    mx = fmaxf(mx, __shfl_xor(mx, 4)); mx = fmaxf(mx, __shfl_xor(mx, 8)); mx = fmaxf(mx, __shfl_xor(mx, 16)); mx = fmaxf(mx, __shfl_xor(mx, 32));
                    const float ex = __expf(l1 - mx);
                    float sm = ex;
                    sm += __shfl_xor(sm, 4); sm += __shfl_xor(sm, 8); sm += __shfl_xor(sm, 16); sm += __shfl_xor(sm, 32);
                    if ((lane & 3) == 0) AFF[(size_t)row * 16 + ((lane >> 5) & 1) * 8 + ((lane >> 4) & 1) * 4 + ((lane >> 3) & 1) * 2 + ((lane >> 2) & 1)] = ex / sm;
                }
            }
        }
    }
    if (MODE & 2) __syncthreads();
}

DI void topk_phase(const Args& A, LAS unsigned char* lds, int nprob, int mper) {
    const int tid = threadIdx.x, lane = tid & 63, w = tid >> 6, G = gridDim.x;
    unsigned char* ws = A.ws;
    const float* AFF = (const float*)(ws + WS_AFF); int* SLOT = (int*)(ws + WS_SLOT); const bf16_t* H = (const bf16_t*)(ws + WS_H); unsigned char* XE = ws + WS_R2;
    LAS int* SEL = (LAS int*)lds;
    LAS unsigned* PART = (LAS unsigned*)(lds + 1024);
    LAS unsigned* WT = (LAS unsigned*)(lds + 1024 + 256);
    for (int p = blockIdx.x; p < nprob; p += G) {
        const bool lat = p < 128; const int pc = lat ? p : p - 128, b = pc >> 4, e = 2 * (pc & 7) + ((pc >> 3) & 1);
        const int N = lat ? 2048 : 256, cap = lat ? 256 : 32, row0 = lat ? b * 2048 : NLAT + b * 256, base = lat ? b * 256 : 2048 + b * 32;
        unsigned key[4]; bool valid[4];
#pragma unroll
        for (int j = 0; j < 4; ++j) { const int t = 4 * tid + j; valid[j] = t < N; key[j] = valid[j] ? __float_as_uint(AFF[(size_t)(row0 + t) * 16 + e]) : 0u; }
        unsigned T = 0u;
        for (int rnd = 0; rnd < 16; ++rnd) {
            const int sh = 28 - 2 * rnd;
            unsigned c1 = 0, c2 = 0, c3 = 0; unsigned k1, k2, k3;
            if (rnd == 0) { k1 = 1u << 30; k2 = k1; k3 = k1; } else { const int s2 = 30 - 2 * rnd; k1 = T | (1u << s2); k2 = T | (2u << s2); k3 = T | (3u << s2); }
#pragma unroll
            for (int j = 0; j < 4; ++j) { c1 += (unsigned)__popcll(__ballot(valid[j] && key[j] >= k1)); c2 += (unsigned)__popcll(__ballot(valid[j] && key[j] >= k2)); c3 += (unsigned)__popcll(__ballot(valid[j] && key[j] >= k3)); }
            if (lane == 0) { PART[((rnd & 1) * 8 + w) * 4] = c1; PART[((rnd & 1) * 8 + w) * 4 + 1] = c2; PART[((rnd & 1) * 8 + w) * 4 + 2] = c3; }
            __syncthreads();
            unsigned t1 = 0, t2 = 0, t3 = 0;
#pragma unroll
            for (int ww = 0; ww < 8; ++ww) { t1 += PART[((rnd & 1) * 8 + ww) * 4]; t2 += PART[((rnd & 1) * 8 + ww) * 4 + 1]; t3 += PART[((rnd & 1) * 8 + ww) * 4 + 2]; }
            if (rnd == 0) { if (t1 >= (unsigned)cap) T = k1; }
            else T = (t3 >= (unsigned)cap) ? k3 : ((t2 >= (unsigned)cap) ? k2 : ((t1 >= (unsigned)cap) ? k1 : T));
            (void)sh;
        }
        unsigned mine = 0;
#pragma unroll
        for (int j = 0; j < 4; ++j) mine += (valid[j] && key[j] == T ? 1u : 0u) + (valid[j] && key[j] > T ? 0x10000u : 0u);
        unsigned inc = mine;
#pragma unroll
        for (int o = 1; o < 64; o <<= 1) { const unsigned x = __shfl_up(inc, o); inc += (lane >= o) ? x : 0u; }
        __syncthreads();
        if (lane == 63) WT[w] = inc;
        __syncthreads();
        unsigned pre = inc - mine, total = 0;
#pragma unroll
        for (int ww = 0; ww < 8; ++ww) { const unsigned x = WT[ww]; pre += (ww < w) ? x : 0u; total += x; }
        const int n_gt = (int)(total >> 16), need_eq = cap - n_gt;
        int eq_before = (int)(pre & 0xffffu), gt_before = (int)(pre >> 16);
#pragma unroll
        for (int j = 0; j < 4; ++j) if (valid[j]) {
            const bool isgt = key[j] > T, iseq = key[j] == T;
            const bool sel = isgt || (iseq && eq_before < need_eq);
            const int slot = gt_before + (eq_before < need_eq ? eq_before : need_eq);
            const int row = row0 + 4 * tid + j;
            SLOT[(size_t)row * 16 + e] = sel ? slot : -1;
            if (sel) SEL[slot] = row;
            eq_before += iseq ? 1 : 0; gt_before += isgt ? 1 : 0;
        }
        __syncthreads();
        for (int s0 = 0; s0 < cap; s0 += 256) {
            u32x4 v[32];
#pragma unroll
            for (int r = 0; r < 32; ++r) { const int sl = s0 + 8 * r + w; v[r] = *(const u32x4*)((const unsigned char*)H + (size_t)SEL[sl < cap ? sl : 0] * D + 16 * lane); }
#pragma unroll
            for (int r = 0; r < 32; ++r) { const int sl = s0 + 8 * r + w; if (sl < cap) *(u32x4*)(XE + ((size_t)e * mper + base + sl) * D + 16 * lane) = v[r]; }
        }
        __syncthreads();
    }
}

template <bool RET>
DI void readout_phase(const Args& A, int nrows) {
    const int tid = threadIdx.x, lane = tid & 63, w = tid >> 6, G = gridDim.x;
    unsigned char* ws = A.ws;
    constexpr int HD = RET ? 2048 : 1024, PITCH = RET ? RET_IN : HG_PITCH, NJ = HD / 512;
    const bf16_t* OF = (const bf16_t*)(ws + WS_R2); const bf16_t* OB = (const bf16_t*)(ws + WS_R2 + R2_HALF);
    const bf16_t* P = (const bf16_t*)(ws + WS_R1); bf16_t* A2 = (bf16_t*)(ws + WS_A2);
    for (int row = blockIdx.x * 8 + w; row < nrows; row += G * 8) {
#pragma unroll
        for (int j = 0; j < NJ; ++j) {
            const int col = 512 * j + 8 * lane;
            const u32x4 a = __builtin_nontemporal_load((const u32x4*)(OF + (size_t)row * HD + col)), b = __builtin_nontemporal_load((const u32x4*)(OB + (size_t)row * HD + col)), g = __builtin_nontemporal_load((const u32x4*)(P + (size_t)row * PITCH + 4096 + col));
            float o[8];
            o[0] = bf_lo(a.x) + bf_lo(b.x); o[1] = bf_hi(a.x) + bf_hi(b.x); o[2] = bf_lo(a.y) + bf_lo(b.y); o[3] = bf_hi(a.y) + bf_hi(b.y);
            o[4] = bf_lo(a.z) + bf_lo(b.z); o[5] = bf_hi(a.z) + bf_hi(b.z); o[6] = bf_lo(a.w) + bf_lo(b.w); o[7] = bf_hi(a.w) + bf_hi(b.w);
            float ss = 0.f;
#pragma unroll
            for (int q = 0; q < 8; ++q) ss += o[q] * o[q];
            float rs;
            if (RET) { ss = wave_sum(ss); rs = rsqrtf(ss * (1.0f / 512.0f) + EPS); }
            else { ss += __shfl_xor(ss, 1); ss += __shfl_xor(ss, 2); ss += __shfl_xor(ss, 4); ss += __shfl_xor(ss, 8); rs = rsqrtf(ss * (1.0f / 128.0f) + EPS); }
            float gn[8];
            if (RET) {
#pragma unroll
                for (int q = 0; q < 8; ++q) gn[q] = 1.0f;
            } else {
                const f32x4 g0 = *(const f32x4*)(A.in[I_HGN] + (col & 127)), g1 = *(const f32x4*)(A.in[I_HGN] + (col & 127) + 4);
                gn[0] = g0[0]; gn[1] = g0[1]; gn[2] = g0[2]; gn[3] = g0[3]; gn[4] = g1[0]; gn[5] = g1[1]; gn[6] = g1[2]; gn[7] = g1[3];
            }
            const float gt[8] = {bf_lo(g.x), bf_hi(g.x), bf_lo(g.y), bf_hi(g.y), bf_lo(g.z), bf_hi(g.z), bf_lo(g.w), bf_hi(g.w)};
            float r[8];
#pragma unroll
            for (int q = 0; q < 8; ++q) r[q] = silu_f(gt[q]) * (o[q] * rs * gn[q]);
            if (RET) { u32x2 wv; wv.x = pk4_fp8(r[0], r[1], r[2], r[3]); wv.y = pk4_fp8(r[4], r[5], r[6], r[7]); *(u32x2*)((unsigned char*)A2 + (size_t)row * HD + col) = wv; }
            else { u32x4 wv; wv.x = pk_bf16(r[0], r[1]); wv.y = pk_bf16(r[2], r[3]); wv.z = pk_bf16(r[4], r[5]); wv.w = pk_bf16(r[6], r[7]);
                   *(u32x4*)(A2 + (size_t)row * HD + col) = wv; }
        }
    }
}

template <bool RET>
DI void scan_naive_phase(const Args& A, LAS unsigned char* lds, bool ctx_out) {
    constexpr int DK = RET ? 256 : 128, DVS = RET ? 64 : 128, NKG = NTHREADS / DVS, PITCH = RET ? RET_IN : HG_PITCH, HD = RET ? 2048 : 1024;
    constexpr int NUNITS = RET ? 8 * 4 * 2 * 8 : 8 * 8 * 2;
    const int tid = threadIdx.x, G = gridDim.x;
    unsigned char* ws = A.ws;
    const bf16_t* P = (const bf16_t*)(ws + WS_R1);
    LAS bf16_t* Lq = (LAS bf16_t*)lds;
    LAS bf16_t* Lk = Lq + 64 * DK;
    LAS bf16_t* Lg = Lk + 64 * DK;
    LAS bf16_t* Lv = Lg + (RET ? 0 : 64 * DK);
    LAS float* Lp = (LAS float*)(Lv + 64 * DVS);
    const int v = tid % DVS, kg = tid / DVS;
    for (int u = blockIdx.x; u < NUNITS; u += G) {
        int b, h, dir, dvs = 0;
        if (RET) { dvs = u & 7; dir = (u >> 3) & 1; h = (u >> 4) & 3; b = u >> 6; } else { dir = u & 1; h = (u >> 1) & 7; b = u >> 4; }
        const int qoff = RET ? h * 256 : h * 128;
        const int koff = RET ? 1024 + h * 256 : 1024 + dir * 1024 + h * 128;
        const int goff = RET ? 0 : 5120 + dir * 1024 + h * 128;
        const int voff = RET ? 2048 + h * 512 + dvs * 64 : 3072 + h * 128;
        const int ooff = RET ? h * 512 + dvs * 64 : h * 128;
        bf16_t* O = (bf16_t*)(ws + WS_R2 + (dir ? R2_HALF : 0));
        float gam = 1.f;
        if (RET) { const float j = (float)(2 * h + dir); gam = 1.0f - exp2f(-5.0f - 0.5f * j); }
        float S[32];
#pragma unroll
        for (int d = 0; d < 32; ++d) S[d] = 0.f;
        for (int st = 0; st < 36; ++st) {
            const bool isctx = st < 4;
            const int c = isctx ? st : st - 4;
            const int len = isctx ? 256 : 2048, rbase = isctx ? NLAT + b * 256 : b * 2048;
            const int tlo = dir ? (len - 64 - 64 * c) : 64 * c;
            for (int id = tid; id < 64 * DK / 8; id += NTHREADS) {
                const int i = id / (DK / 8), ch = id % (DK / 8); const size_t grow = (size_t)(rbase + tlo + (dir ? 63 - i : i)) * PITCH;
                *(LAS u32x4*)(Lq + i * DK + 8 * ch) = *(const u32x4*)(P + grow + qoff + 8 * ch);
                *(LAS u32x4*)(Lk + i * DK + 8 * ch) = *(const u32x4*)(P + grow + koff + 8 * ch);
                if (!RET) *(LAS u32x4*)(Lg + i * DK + 8 * ch) = *(const u32x4*)(P + grow + goff + 8 * ch);
            }
            for (int id = tid; id < 64 * DVS / 8; id += NTHREADS) {
                const int i = id / (DVS / 8), ch = id % (DVS / 8); const size_t grow = (size_t)(rbase + tlo + (dir ? 63 - i : i)) * PITCH;
                *(LAS u32x4*)(Lv + i * DVS + 8 * ch) = *(const u32x4*)(P + grow + voff + 8 * ch);
            }
            __syncthreads();
            const bool wr_out = ctx_out || !isctx;
            for (int i = 0; i < 64; ++i) {
                const float vv = bf2f(Lv[i * DVS + v]);
                float part = 0.f;
#pragma unroll
                for (int d8 = 0; d8 < 4; ++d8) {
                    const u32x4 qq = *(const LAS u32x4*)(Lq + i * DK + kg * 32 + 8 * d8), kk = *(const LAS u32x4*)(Lk + i * DK + kg * 32 + 8 * d8);
                    u32x4 gg = (u32x4){0u, 0u, 0u, 0u};
                    if (!RET) gg = *(const LAS u32x4*)(Lg + i * DK + kg * 32 + 8 * d8);
                    const unsigned qa[4] = {qq.x, qq.y, qq.z, qq.w}, ka[4] = {kk.x, kk.y, kk.z, kk.w}, ga[4] = {gg.x, gg.y, gg.z, gg.w};
#pragma unroll
                    for (int e = 0; e < 4; ++e) {
                        const float d0 = RET ? gam : __expf(bf_lo(ga[e])), d1 = RET ? gam : __expf(bf_hi(ga[e]));
                        float& s0 = S[8 * d8 + 2 * e]; float& s1 = S[8 * d8 + 2 * e + 1];
                        s0 = d0 * s0 + bf_lo(ka[e]) * vv; s1 = d1 * s1 + bf_hi(ka[e]) * vv;
                        part += s0 * bf_lo(qa[e]) + s1 * bf_hi(qa[e]);
                    }
                }
                Lp[((i & 1) * NKG + kg) * DVS + v] = part;
                __syncthreads();
                if (kg == 0 && wr_out) {
                    float o = 0.f;
#pragma unroll
                    for (int g2 = 0; g2 < NKG; ++g2) o += Lp[((i & 1) * NKG + g2) * DVS + v];
                    O[(size_t)(rbase + tlo + (dir ? 63 - i : i)) * HD + ooff + v] = f2bf(o);
                }
            }
            __syncthreads();
        }
    }
}

typedef short s16x8 __attribute__((ext_vector_type(8)));
typedef short s16x4 __attribute__((ext_vector_type(4)));
DI unsigned offb(unsigned row, unsigned ch) { return 256u * row + 16u * (ch ^ (((row & 3u) << 2) | ((row >> 2) & 3u))); }
DI s16x4 trread(LAS unsigned char* p) { return __builtin_amdgcn_ds_read_tr16_b64_v4i16((LAS s16x4*)p); }
DI s16x8 cat8(s16x4 a, s16x4 b) { return __builtin_shufflevector(a, b, 0, 1, 2, 3, 4, 5, 6, 7); }
#define MFMA16(a, b, c) __builtin_amdgcn_mfma_f32_16x16x32_bf16((a), (b), (c), 0, 0, 0)
DI u32x4 scale8(u32x4 v, float f) { u32x4 r; r.x = pk_bf16(bf_lo(v.x) * f, bf_hi(v.x) * f); r.y = pk_bf16(bf_lo(v.y) * f, bf_hi(v.y) * f); r.z = pk_bf16(bf_lo(v.z) * f, bf_hi(v.z) * f); r.w = pk_bf16(bf_lo(v.w) * f, bf_hi(v.w) * f); return r; }
DI void unpack8(u32x4 v, float (&o)[8]) { o[0] = bf_lo(v.x); o[1] = bf_hi(v.x); o[2] = bf_lo(v.y); o[3] = bf_hi(v.y); o[4] = bf_lo(v.z); o[5] = bf_hi(v.z); o[6] = bf_lo(v.w); o[7] = bf_hi(v.w); }
DI u32x4 pack8(const float (&o)[8]) { u32x4 r; r.x = pk_bf16(o[0], o[1]); r.y = pk_bf16(o[2], o[3]); r.z = pk_bf16(o[4], o[5]); r.w = pk_bf16(o[6], o[7]); return r; }

template <bool RET>
DI void scan_mfma_phase(const Args& A, LAS unsigned char* lds, bool ctx_out) {
    constexpr int DK = RET ? 256 : 128, NT = DK / 128, NS = DK / 32, PITCH = RET ? RET_IN : HG_PITCH, HD = RET ? 2048 : 1024;
    constexpr int NUNITS = RET ? 256 : 128;
    constexpr int TQ = 0, TK = TQ + NT * 16384, TV = TK + NT * 16384, TP = TV + 16384, TE = TP + 9216, CS = TE + 512;
    const int tid = threadIdx.x, lane = tid & 63, w = __builtin_amdgcn_readfirstlane(tid >> 6), G = gridDim.x;
    const int l15 = lane & 15, g4 = lane >> 4, tq_ = (lane & 15) >> 2, tp_ = lane & 3;
    const int sc = tid & 15, rg = tid >> 4;
    unsigned char* ws = A.ws;
    const bf16_t* P = (const bf16_t*)(ws + WS_R1);
    for (int u = blockIdx.x; u < NUNITS; u += G) {
        int b, h, dir, dvs = 0;
        if (RET) {
            int uu = u; if ((G & 7) == 0 && G == NUNITS) { const int x = u & 7, y = u >> 3; uu = ((x * (G >> 6) + (y >> 3)) << 3) | (y & 7); }
            dvs = uu & 3; dir = (uu >> 2) & 1; h = (uu >> 3) & 3; b = uu >> 5;
        } else {
            int uu = u; if (G == 2 * NUNITS || G == NUNITS) { const int x = u & 7, y = u >> 3; uu = ((x * (NUNITS >> 4) + (y >> 1)) << 1) | (y & 1); }
            dir = uu & 1; h = (uu >> 1) & 7; b = uu >> 4;
        }
        const int qoff = RET ? h * 256 : h * 128;
        const int koff = RET ? 1024 + h * 256 : 1024 + dir * 1024 + h * 128;
        const int goff = RET ? 0 : 5120 + dir * 1024 + h * 128;
        const int voff = RET ? 2048 + h * 512 + dvs * 128 : 3072 + h * 128;
        const int ooff = RET ? h * 512 + dvs * 128 : h * 128;
        bf16_t* O = (bf16_t*)(ws + WS_R2 + (dir ? R2_HALF : 0));
        float fq0 = 1.f, fq1 = 1.f, fk0 = 1.f, fk1 = 1.f, e64 = 1.f;
        if (RET) {
            const float gam = 1.0f - exp2f(-5.0f - 0.5f * (float)(2 * h + dir)), lg = log2f(gam);
            fq0 = exp2f((float)(2 * rg + 1) * lg); fq1 = exp2f((float)(2 * rg + 2) * lg); fk0 = exp2f(-(float)(2 * rg + 1) * lg); fk1 = exp2f(-(float)(2 * rg + 2) * lg); e64 = exp2f(64.0f * lg);
        }
        f32x4 S[2 * NS];
#pragma unroll
        for (int i = 0; i < 2 * NS; ++i) S[i] = (f32x4){0.f, 0.f, 0.f, 0.f};
        u32x4 rq[NT][2], rk[NT][2], rgv[2], rv[2];
#define SCAN_ROWBASE(st_) (((st_) < 4) ? (NLAT + b * 256 + (dir ? 256 - 64 - 64 * (st_) : 64 * (st_))) : (b * 2048 + (dir ? 2048 - 64 - 64 * ((st_) - 4) : 64 * ((st_) - 4))))
#define SCAN_LOAD(st_) do { const int rb_ = SCAN_ROWBASE(st_); _Pragma("unroll") for (int j = 0; j < 2; ++j) { const int i_ = 2 * rg + j; const bf16_t* gp = P + (size_t)(rb_ + (dir ? 63 - i_ : i_)) * PITCH + 8 * sc; \
            _Pragma("unroll") for (int t = 0; t < NT; ++t) { rq[t][j] = *(const u32x4*)(gp + qoff + 128 * t); rk[t][j] = *(const u32x4*)(gp + koff + 128 * t); } \
            if (!RET) rgv[j] = *(const u32x4*)(gp + goff); rv[j] = *(const u32x4*)(gp + voff); } } while (0)
        SCAN_LOAD(0);
        for (int st = 0; st < 36; ++st) {
            const bool wr_out = ctx_out || st >= 4;
            const int rowbase = SCAN_ROWBASE(st);
            float tsum[8], g0[8], g1[8];
            if (!RET) {
                unpack8(rgv[0], g0); unpack8(rgv[1], g1);
#pragma unroll
                for (int c = 0; c < 8; ++c) {
                    float t = g0[c] + g1[c];
                    float x = __shfl_up(t, 16); t += (lane >= 16) ? x : 0.f;
                    x = __shfl_up(t, 32); t += (lane >= 32) ? x : 0.f;
                    tsum[c] = t;
                }
                if (lane >= 48) {
                    *(LAS f32x4*)(lds + CS + (w * 128 + 8 * sc) * 4) = (f32x4){tsum[0], tsum[1], tsum[2], tsum[3]};
                    *(LAS f32x4*)(lds + CS + (w * 128 + 8 * sc + 4) * 4) = (f32x4){tsum[4], tsum[5], tsum[6], tsum[7]};
                }
            }
            __syncthreads();
            if (RET) {
#pragma unroll
                for (int j = 0; j < 2; ++j) {
                    const int i_ = 2 * rg + j; const float fq = j ? fq1 : fq0, fk = j ? fk1 : fk0;
#pragma unroll
                    for (int t = 0; t < NT; ++t) {
                        *(LAS u32x4*)(lds + TQ + t * 16384 + offb(i_, sc)) = scale8(rq[t][j], fq);
                        *(LAS u32x4*)(lds + TK + t * 16384 + offb(i_, sc)) = scale8(rk[t][j], fk);
                    }
                    *(LAS u32x4*)(lds + TV + offb(i_, sc)) = rv[j];
                }
            } else {
                float off[8];
#pragma unroll
                for (int c = 0; c < 8; ++c) off[c] = 0.f;
                for (int ww = 0; ww < w; ++ww) {
                    const f32x4 a0 = *(const LAS f32x4*)(lds + CS + (ww * 128 + 8 * sc) * 4), a1 = *(const LAS f32x4*)(lds + CS + (ww * 128 + 8 * sc + 4) * 4);
                    off[0] += a0[0]; off[1] += a0[1]; off[2] += a0[2]; off[3] += a0[3]; off[4] += a1[0]; off[5] += a1[1]; off[6] += a1[2]; off[7] += a1[3];
                }
                float q0[8], q1[8], k0[8], k1[8], ee[8];
                unpack8(rq[0][0], q0); unpack8(rq[0][1], q1); unpack8(rk[0][0], k0); unpack8(rk[0][1], k1);
#pragma unroll
                for (int c = 0; c < 8; ++c) {
                    const float b0 = off[c] + tsum[c] - g1[c], b1 = b0 + g1[c];
                    const float e0 = __expf(b0), e1 = __expf(b1);
                    q0[c] *= e0; q1[c] *= e1; k0[c] *= __builtin_amdgcn_rcpf(e0); k1[c] *= __builtin_amdgcn_rcpf(e1); ee[c] = e1;
                }
                *(LAS u32x4*)(lds + TQ + offb(2 * rg, sc)) = pack8(q0); *(LAS u32x4*)(lds + TQ + offb(2 * rg + 1, sc)) = pack8(q1);
                *(LAS u32x4*)(lds + TK + offb(2 * rg, sc)) = pack8(k0); *(LAS u32x4*)(lds + TK + offb(2 * rg + 1, sc)) = pack8(k1);
                *(LAS u32x4*)(lds + TV + offb(2 * rg, sc)) = rv[0]; *(LAS u32x4*)(lds + TV + offb(2 * rg + 1, sc)) = rv[1];
                if (rg == 31) { *(LAS f32x4*)(lds + TE + (8 * sc) * 4) = (f32x4){ee[0], ee[1], ee[2], ee[3]}; *(LAS f32x4*)(lds + TE + (8 * sc + 4) * 4) = (f32x4){ee[4], ee[5], ee[6], ee[7]}; }
            }
            __syncthreads();
            if (st + 1 < 36) SCAN_LOAD(st + 1);
            if (wr_out) {
                const int mi = w >> 1;
#pragma unroll
                for (int nn = 0; nn < 2; ++nn) {
                    const int nj = 2 * (w & 1) + nn;
                    f32x4 pa = (f32x4){0.f, 0.f, 0.f, 0.f};
                    if (nj <= mi) {
#pragma unroll
                        for (int s = 0; s < NS; ++s) {
                            const s16x8 ka = *(const LAS s16x8*)(lds + TK + (s >> 2) * 16384 + offb(l15 + 16 * nj, 4 * (s & 3) + g4));
                            const s16x8 qb = *(const LAS s16x8*)(lds + TQ + (s >> 2) * 16384 + offb(l15 + 16 * mi, 4 * (s & 3) + g4));
                            pa = MFMA16(ka, qb, pa);
                        }
#pragma unroll
                        for (int r = 0; r < 4; ++r) pa[r] = (16 * nj + 4 * g4 + r > 16 * mi + l15) ? 0.f : pa[r];
                    }
                    u32x2 pk; pk.x = pk_bf16(pa[0], pa[1]); pk.y = pk_bf16(pa[2], pa[3]);
                    *(LAS u32x2*)(lds + TP + (16 * mi + l15) * 144 + 2 * (16 * nj + 4 * g4)) = pk;
                }
            }
            __syncthreads();
            s16x8 vf[2];
#pragma unroll
            for (int ks = 0; ks < 2; ++ks) {
                const s16x4 t0 = trread(lds + TV + offb(32 * ks + 8 * g4 + tq_, 2 * w + (tp_ >> 1)) + 8 * (tp_ & 1));
                const s16x4 t1 = trread(lds + TV + offb(32 * ks + 8 * g4 + 4 + tq_, 2 * w + (tp_ >> 1)) + 8 * (tp_ & 1));
                vf[ks] = cat8(t0, t1);
            }
            if (wr_out) {
                f32x4 OT[4];
#pragma unroll
                for (int m = 0; m < 4; ++m) OT[m] = (f32x4){0.f, 0.f, 0.f, 0.f};
#pragma unroll
                for (int s = 0; s < NS; ++s) {
                    u32x4 sp; sp.x = pk_bf16(S[2 * s][0], S[2 * s][1]); sp.y = pk_bf16(S[2 * s][2], S[2 * s][3]); sp.z = pk_bf16(S[2 * s + 1][0], S[2 * s + 1][1]); sp.w = pk_bf16(S[2 * s + 1][2], S[2 * s + 1][3]);
                    const s16x8 sa = __builtin_bit_cast(s16x8, sp);
#pragma unroll
                    for (int m = 0; m < 4; ++m) {
                        const s16x8 qb = *(const LAS s16x8*)(lds + TQ + (s >> 2) * 16384 + offb(l15 + 16 * m, 4 * (s & 3) + g4));
                        OT[m] = MFMA16(sa, qb, OT[m]);
                    }
                }
#pragma unroll
                for (int ks = 0; ks < 2; ++ks)
#pragma unroll
                    for (int m = 0; m < 4; ++m) {
                        if (ks == 0 || m >= 2) {
                            const s16x8 pb = *(const LAS s16x8*)(lds + TP + (16 * m + l15) * 144 + 2 * (32 * ks + 8 * g4));
                            OT[m] = MFMA16(vf[ks], pb, OT[m]);
                        }
                    }
#pragma unroll
                for (int m = 0; m < 4; ++m) {
                    const int i_ = 16 * m + l15;
                    u32x2 o; o.x = pk_bf16(OT[m][0], OT[m][1]); o.y = pk_bf16(OT[m][2], OT[m][3]);
                    *(u32x2*)(O + (size_t)(rowbase + (dir ? 63 - i_ : i_)) * HD + ooff + 16 * w + 4 * g4) = o;
                }
            }
#pragma unroll
            for (int s = 0; s < NS; ++s)
#pragma unroll
                for (int u2 = 0; u2 < 2; ++u2) {
#pragma unroll
                    for (int ks = 0; ks < 2; ++ks) {
                        const s16x4 a0 = trread(lds + TK + (s >> 2) * 16384 + offb(32 * ks + 8 * g4 + tq_, 4 * (s & 3) + tp_) + 8 * u2);
                        const s16x4 a1 = trread(lds + TK + (s >> 2) * 16384 + offb(32 * ks + 8 * g4 + 4 + tq_, 4 * (s & 3) + tp_) + 8 * u2);
                        S[2 * s + u2] = MFMA16(cat8(a0, a1), vf[ks], S[2 * s + u2]);
                    }
                    if (RET) S[2 * s + u2] *= e64;
                    else { const f32x4 ev = *(const LAS f32x4*)(lds + TE + (32 * s + 8 * g4 + 4 * u2) * 4); S[2 * s + u2] *= ev; }
                }
        }
        __syncthreads();
#undef SCAN_ROWBASE
#undef SCAN_LOAD
    }
}

#ifndef PROBE_SCAN
#define PROBE_SCAN 0
#endif
template <bool RET>
DI void scan_v3_phase(const Args& A, LAS unsigned char* lds, bool ctx_out) {
    constexpr int DK = RET ? 256 : 128, NT = DK / 128, NS = DK / 32, PITCH = RET ? RET_IN : HG_PITCH, HD = RET ? 2048 : 1024;
    constexpr int NUNITS = RET ? 256 : 128, C = 32, NSTEP = 2304 / C, NCTX = 256 / C, RN = 4;
    constexpr int TQ = 0, TK = TQ + NT * C * 256, TV = TK + NT * C * 256, TV2 = TV + C * 256, TP = TV2 + (RET ? C * 256 : 0), TE = TP + C * 80, BUF = TE + 512;
    static_assert(2 * BUF <= 131072, "scan LDS");
    const int tid = threadIdx.x, lane = tid & 63, w = __builtin_amdgcn_readfirstlane(tid >> 6), G = gridDim.x;
    const int l15 = lane & 15, g4 = lane >> 4, tq_ = (lane & 15) >> 2, tp_ = lane & 3;
    const bool cons = w < 4;
    const int pw = w & 3, ptid = tid & 255;
    unsigned char* ws = A.ws;
    const bf16_t* P = (const bf16_t*)(ws + WS_R1);
    for (int u = blockIdx.x; u < NUNITS; u += G) {
        int b, h, dir, dvs = 0;
        if (RET) {
            int uu = u; if ((G & 7) == 0 && G == NUNITS) { const int x = u & 7, y = u >> 3; uu = ((x * (G >> 6) + (y >> 3)) << 3) | (y & 7); }
            dvs = uu & 3; dir = (uu >> 2) & 1; h = (uu >> 3) & 3; b = uu >> 5;
        } else {
            int uu = u; if (G == 2 * NUNITS || G == NUNITS) { const int x = u & 7, y = u >> 3; uu = ((x * (NUNITS >> 4) + (y >> 1)) << 1) | (y & 1); }
            dir = uu & 1; h = (uu >> 1) & 7; b = uu >> 4;
        }
        const int qoff = RET ? h * 256 : h * 128;
        const int koff = RET ? 1024 + h * 256 : 1024 + dir * 1024 + h * 128;
        const int goff = RET ? 0 : 5120 + dir * 1024 + h * 128;
        const int voff = RET ? 2048 + h * 512 + dvs * 128 : 3072 + h * 128;
        const int ooff = RET ? h * 512 + dvs * 128 : h * 128;
        bf16_t* O = (bf16_t*)(ws + WS_R2 + (dir ? R2_HALF : 0));
        float lg = 0.f;
        if (RET) lg = log2f(1.0f - exp2f(-5.0f - 0.5f * (float)(2 * h + dir)));
#define V3_ROWBASE(st_) (((st_) < NCTX) ? (NLAT + b * 256 + (dir ? 256 - C - C * (st_) : C * (st_))) : (b * 2048 + (dir ? 2048 - C - C * ((st_) - NCTX) : C * ((st_) - NCTX))))
        if (cons) {
            if (RET) __builtin_amdgcn_s_setprio(2);
            f32x4 S[2][2 * NS];
#pragma unroll
            for (int n = 0; n < 2; ++n)
#pragma unroll
                for (int i = 0; i < 2 * NS; ++i) S[n][i] = (f32x4){0.f, 0.f, 0.f, 0.f};
            __syncthreads(); __syncthreads();
#pragma unroll (RET ? 1 : 2)
            for (int st = 0; st < NSTEP; ++st) {
                LAS unsigned char* B = lds + (st & 1) * BUF;
                const bool wr_out = ctx_out || st >= NCTX;
                const int mm = st & (RN - 1);
                for (int rep_ = 0; rep_ < (((PROBE_SCAN & 2) && !RET) ? 2 : 1); ++rep_)
                if (wr_out) {
                    const int rowbase = V3_ROWBASE(st);
                    f32x4 OT[2][2];
#pragma unroll
                    for (int n = 0; n < 2; ++n)
#pragma unroll
                        for (int m = 0; m < 2; ++m) OT[n][m] = (f32x4){0.f, 0.f, 0.f, 0.f};
#pragma unroll
                    for (int s = 0; s < NS; ++s) {
                        s16x8 sa[2];
#pragma unroll
                        for (int n = 0; n < 2; ++n) { u32x4 sp; sp.x = pk_bf16(S[n][2 * s][0], S[n][2 * s][1]); sp.y = pk_bf16(S[n][2 * s][2], S[n][2 * s][3]); sp.z = pk_bf16(S[n][2 * s + 1][0], S[n][2 * s + 1][1]); sp.w = pk_bf16(S[n][2 * s + 1][2], S[n][2 * s + 1][3]); sa[n] = __builtin_bit_cast(s16x8, sp); }
#pragma unroll
                        for (int m = 0; m < 2; ++m) {
                            const s16x8 qb = *(const LAS s16x8*)(B + TQ + (s >> 2) * (C * 256) + offb(l15 + 16 * m, 4 * (s & 3) + g4));
#pragma unroll
                            for (int n = 0; n < 2; ++n) OT[n][m] = MFMA16(sa[n], qb, OT[n][m]);
                        }
                    }
                    if (RET) {
#pragma unroll
                        for (int m = 0; m < 2; ++m) { const float fo = exp2f((float)(C * mm + 16 * m + l15 + 1) * lg);
#pragma unroll
                            for (int n = 0; n < 2; ++n) OT[n][m] *= fo; }
                    }
#pragma unroll
                    for (int n = 0; n < 2; ++n) {
                        const int cc = 2 * w + n;
                        const s16x4 t0 = trread(B + TV + offb(8 * g4 + tq_, 2 * cc + (tp_ >> 1)) + 8 * (tp_ & 1));
                        const s16x4 t1 = trread(B + TV + offb(8 * g4 + 4 + tq_, 2 * cc + (tp_ >> 1)) + 8 * (tp_ & 1));
                        const s16x8 vf = cat8(t0, t1);
#pragma unroll
                        for (int m = 0; m < 2; ++m) {
                            const s16x8 pb = *(const LAS s16x8*)(B + TP + (16 * m + l15) * 80 + 16 * g4);
                            OT[n][m] = MFMA16(vf, pb, OT[n][m]);
                        }
                    }
#pragma unroll
                    for (int n = 0; n < 2; ++n)
#pragma unroll
                        for (int m = 0; m < 2; ++m) {
                            const int i_ = 16 * m + l15;
                            u32x2 o; o.x = pk_bf16(OT[n][m][0], OT[n][m][1]); o.y = pk_bf16(OT[n][m][2], OT[n][m][3]);
                            *(u32x2*)(O + (size_t)(rowbase + (dir ? C - 1 - i_ : i_)) * HD + ooff + 32 * w + 16 * n + 4 * g4) = o;
                        }
                }
                __syncthreads();
                if ((PROBE_SCAN & 4) && !RET) { __syncthreads(); __syncthreads(); }
                {
                    s16x8 vb[2];
#pragma unroll
                    for (int n = 0; n < 2; ++n) {
                        const int cc = 2 * w + n;
                        const s16x4 t0 = trread(B + (RET ? TV2 : TV) + offb(8 * g4 + tq_, 2 * cc + (tp_ >> 1)) + 8 * (tp_ & 1));
                        const s16x4 t1 = trread(B + (RET ? TV2 : TV) + offb(8 * g4 + 4 + tq_, 2 * cc + (tp_ >> 1)) + 8 * (tp_ & 1));
                        vb[n] = cat8(t0, t1);
                    }
#pragma unroll
                    for (int s = 0; s < NS; ++s)
#pragma unroll
                        for (int u2 = 0; u2 < 2; ++u2) {
                            const s16x4 a0 = trread(B + TK + (s >> 2) * (C * 256) + offb(8 * g4 + tq_, 4 * (s & 3) + tp_) + 8 * u2);
                            const s16x4 a1 = trread(B + TK + (s >> 2) * (C * 256) + offb(8 * g4 + 4 + tq_, 4 * (s & 3) + tp_) + 8 * u2);
                            const s16x8 ka = cat8(a0, a1);
#pragma unroll
                            for (int n = 0; n < 2; ++n) S[n][2 * s + u2] = MFMA16(ka, vb[n], S[n][2 * s + u2]);
                            if ((PROBE_SCAN & 8) && !RET) { const s16x4 b0 = trread(B + TK + (s >> 2) * (C * 256) + offb(8 * g4 + tq_, 4 * (s & 3) + tp_) + 8 * u2); const s16x4 b1 = trread(B + TK + (s >> 2) * (C * 256) + offb(8 * g4 + 4 + tq_, 4 * (s & 3) + tp_) + 8 * u2);
                                f32x4 dmy = (f32x4){0.f, 0.f, 0.f, 0.f}; dmy = MFMA16(cat8(b0, b1), vb[0], dmy); dmy = MFMA16(cat8(b0, b1), vb[1], dmy); asm volatile("" :: "v"(dmy)); }
                            if (!RET) { const f32x4 ev = *(const LAS f32x4*)(B + TE + (32 * s + 8 * g4 + 4 * u2) * 4);
#pragma unroll
                                for (int n = 0; n < 2; ++n) S[n][2 * s + u2] *= ev; }
                        }
                    if (RET && mm == RN - 1) {
                        const float er = exp2f((float)(C * RN) * lg);
#pragma unroll
                        for (int n = 0; n < 2; ++n)
#pragma unroll
                            for (int i = 0; i < 2 * NS; ++i) S[n][i] *= er;
                    }
                }
                __syncthreads();
            }
            if (RET) __builtin_amdgcn_s_setprio(0);
        } else {
            constexpr int NQ = RET ? 4 : 2;
            u32x4 rq[2][NQ], rk[2][NQ], rgv[2][2], rv[2][2];
            const int c4 = lane & 3, rg = lane >> 2;
#define V3_LOAD(set_, st_) do { const int rb_ = V3_ROWBASE(st_); \
                if (RET) { _Pragma("unroll") for (int j = 0; j < 4; ++j) { const int id = ptid + 256 * j, i_ = id >> 5, ch = id & 31; const bf16_t* gp = P + (size_t)(rb_ + (dir ? C - 1 - i_ : i_)) * PITCH + 8 * ch; \
                        rq[set_][j] = *(const u32x4*)(gp + qoff); rk[set_][j] = *(const u32x4*)(gp + koff); } \
                    _Pragma("unroll") for (int j = 0; j < 2; ++j) { const int id = ptid + 256 * j, i_ = id >> 4, ch = id & 15; rv[set_][j] = *(const u32x4*)(P + (size_t)(rb_ + (dir ? C - 1 - i_ : i_)) * PITCH + voff + 8 * ch); } } \
                else { _Pragma("unroll") for (int j = 0; j < 2; ++j) { const int i_ = 2 * rg + j; const bf16_t* gp = P + (size_t)(rb_ + (dir ? C - 1 - i_ : i_)) * PITCH + 8 * (4 * pw + c4); \
                        rq[set_][j] = *(const u32x4*)(gp + qoff); rk[set_][j] = *(const u32x4*)(gp + koff); rgv[set_][j] = *(const u32x4*)(gp + goff); rv[set_][j] = *(const u32x4*)(gp + voff); } } } while (0)
#define V3_STAGE(set_, st_) do { LAS unsigned char* Bn = lds + ((st_) & 1) * BUF; \
                if (RET) { const int mmn = (st_) & (RN - 1); \
                    _Pragma("unroll") for (int j = 0; j < 4; ++j) { const int id = ptid + 256 * j, i_ = id >> 5, ch = id & 31; \
                        *(LAS u32x4*)(Bn + TQ + (ch >> 4) * (C * 256) + offb(i_, ch & 15)) = rq[set_][j]; *(LAS u32x4*)(Bn + TK + (ch >> 4) * (C * 256) + offb(i_, ch & 15)) = rk[set_][j]; } \
                    _Pragma("unroll") for (int j = 0; j < 2; ++j) { const int id = ptid + 256 * j, i_ = id >> 4, ch = id & 15; \
                        *(LAS u32x4*)(Bn + TV + offb(i_, ch)) = rv[set_][j]; *(LAS u32x4*)(Bn + TV2 + offb(i_, ch)) = scale8(rv[set_][j], exp2f(-(float)(C * mmn + i_ + 1) * lg)); } } \
                else { float g0[8], g1[8], q0[8], q1[8], k0[8], k1[8], ee[8]; unpack8(rgv[set_][0], g0); unpack8(rgv[set_][1], g1); \
                    unpack8(rq[set_][0], q0); unpack8(rq[set_][1], q1); unpack8(rk[set_][0], k0); unpack8(rk[set_][1], k1); \
                    _Pragma("unroll") for (int c = 0; c < 8; ++c) { float t = g0[c] + g1[c]; float x = __shfl_up(t, 4); t += (lane >= 4) ? x : 0.f; x = __shfl_up(t, 8); t += (lane >= 8) ? x : 0.f; \
                        x = __shfl_up(t, 16); t += (lane >= 16) ? x : 0.f; x = __shfl_up(t, 32); t += (lane >= 32) ? x : 0.f; \
                        const float b0 = t - g1[c], b1 = t; const float e0 = __expf(b0), e1 = __expf(b1); \
                        q0[c] *= e0; q1[c] *= e1; k0[c] *= __builtin_amdgcn_rcpf(e0); k1[c] *= __builtin_amdgcn_rcpf(e1); ee[c] = e1; } \
                    const int cch = 4 * pw + c4; \
                    *(LAS u32x4*)(Bn + TQ + offb(2 * rg, cch)) = pack8(q0); *(LAS u32x4*)(Bn + TQ + offb(2 * rg + 1, cch)) = pack8(q1); \
                    *(LAS u32x4*)(Bn + TK + offb(2 * rg, cch)) = pack8(k0); *(LAS u32x4*)(Bn + TK + offb(2 * rg + 1, cch)) = pack8(k1); \
                    *(LAS u32x4*)(Bn + TV + offb(2 * rg, cch)) = rv[set_][0]; *(LAS u32x4*)(Bn + TV + offb(2 * rg + 1, cch)) = rv[set_][1]; \
                    if (rg == 15) { *(LAS f32x4*)(Bn + TE + (8 * cch) * 4) = (f32x4){ee[0], ee[1], ee[2], ee[3]}; *(LAS f32x4*)(Bn + TE + (8 * cch + 4) * 4) = (f32x4){ee[4], ee[5], ee[6], ee[7]}; } } } while (0)
            const int mi = pw >> 1, nj = pw & 1;
            float pf[4];
#pragma unroll
            for (int r = 0; r < 4; ++r) pf[r] = RET ? exp2f((float)(16 * (mi - nj) + l15 - 4 * g4 - r) * lg) : 1.0f;
#define V3_PTILE(st_) do { LAS unsigned char* Bn = lds + ((st_) & 1) * BUF; f32x4 pa = (f32x4){0.f, 0.f, 0.f, 0.f}; \
                if (nj <= mi) { _Pragma("unroll") for (int s = 0; s < NS; ++s) { \
                        const s16x8 ka = *(const LAS s16x8*)(Bn + TK + (s >> 2) * (C * 256) + offb(l15 + 16 * nj, 4 * (s & 3) + g4)); \
                        const s16x8 qb = *(const LAS s16x8*)(Bn + TQ + (s >> 2) * (C * 256) + offb(l15 + 16 * mi, 4 * (s & 3) + g4)); \
                        pa = MFMA16(ka, qb, pa); } \
                    _Pragma("unroll") for (int r = 0; r < 4; ++r) pa[r] = (16 * nj + 4 * g4 + r > 16 * mi + l15) ? 0.f : pa[r] * pf[r]; } \
                u32x2 pk; pk.x = pk_bf16(pa[0], pa[1]); pk.y = pk_bf16(pa[2], pa[3]); \
                *(LAS u32x2*)(Bn + TP + (16 * mi + l15) * 80 + 2 * (16 * nj + 4 * g4)) = pk; } while (0)
            V3_LOAD(0, 0); V3_LOAD(1, 1);
            V3_STAGE(0, 0);
            V3_LOAD(0, 2);
            __syncthreads();
            if (ctx_out || 0 >= NCTX) V3_PTILE(0);
            __syncthreads();
            for (int st = 0; st < NSTEP; st += 2) {
                if (st + 1 < NSTEP) V3_STAGE(1, st + 1);
                if ((PROBE_SCAN & 1) && !RET && st + 1 < NSTEP) V3_STAGE(1, st + 1);
                { const int sl_ = st + 3 < NSTEP ? st + 3 : NSTEP - 1; V3_LOAD(1, sl_); }
                __syncthreads();
                if ((PROBE_SCAN & 4) && !RET) { __syncthreads(); __syncthreads(); }
                if (st + 1 < NSTEP && (ctx_out || st + 1 >= NCTX)) V3_PTILE(st + 1);
                __syncthreads();
                if (st + 2 < NSTEP) V3_STAGE(0, st + 2);
                if ((PROBE_SCAN & 1) && !RET && st + 2 < NSTEP) V3_STAGE(0, st + 2);
                { const int sl_ = st + 4 < NSTEP ? st + 4 : NSTEP - 1; V3_LOAD(0, sl_); }
                __syncthreads();
                if ((PROBE_SCAN & 4) && !RET) { __syncthreads(); __syncthreads(); }
                if (st + 2 < NSTEP && (ctx_out || st + 2 >= NCTX)) V3_PTILE(st + 2);
                __syncthreads();
            }
#undef V3_LOAD
#undef V3_STAGE
#undef V3_PTILE
        }
        __syncthreads();
#undef V3_ROWBASE
    }
}

constexpr int NPHASES = 20;
#ifndef GEMM_STAGGER_TICKS
#define GEMM_STAGGER_TICKS 0
#endif
#ifndef SCAN_IMPL
#define SCAN_IMPL scan_v3_phase
#endif
template <class Epi, bool F8 = false>
DI void run_gemm(LAS unsigned char* lds, const bf16_t* Aop, const bf16_t* Bt, int M, int N, int K, int pmg, size_t bgs, const Epi& E, int G = -1, int c = -1, int rb = 0, int re = 1 << 30) {
    pg8::Gemm g{Aop, Bt, M, N, K, pmg, bgs};
    if (G < 0) { G = (int)gridDim.x; c = (int)blockIdx.x; }
    pg8::StaticOrder S; S.init(M, N, G, c, (pmg < 64) ? pmg : 8); S.ib = rb; S.ie = re;
    if (GEMM_STAGGER_TICKS > 0 && (M / 256) * (N / 256) >= 4 * (int)gridDim.x) {
        const unsigned long long t0 = __builtin_amdgcn_s_memrealtime(), dl = (unsigned long long)((blockIdx.x & 7u) * GEMM_STAGGER_TICKS);
        while (__builtin_amdgcn_s_memrealtime() - t0 < dl) __builtin_amdgcn_s_sleep(8);
    }
    pg8::gemm_phase<Epi, pg8::StaticOrder, false, F8>((PG8_LAS unsigned char*)lds, g, S, E, nullptr);
}

template <class Epi, bool F8 = false>
DI void run_gemm_cvt(const Args& A, LAS unsigned char* lds, const bf16_t* Aop, const bf16_t* Bt, int M, int N, int K, int pmg, size_t bgs, const Epi& E, int base, int count) {
    const int G = (int)gridDim.x, c = (int)blockIdx.x, nwg = (M / 256) * (N / 256), R = (nwg + G - 1) / G;
    const int sp = ((c & 7) % R) + 1;
    run_gemm<Epi, F8>(lds, Aop, Bt, M, N, K, pmg, bgs, E, -1, -1, 0, sp);
    __syncthreads();
    convert_range_fast(A, lds, base, count, c, G);
    __syncthreads();
    run_gemm<Epi, F8>(lds, Aop, Bt, M, N, K, pmg, bgs, E, -1, -1, sp, 1 << 30);
}

__global__ void __launch_bounds__(NTHREADS, 2) mk_fwd(Args A) {
    extern __shared__ __attribute__((aligned(16))) unsigned char lds_raw[];
    LAS unsigned char* lds = (LAS unsigned char*)lds_raw;
    unsigned char* ws = A.ws;
    const int lo = A.ph_lo, hi = A.ph_hi;
    XcdBarrier bar; bar.bar = (unsigned*)(ws + WS_BAR); bar.x = 0; bar.st = nullptr;
    if (hi - lo > 1) {
        volatile LAS unsigned* st = (volatile LAS unsigned*)(lds + MISC_OFF);
        if (threadIdx.x == 0) { st[0] = 0u; st[1] = 0u; st[2] = 0u; st[3] = 0u; }
        __syncthreads();
        bar = xcd_barrier_post((unsigned*)(ws + WS_BAR), st);
    }
#ifndef REP_MASK
#define REP_MASK 0
#endif
#ifdef ONLY_PHASE
#define IN(k) ((k) == ONLY_PHASE && lo <= (k) && (k) < hi)
#else
#define IN(k) (lo <= (k) && (k) < hi)
#endif
#define SEAM(k) do { if (IN(k) && IN((k) + 1)) xcd_barrier(bar); } while (0)
    const float* MOD0 = (const float*)(ws + WS_MOD); const float* MOD1 = MOD0 + 9 * 6144;
    bf16_t* X = (bf16_t*)(ws + WS_X); bf16_t* H = (bf16_t*)(ws + WS_H); bf16_t* PROJ = (bf16_t*)(ws + WS_R1); bf16_t* A2 = (bf16_t*)(ws + WS_A2);
    const bf16_t* XE = (const bf16_t*)(ws + WS_R2); bf16_t* Y = (bf16_t*)(ws + WS_R2 + R2_HALF); unsigned char* ACT = ws + WS_R1;

    if (IN(0)) { p0_prologue(A, lds); if (REP_MASK >> 0 & 1) { __syncthreads(); p0_prologue(A, lds); } }
    SEAM(0);
    if (IN(1)) { row_phase<0, 3>(A, lds, NTOK, A.in[I_X], A.in[I_CTX], A.in[I_NMIX], MOD0, 0, 1024, nullptr, 0, nullptr); if (REP_MASK >> 1 & 1) { __syncthreads(); row_phase<0, 3>(A, lds, NTOK, A.in[I_X], A.in[I_CTX], A.in[I_NMIX], MOD0, 0, 1024, nullptr, 0, nullptr); } }
    SEAM(1);
    if (IN(2)) { { EpiRetIn E{PROJ, (const f32x2*)(ws + WS_ROPE), (const f32x2*)(ws + WS_ROPE) + 2048}; run_gemm_cvt(A, lds, H, (const bf16_t*)(ws + WS_WRI), NTOK, RET_IN, 1024, 1 << 20, 0, E, I2_B, I2_N); } if (REP_MASK >> 2 & 1) { __syncthreads(); { EpiRetIn E{PROJ, (const f32x2*)(ws + WS_ROPE), (const f32x2*)(ws + WS_ROPE) + 2048}; run_gemm(lds, H, (const bf16_t*)(ws + WS_WRI), NTOK, RET_IN, 1024, 1 << 20, 0, E); } } }
    if (IN(2)) tail_convert(A, lds, (NTOK / 256) * (RET_IN / 256), T2_B, T2_N);
    SEAM(2);
    if (IN(3)) { SCAN_IMPL<true>(A, lds, true); if (REP_MASK >> 3 & 1) { __syncthreads(); SCAN_IMPL<true>(A, lds, true); } }
    SEAM(3);
    if (IN(4)) { readout_phase<true>(A, NTOK); if (REP_MASK >> 4 & 1) { __syncthreads(); readout_phase<true>(A, NTOK); } }
    SEAM(4);
    if (IN(5)) { { EpiResidT<false> E{A.in[I_X], A.in[I_CTX], X, MOD0, 2048}; run_gemm<EpiResidT<false>, true>(lds, A2, (const bf16_t*)(ws + WS_WRO), NTOK, 1024, 1024, 1 << 20, 0, E); } if (REP_MASK >> 5 & 1) { __syncthreads(); { EpiResidT<false> E{A.in[I_X], A.in[I_CTX], X, MOD0, 2048}; run_gemm<EpiResidT<false>, true>(lds, A2, (const bf16_t*)(ws + WS_WRO), NTOK, 1024, 1024, 1 << 20, 0, E); } } }
    if (IN(5)) tail_convert(A, lds, (NTOK / 256) * 4, T5_B, T5_N);
    SEAM(5);
    if (IN(6)) { row_phase<2, 3>(A, lds, NTOK, nullptr, nullptr, A.in[I_NFFN], MOD0, 3 * 1024, 4 * 1024, nullptr, 0, A.in[I_ROUTER]); if (REP_MASK >> 6 & 1) { __syncthreads(); row_phase<2, 3>(A, lds, NTOK, nullptr, nullptr, A.in[I_NFFN], MOD0, 3 * 1024, 4 * 1024, nullptr, 0, A.in[I_ROUTER]); } }
    SEAM(6);
    if (IN(7)) { topk_phase(A, lds, 256, MPER0); if (REP_MASK >> 7 & 1) { __syncthreads(); topk_phase(A, lds, 256, MPER0); } }
    if (IN(7) && (int)gridDim.x > 128) { __syncthreads(); if ((int)blockIdx.x >= 128) convert_range_fast(A, lds, T7_B, T7_N, (int)blockIdx.x - 128, (int)gridDim.x - 128); }
    else if (IN(7)) { __syncthreads(); convert_range_fast(A, lds, T7_B, T7_N, (int)blockIdx.x, (int)gridDim.x); }
    SEAM(7);
    if (IN(8)) { { EpiMoe1 E{ACT}; run_gemm_cvt<EpiMoe1, true>(A, lds, XE, (const bf16_t*)(ws + WS_WM1), NE * MPER0, N1, 512, MPER0 / 256, (size_t)N1 * 1024, E, I8_B, I8_N); } if (REP_MASK >> 8 & 1) { __syncthreads(); { EpiMoe1 E{ACT}; run_gemm<EpiMoe1, true>(lds, XE, (const bf16_t*)(ws + WS_WM1), NE * MPER0, N1, 512, MPER0 / 256, (size_t)N1 * 1024, E); } } }
    if (IN(8)) tail_convert(A, lds, (NE * MPER0 / 256) * (N1 / 256), T8_B, T8_N);
    SEAM(8);
    if (IN(9)) { { EpiPlainF8 E{(unsigned char*)Y, 1024, Y_SCALE}; run_gemm<EpiPlainF8, true>(lds, (const bf16_t*)ACT, (const bf16_t*)(ws + WS_WM2), NE * MPER0, 1024, FF / 2, MPER0 / 256, (size_t)1024 * FF, E); } if (REP_MASK >> 9 & 1) { __syncthreads(); { EpiPlainF8 E{(unsigned char*)Y, 1024, Y_SCALE}; run_gemm<EpiPlainF8, true>(lds, (const bf16_t*)ACT, (const bf16_t*)(ws + WS_WM2), NE * MPER0, 1024, FF / 2, MPER0 / 256, (size_t)1024 * FF, E); } } }
    if (IN(9)) tail_convert(A, lds, (NE * MPER0 / 256) * 4, T9_B, T9_N);
    SEAM(9);
    if (IN(10)) { row_phase<1, 3>(A, lds, NTOK, nullptr, nullptr, A.in[I_NMIX] + 1024, MOD1, 0, 1024, MOD0, MPER0, nullptr); if (REP_MASK >> 10 & 1) { __syncthreads(); row_phase<1, 3>(A, lds, NTOK, nullptr, nullptr, A.in[I_NMIX] + 1024, MOD1, 0, 1024, MOD0, MPER0, nullptr); } }
    SEAM(10);
    if (IN(11)) { { EpiHgIn E{PROJ, (const float*)(ws + WS_LB), 0}; run_gemm(lds, H, (const bf16_t*)(ws + WS_WHI), NTOK, HG_IN - 1024, 1024, 1 << 20, 0, E); } if (REP_MASK >> 11 & 1) { __syncthreads(); { EpiHgIn E{PROJ, (const float*)(ws + WS_LB), 0}; run_gemm(lds, H, (const bf16_t*)(ws + WS_WHI), NTOK, HG_IN - 1024, 1024, 1 << 20, 0, E); } } }
    if (IN(11)) tail_convert(A, lds, (NTOK / 256) * ((HG_IN - 1024) / 256), T11_B, T11_N);
    SEAM(11);
    if (IN(12)) {
        const int G = (int)gridDim.x;
        EpiHgIn Eg{PROJ, (const float*)(ws + WS_LB), 16};
        if (G > 128) { if ((int)blockIdx.x >= 128) { run_gemm(lds, H, (const bf16_t*)(ws + WS_WHI) + (size_t)4096 * 1024, NLAT, 1024, 1024, 1 << 20, 0, Eg, G - 128, (int)blockIdx.x - 128);
                                                     __syncthreads(); convert_range_fast(A, lds, T12A_B, T12A_N, (int)blockIdx.x - 128, G - 128); convert_range_fast(A, lds, T12B_B, T12B_N, (int)blockIdx.x - 128, G - 128); }
                       else { SCAN_IMPL<false>(A, lds, false); if (REP_MASK >> 12 & 1) SCAN_IMPL<false>(A, lds, false); } }
        else { SCAN_IMPL<false>(A, lds, false); __syncthreads(); run_gemm(lds, H, (const bf16_t*)(ws + WS_WHI) + (size_t)4096 * 1024, NLAT, 1024, 1024, 1 << 20, 0, Eg);
               __syncthreads(); convert_range_fast(A, lds, T12A_B, T12A_N, (int)blockIdx.x, G); convert_range_fast(A, lds, T12B_B, T12B_N, (int)blockIdx.x, G); }
    }
    SEAM(12);
    if (IN(13)) { readout_phase<false>(A, NLAT); if (REP_MASK >> 13 & 1) { __syncthreads(); readout_phase<false>(A, NLAT); } }
    SEAM(13);
    if (IN(14)) { { EpiResidT<true> E{nullptr, nullptr, X, MOD1, 2048}; run_gemm(lds, A2, (const bf16_t*)(ws + WS_WHO), NLAT, 1024, 1024, 1 << 20, 0, E); } if (REP_MASK >> 14 & 1) { __syncthreads(); { EpiResidT<true> E{nullptr, nullptr, X, MOD1, 2048}; run_gemm(lds, A2, (const bf16_t*)(ws + WS_WHO), NLAT, 1024, 1024, 1 << 20, 0, E); } } }
    SEAM(14);
    if (IN(15)) { row_phase<2, 4>(A, lds, NLAT, nullptr, nullptr, A.in[I_NFFN] + 1024, MOD1, 3 * 1024, 4 * 1024, nullptr, 0, A.in[I_ROUTER] + 1024 * 16); if (REP_MASK >> 15 & 1) { __syncthreads(); row_phase<2, 4>(A, lds, NLAT, nullptr, nullptr, A.in[I_NFFN] + 1024, MOD1, 3 * 1024, 4 * 1024, nullptr, 0, A.in[I_ROUTER] + 1024 * 16); } }
    SEAM(15);
    if (IN(16)) { topk_phase(A, lds, 128, MPER1); if (REP_MASK >> 16 & 1) { __syncthreads(); topk_phase(A, lds, 128, MPER1); } }
    if (IN(16) && (int)gridDim.x > 128) { __syncthreads(); if ((int)blockIdx.x >= 128) convert_range_fast(A, lds, T16_B, T16_N, (int)blockIdx.x - 128, (int)gridDim.x - 128); }
    else if (IN(16)) { __syncthreads(); convert_range_fast(A, lds, T16_B, T16_N, (int)blockIdx.x, (int)gridDim.x); }
    SEAM(16);
    if (IN(17)) { { EpiMoe1 E{ACT}; run_gemm<EpiMoe1, true>(lds, XE, (const bf16_t*)(ws + WS_WM1 + (size_t)16 * N1 * 1024), NE * MPER1, N1, 512, MPER1 / 256, (size_t)N1 * 1024, E); } if (REP_MASK >> 17 & 1) { __syncthreads(); { EpiMoe1 E{ACT}; run_gemm<EpiMoe1, true>(lds, XE, (const bf16_t*)(ws + WS_WM1 + (size_t)16 * N1 * 1024), NE * MPER1, N1, 512, MPER1 / 256, (size_t)N1 * 1024, E); } } }
    SEAM(17);
    if (IN(18)) { { EpiPlainF8 E{(unsigned char*)Y, 1024, Y_SCALE}; run_gemm<EpiPlainF8, true>(lds, (const bf16_t*)ACT, (const bf16_t*)(ws + WS_WM2 + (size_t)16 * 1024 * FF), NE * MPER1, 1024, FF / 2, MPER1 / 256, (size_t)1024 * FF, E); } if (REP_MASK >> 18 & 1) { __syncthreads(); { EpiPlainF8 E{(unsigned char*)Y, 1024, Y_SCALE}; run_gemm<EpiPlainF8, true>(lds, (const bf16_t*)ACT, (const bf16_t*)(ws + WS_WM2 + (size_t)16 * 1024 * FF), NE * MPER1, 1024, FF / 2, MPER1 / 256, (size_t)1024 * FF, E); } } }
    SEAM(18);
    if (IN(19)) { row_phase<5>(A, lds, NLAT, nullptr, nullptr, A.in[I_NFIN], nullptr, 0, 0, MOD1, MPER1, nullptr); if (REP_MASK >> 19 & 1) { __syncthreads(); row_phase<5>(A, lds, NLAT, nullptr, nullptr, A.in[I_NFIN], nullptr, 0, 0, MOD1, MPER1, nullptr); } }
#undef IN
#undef SEAM
}

extern "C" void kernel_launch(void* const* d_in, const int* in_sizes, int n_in, void* d_out, int out_size, void* d_ws, size_t ws_size, hipStream_t stream) {
    static int grid = 0;
    if (grid == 0) {
        if (n_in != 19 || out_size != NLAT * D || ws_size < WS_END) { fprintf(stderr, "kernel_launch: unexpected shapes (n_in %d, out %d, ws %zu < %zu)\n", n_in, out_size, ws_size, (size_t)WS_END); grid = -1; return; }
        int dev = 0, cus = 0, per_cu = 0;
        if (hipGetDevice(&dev) != hipSuccess || hipDeviceGetAttribute(&cus, hipDeviceAttributeMultiprocessorCount, dev) != hipSuccess) { grid = -1; return; }
        if (hipFuncSetAttribute((const void*)mk_fwd, hipFuncAttributeMaxDynamicSharedMemorySize, LDS_BYTES) != hipSuccess) { fprintf(stderr, "kernel_launch: hipFuncSetAttribute failed\n"); grid = -1; return; }
        if (hipOccupancyMaxActiveBlocksPerMultiprocessor(&per_cu, (const void*)mk_fwd, NTHREADS, LDS_BYTES) != hipSuccess || per_cu < 1) { fprintf(stderr, "kernel_launch: occupancy query says %d\n", per_cu); }
        (void)hipGetLastError();
        grid = cus;
    }
    if (grid < 0) return;
    (void)hipMemsetAsync((char*)d_ws + WS_BAR, 0, 16384, stream);
    Args a{};
    for (int i = 0; i < 19; ++i) a.in[i] = (const float*)d_in[i];
    a.out = (float*)d_out; a.ws = (unsigned char*)d_ws;
#if MK_PER_PHASE
    for (int p = 0; p < NPHASES; ++p) { a.ph_lo = p; a.ph_hi = p + 1; hipLaunchKernelGGL(mk_fwd, dim3(grid), dim3(NTHREADS), LDS_BYTES, stream, a); }
#else
    a.ph_lo = 0; a.ph_hi = NPHASES;
    hipLaunchKernelGGL(mk_fwd, dim3(grid), dim3(NTHREADS), LDS_BYTES, stream, a);
#endif
}
```

```cpp
#include <hip/hip_runtime.h>
#include <cstdio>
#include <cstdint>
#ifndef MK_PER_PHASE
#define MK_PER_PHASE 0
#endif
namespace pg8 {
#define PG8_LAS __attribute__((address_space(3)))
typedef unsigned short bf16_t;
typedef short bf16x8 __attribute__((ext_vector_type(8)));
typedef float f32x4 __attribute__((ext_vector_type(4)));
typedef unsigned u32x4 __attribute__((ext_vector_type(4)));
constexpr int BM = 256, BK = 64, HALF = 128, HTB = HALF * BK * 2  , STAGE_BYTES = 8 * HTB, NXCD = 8, WGM = 8;

__host__ __device__ __forceinline__ int lds_byte(int r, int c) { const int st = (r >> 4) * 2 + (c >> 5), rr = r & 15, cc = c & 31, ob = rr * 64 + cc * 2; return st * 1024 + (ob ^ (((ob >> 9) & 1) << 5)); }
__host__ __device__ __forceinline__ void stage_rc(int b, int& R, int& C) { const int st = b / 1024, sb = b % 1024, swz = sb ^ (((sb >> 9) & 1) << 5); R = (st >> 1) * 16 + swz / 64; C = (st & 1) * 32 + (swz % 64) / 2; }
__host__ __device__ __forceinline__ int perm32(int rho) { const int n = rho >> 4, i = rho & 15; return 8 * (i >> 2) + 4 * n + (i & 3); }

struct Unit { int pm, pn; };
struct Gemm { const bf16_t* A; const bf16_t* Bt; int M, N, K; int pmg; size_t bgs; };

struct StaticOrder {
    int ib = 0, ie = 1 << 30;
    int nM, nN, nwg, G, c, wgm;
    __host__ __device__ void init(int M, int N, int G_, int c_, int wgm_ = WGM) { nM = M / BM; nN = N / BM; nwg = nM * nN; G = G_; c = c_; wgm = wgm_; }
    __host__ __device__ bool next(int i, Unit& u) const {
        const long ii = (long)i + ib; if (ii >= ie) return false;
        const long L = ii * G + c; if (L >= nwg) return false;
        int wgid = (int)L; { const int q = nwg / NXCD, r = nwg % NXCD, xcd = wgid % NXCD, off = wgid / NXCD; wgid = (xcd < r ? xcd * (q + 1) : r * (q + 1) + (xcd - r) * q) + off; }
        const int nig = wgm * nN, gid = wgid / nig, fm = gid * wgm, gsz = (nM - fm) < wgm ? (nM - fm) : wgm;
        u.pm = fm + ((wgid % nig) % gsz); u.pn = (wgid % nig) / gsz; return true;
    }
    __device__ __forceinline__ void a_ready(const Unit&) const {}
    __device__ __forceinline__ void done(const Unit&) const {}
};
__device__ __forceinline__ unsigned cvt_pk_bf16(float lo, float hi) { unsigned r; asm volatile("v_cvt_pk_bf16_f32 %0, %1, %2" : "=v"(r) : "v"(lo), "v"(hi)); return r; }

template <class Epi, class Sched, bool STAMP = false, bool F8 = false>
__device__ __forceinline__ void gemm_phase(PG8_LAS unsigned char* lds, const Gemm g, const Sched& S, const Epi& E, unsigned long long* stamps) {
    const int tid = threadIdx.x, wid = __builtin_amdgcn_readfirstlane(tid >> 6), lane = tid & 63, wr = wid >> 2, wc = wid & 3, fr = lane & 15, fq = lane >> 4;
    int K_ = g.K; if constexpr (F8) { asm volatile("" : "+s"(K_)); }
    const int K = K_, nt = K / BK;
    const int f8_scale_w = 0x79797979, f8_scale_a = 0x7f7f7f7f;
    int ts_lo = 0, ts_hi = 0, nts = 0; const unsigned long long rt_entry = STAMP ? (unsigned long long)wall_clock64() : 0ull;
#define PG8_STAMP() do { if (STAMP && wid == 0 && nts < 64) { const unsigned long long _c = (unsigned long long)clock64(); \
        ts_lo = (lane == nts) ? (int)(unsigned)_c : ts_lo; ts_hi = (lane == nts) ? (int)(unsigned)(_c >> 32) : ts_hi; ++nts; } } while (0)
    PG8_STAMP();
    unsigned voffA[2], voffB[2];
#pragma unroll
    for (int i = 0; i < 2; ++i) { int R, C; stage_rc(tid * 16 + i * 8192, R, C); const int Rb = Epi::PERM ? ((R & ~31) + perm32(R & 31)) : R;
        voffA[i] = (unsigned)(R * K + C) * 2u; voffB[i] = (unsigned)(Rb * K + C) * 2u; }
    const size_t kstep = (size_t)(BK * 2);
    const size_t hstep = (size_t)HALF * K * 2;
    const size_t tstep = 2 * hstep;
    const unsigned ldsw = (unsigned)wid * 1024u;
    const int aoff = lds_byte(wr * 64 + fr, fq * 8), boff = lds_byte(wc * 32 + fr, fq * 8);
#define PG8_SA(b, h) (((b) * 2 + (h)) * HTB)
#define PG8_SB(b, h) ((4 + (b) * 2 + (h)) * HTB)
#define PG8_STAGE(bufoff, gbase, voff) do { _Pragma("unroll") for (int _i = 0; _i < 2; ++_i) \
        __builtin_amdgcn_global_load_lds((const unsigned*)((const char*)(gbase) + (voff)[_i]), (PG8_LAS unsigned*)(lds + (bufoff) + ldsw + _i * 8192), 16, 0, 0); } while (0)
#define PG8_LDA(dst, b, h) do { _Pragma("unroll") for (int m = 0; m < 4; ++m) { const bf16x8 lo_ = *(const PG8_LAS bf16x8*)(lds + PG8_SA(b, h) + aoff + m * 2048), hi_ = *(const PG8_LAS bf16x8*)(lds + PG8_SA(b, h) + aoff + m * 2048 + 1024); \
        dst[m] = __builtin_shufflevector(lo_, hi_, 0, 1, 2, 3, 4, 5, 6, 7, 8, 9, 10, 11, 12, 13, 14, 15); } } while (0)
#define PG8_LDB(dst, b, h) do { _Pragma("unroll") for (int n = 0; n < 2; ++n) { const bf16x8 lo_ = *(const PG8_LAS bf16x8*)(lds + PG8_SB(b, h) + boff + n * 2048), hi_ = *(const PG8_LAS bf16x8*)(lds + PG8_SB(b, h) + boff + n * 2048 + 1024); \
        dst[n] = __builtin_shufflevector(lo_, hi_, 0, 1, 2, 3, 4, 5, 6, 7, 8, 9, 10, 11, 12, 13, 14, 15); } } while (0)
#define PG8_MMA(ai, bj, At, Bt) do { __builtin_amdgcn_s_setprio(1); _Pragma("unroll") for (int m = 0; m < 4; ++m) _Pragma("unroll") for (int n = 0; n < 2; ++n) { \
        if constexpr (F8) { asm volatile("v_mfma_scale_f32_16x16x128_f8f6f4 %0, %1, %2, %0, %3, %4 op_sel_hi:[0,0,0]" : "+v"(acc[ai][bj][m][n]) : "v"(__builtin_bit_cast(i32x8_, Bt[n])), "v"(__builtin_bit_cast(i32x8_, At[m])), "v"(f8_scale_w), "v"(f8_scale_a)); } \
        else { acc[ai][bj][m][n] = __builtin_amdgcn_mfma_f32_16x16x32_bf16(__builtin_shufflevector(Bt[n], Bt[n], 0, 1, 2, 3, 4, 5, 6, 7), __builtin_shufflevector(At[m], At[m], 0, 1, 2, 3, 4, 5, 6, 7), acc[ai][bj][m][n], 0, 0, 0); \
               acc[ai][bj][m][n] = __builtin_amdgcn_mfma_f32_16x16x32_bf16(__builtin_shufflevector(Bt[n], Bt[n], 8, 9, 10, 11, 12, 13, 14, 15), __builtin_shufflevector(At[m], At[m], 8, 9, 10, 11, 12, 13, 14, 15), acc[ai][bj][m][n], 0, 0, 0); } } \
        __builtin_amdgcn_s_setprio(0); } while (0)
#define PG8_WAIT_V(n) asm volatile("s_waitcnt vmcnt(" #n ")" ::: "memory")
#define PG8_WAIT_L(n) asm volatile("s_waitcnt lgkmcnt(" #n ")" ::: "memory")
#define PG8_BAR __builtin_amdgcn_s_barrier()
#define PG8_SCHED __builtin_amdgcn_sched_barrier(0)
    Unit cur, nxt; int ui = 0;
    if (!S.next(0, cur)) return;
    f32x4 acc[2][2][4][2];
#pragma unroll
    for (int a = 0; a < 2; ++a)
#pragma unroll
        for (int b = 0; b < 2; ++b)
#pragma unroll
            for (int m = 0; m < 4; ++m)
#pragma unroll
                for (int n = 0; n < 2; ++n) acc[a][b][m][n] = (f32x4){0.f, 0.f, 0.f, 0.f};
    typedef short s16x16_ __attribute__((ext_vector_type(16))); typedef int i32x8_ __attribute__((ext_vector_type(8)));
    s16x16_ At[4], B0[2], B1[2];
    const char* cA = (const char*)g.A + (size_t)cur.pm * tstep; const char* cB = (const char*)g.Bt + (size_t)(cur.pm / g.pmg) * g.bgs + (size_t)cur.pn * tstep;
    S.a_ready(cur);
    PG8_STAGE(PG8_SB(0, 0), cB, voffB); PG8_STAGE(PG8_SA(0, 0), cA, voffA); PG8_STAGE(PG8_SB(0, 1), cB + hstep, voffB); PG8_STAGE(PG8_SA(0, 1), cA + hstep, voffA);
    if (wr == 1) PG8_BAR;
    PG8_WAIT_V(4); PG8_BAR;
    PG8_STAGE(PG8_SB(1, 0), cB + kstep, voffB); PG8_STAGE(PG8_SA(1, 0), cA + kstep, voffA); PG8_STAGE(PG8_SB(1, 1), cB + hstep + kstep, voffB);
    PG8_WAIT_V(6); PG8_BAR;
    PG8_STAMP();
    for (;;) {
        const bool has_next = S.next(ui + 1, nxt);
        const char* nA = has_next ? (const char*)g.A + (size_t)nxt.pm * tstep : cA; const char* nB = has_next ? (const char*)g.Bt + (size_t)(nxt.pm / g.pmg) * g.bgs + (size_t)nxt.pn * tstep : cB;
        for (int t = 0; t < nt; t += 2) {
            const bool last = (t == nt - 2);
            const char* a1 = cA + (size_t)(t + 1) * kstep;
            const char* a2 = last ? nA : cA + (size_t)(t + 2) * kstep; const char* b2 = last ? nB : cB + (size_t)(t + 2) * kstep;
            const char* a3 = a2 + kstep; const char* b3 = b2 + kstep;
            if (last && has_next) S.a_ready(nxt);
            PG8_LDB(B0, 0, 0); PG8_SCHED; PG8_LDA(At, 0, 0); PG8_STAGE(PG8_SA(1, 1), a1 + hstep, voffA);
            PG8_WAIT_L(8); PG8_BAR; PG8_WAIT_L(0); PG8_MMA(0, 0, At, B0); PG8_BAR; PG8_SCHED;
            PG8_LDB(B1, 0, 1); PG8_STAGE(PG8_SB(0, 0), b2, voffB);
            PG8_BAR; PG8_WAIT_L(0); PG8_MMA(0, 1, At, B1); PG8_BAR;
            PG8_LDA(At, 0, 1); PG8_STAGE(PG8_SA(0, 0), a2, voffA);
            PG8_BAR; PG8_WAIT_L(0); PG8_MMA(1, 0, At, B0); PG8_BAR; PG8_SCHED;
            PG8_STAGE(PG8_SB(0, 1), b2 + hstep, voffB);
            PG8_WAIT_V(6); PG8_BAR; PG8_MMA(1, 1, At, B1); PG8_BAR;
            PG8_LDB(B0, 1, 0); PG8_SCHED; PG8_LDA(At, 1, 0); PG8_STAGE(PG8_SA(0, 1), a2 + hstep, voffA);
            PG8_WAIT_L(8); PG8_BAR; PG8_WAIT_L(0); PG8_MMA(0, 0, At, B0); PG8_BAR; PG8_SCHED;
            PG8_LDB(B1, 1, 1); PG8_STAGE(PG8_SB(1, 0), b3, voffB);
            PG8_BAR; PG8_WAIT_L(0); PG8_MMA(0, 1, At, B1); PG8_BAR;
            PG8_LDA(At, 1, 1); PG8_STAGE(PG8_SA(1, 0), a3, voffA);
            PG8_BAR; PG8_WAIT_L(0); PG8_MMA(1, 0, At, B0); PG8_BAR; PG8_SCHED;
            PG8_STAGE(PG8_SB(1, 1), b3 + hstep, voffB);
            PG8_WAIT_V(6); PG8_BAR; PG8_MMA(1, 1, At, B1); PG8_BAR;
        }
        PG8_STAMP();
        if constexpr (!Epi::AFTER_DRAIN) { E(acc, cur, wr, wc, fr, fq); S.done(cur); }
        PG8_STAMP();
        if (!has_next) break;
#pragma unroll
        for (int a = 0; a < 2; ++a)
#pragma unroll
            for (int b = 0; b < 2; ++b)
#pragma unroll
                for (int m = 0; m < 4; ++m)
#pragma unroll
                    for (int n = 0; n < 2; ++n) acc[a][b][m][n] = (f32x4){0.f, 0.f, 0.f, 0.f};
        cur = nxt; cA = nA; cB = nB; ++ui;
    }
    PG8_WAIT_V(0);
    if (wr == 0) PG8_BAR;
    PG8_BAR;
    if constexpr (Epi::AFTER_DRAIN) { E.fused(acc, cur, wr, wc, fr, fq, lds, wid, lane); S.done(cur); }
    PG8_STAMP();
    if (STAMP && wid == 0) { stamps[lane] = lane < nts ? (((unsigned long long)(unsigned)ts_hi << 32) | (unsigned)ts_lo) : 0ull;
        if (lane == 62) stamps[62] = rt_entry; if (lane == 63) stamps[63] = (unsigned long long)wall_clock64(); }
#undef PG8_STAMP
#undef PG8_SA
#undef PG8_SB
#undef PG8_STAGE
#undef PG8_LDA
#undef PG8_LDB
#undef PG8_MMA
#undef PG8_WAIT_V
#undef PG8_WAIT_L
#undef PG8_BAR
#undef PG8_SCHED
}
}
#define XB_TMO      128
#define XB_XCNT(j)  (256  + 64 * (j))
#define XB_XSUB(j)  (1280 + 64 * (j))
#define XB_XGEN(j)  (2304 + 64 * (j))
#define XB_TOP      3328
#define XB_TOPGEN   3392
#define XCD_BAR_WORDS 3456
#define XB_SPIN_CAP (1u << 18)
#define LAS __attribute__((address_space(3)))

__device__ __forceinline__ unsigned xb_ld(unsigned* p)              { return __hip_atomic_load(p, __ATOMIC_RELAXED, __HIP_MEMORY_SCOPE_AGENT); }
__device__ __forceinline__ unsigned xb_add(unsigned* p, unsigned v) { return __hip_atomic_fetch_add(p, v, __ATOMIC_RELAXED, __HIP_MEMORY_SCOPE_AGENT); }
__device__ __forceinline__ unsigned xb_xcc_id() { return (unsigned)__builtin_amdgcn_s_getreg((3 << 11) | 20) & 0xFu; }
#define XB_SPIN(cond, bar) do { unsigned _sp = 0; while (cond) { __builtin_amdgcn_s_sleep(1); \
    if ((++_sp & 255u) == 0u) { if (xb_ld(&(bar)[XB_TMO])) break; if (_sp > XB_SPIN_CAP) { atomicAdd(&(bar)[XB_TMO], 1u); break; } } } } while (0)

struct XcdBarrier {
    unsigned* bar; unsigned x;
    volatile LAS unsigned* st;
};

__device__ __forceinline__ XcdBarrier xcd_barrier_post(unsigned* bar, volatile LAS unsigned* st) {
    XcdBarrier b; b.bar = bar; b.x = xb_xcc_id(); b.st = st;
    if (threadIdx.x == 0) (void)xb_add(&bar[XB_XCNT(b.x)], 1u);
    return b;
}
__device__ __forceinline__ void xcd_barrier_complete(unsigned* bar, unsigned x, unsigned& nloc, unsigned& nx) {
    const unsigned G = gridDim.x * gridDim.y * gridDim.z;
    unsigned sum, cnt, mine, sp = 0u;
    for (;;) {
        sum = 0u; cnt = 0u; mine = 0u;
#pragma unroll
        for (unsigned j = 0; j < 16; ++j) { const unsigned c = xb_ld(&bar[XB_XCNT(j)]); sum += c; cnt += (c > 0u) ? 1u : 0u; mine = (j == x) ? c : mine; }
        if (sum == G) break;
        __builtin_amdgcn_s_sleep(1);
        if ((++sp & 255u) == 0u) { if (xb_ld(&bar[XB_TMO])) break; if (sp > XB_SPIN_CAP) { atomicAdd(&bar[XB_TMO], 1u); break; } }
    }
    nloc = mine > 0u ? mine : 1u; nx = cnt > 0u ? cnt : 1u;
}

__device__ __forceinline__ void xcd_barrier(const XcdBarrier& b) {
    asm volatile("s_waitcnt vmcnt(0)" ::: "memory");
    __syncthreads();
    if (threadIdx.x == 0) {
        unsigned* bar = b.bar;
        __builtin_amdgcn_s_waitcnt(0);
        unsigned nloc = b.st[0], nx = b.st[1];
        if (nloc == 0u) { xcd_barrier_complete(bar, b.x, nloc, nx); b.st[0] = nloc; b.st[1] = nx; }
        const unsigned old = xb_add(&bar[XB_XSUB(b.x)], 1u);
        const unsigned gen = old / nloc;
        if (old + 1u == (gen + 1u) * nloc) {
            __builtin_amdgcn_fence(__ATOMIC_RELEASE, "agent");
            asm volatile("s_waitcnt vmcnt(0)" ::: "memory");
            const unsigned og = xb_add(&bar[XB_TOP], 1u);
            const unsigned tg = og / nx;
            if (og + 1u == (tg + 1u) * nx) xb_add(&bar[XB_TOPGEN], 1u);
            else XB_SPIN(xb_ld(&bar[XB_TOPGEN]) == tg, bar);
            __builtin_amdgcn_fence(__ATOMIC_ACQUIRE, "agent");
            xb_add(&bar[XB_XGEN(b.x)], 1u);
            asm volatile("s_waitcnt vmcnt(0)" ::: "memory");
        } else {
            XB_SPIN(xb_ld(&bar[XB_XGEN(b.x)]) == gen, bar);
            __builtin_amdgcn_fence(__ATOMIC_ACQUIRE, "agent");
            asm volatile("s_waitcnt vmcnt(0)" ::: "memory");
        }
    }
    __syncthreads();
}


typedef unsigned short bf16_t;
typedef float f32x4 __attribute__((ext_vector_type(4)));
typedef float f32x2 __attribute__((ext_vector_type(2)));
typedef unsigned u32x4 __attribute__((ext_vector_type(4)));
typedef unsigned u32x2 __attribute__((ext_vector_type(2)));
typedef __bf16 bf16x2_t __attribute__((ext_vector_type(2)));
#define DI __device__ __forceinline__

constexpr int D = 1024, NB = 8, SEQ = 2048, CTXL = 256;
constexpr int NLAT = NB * SEQ, NCTX = NB * CTXL, NTOK = NLAT + NCTX;
constexpr int RET_IN = 6144, HG_IN = 5120, HG_PITCH = 7168;
constexpr int NE = 16, FF = 2816, N1 = 2 * FF;
constexpr int MPER0 = 2304, MPER1 = 2048;
constexpr float EPS = 1e-6f;
constexpr int NTHREADS = 512;
constexpr int LDS_BYTES = 131072 + 256;
constexpr int MISC_OFF = 131072;

constexpr size_t al256(size_t x) { return (x + 255) & ~(size_t)255; }
constexpr size_t WS_BAR  = 0;
constexpr size_t WS_MOD  = 16384;
constexpr size_t WS_ROPE = WS_MOD + al256(2 * 9 * 6144 * 4);
constexpr size_t WS_LB   = WS_ROPE + al256((32 * 64 + 64 * 64) * 8);
constexpr size_t WS_AFF  = WS_LB + al256(2 * 1024 * 4);
constexpr size_t WS_SLOT = WS_AFF + al256((size_t)NTOK * 16 * 4);
constexpr size_t WS_WRI  = WS_SLOT + al256((size_t)NTOK * 16 * 4);
constexpr size_t WS_WRO  = WS_WRI + al256((size_t)6144 * 1024 * 2);
constexpr size_t WS_WHI  = WS_WRO + al256((size_t)1024 * 2048 * 2);
constexpr size_t WS_WHO  = WS_WHI + al256((size_t)5120 * 1024 * 2);
constexpr size_t WS_WM1  = WS_WHO + al256((size_t)1024 * 1024 * 2);
constexpr size_t WS_WM2  = WS_WM1 + al256((size_t)32 * N1 * 1024 * 2);
constexpr size_t WS_X    = WS_WM2 + al256((size_t)32 * 1024 * FF * 2);
constexpr size_t WS_H    = WS_X + al256((size_t)NTOK * 1024 * 4);
constexpr size_t WS_R1   = WS_H + al256((size_t)NTOK * 1024 * 2);
constexpr size_t WS_R2   = WS_R1 + al256((size_t)NTOK * HG_PITCH * 2);
constexpr size_t WS_A2   = WS_R2 + al256((size_t)NTOK * 2048 * 2 * 2);
constexpr size_t WS_END  = WS_A2 + al256((size_t)NTOK * 2048 * 2);
constexpr size_t R2_HALF = (size_t)NTOK * 2048 * 2;

struct Args { const float* in[19]; float* out; unsigned char* ws; int ph_lo, ph_hi; };
enum { I_X = 0, I_C, I_CTX, I_CCTX, I_WADA, I_BADA, I_NMIX, I_NFFN, I_RWIN, I_RWOUT, I_HWIN, I_HGN, I_HLB, I_HWOUT, I_ROUTER, I_WG, I_WU, I_WD, I_NFIN };

DI unsigned pk_bf16(float lo, float hi) { f32x2 v = {lo, hi}; bf16x2_t b = __builtin_convertvector(v, bf16x2_t); return __builtin_bit_cast(unsigned, b); }
DI unsigned pk4_fp8(float a, float b, float c, float d) { int p = __builtin_amdgcn_cvt_pk_fp8_f32(a, b, 0, false); p = __builtin_amdgcn_cvt_pk_fp8_f32(c, d, p, true); return (unsigned)p; }
DI float bf_lo(unsigned u) { return __uint_as_float(u << 16); }
DI float bf_hi(unsigned u) { return __uint_as_float(u & 0xffff0000u); }
DI float bf2f(bf16_t h) { return __uint_as_float(((unsigned)h) << 16); }
DI bf16_t f2bf(float f) { return (bf16_t)(pk_bf16(f, 0.f) & 0xffffu); }
DI float fast_sigmoid(float x) { return __builtin_amdgcn_rcpf(1.0f + __expf(-x)); }
DI float silu_f(float x) { return x * fast_sigmoid(x); }
DI float wave_sum(float v) {
#pragma unroll
    for (int o = 32; o >= 1; o >>= 1) v += __shfl_xor(v, o);
    return v;
}
DI int mod_row(int row) { return row < NLAT ? (row >> 11) : 8; }

struct EpiRetIn {
    static constexpr bool PERM = true, AFTER_DRAIN = false;
    bf16_t* O; const f32x2* ropeR; const f32x2* ropeC;
    DI void operator()(const f32x4 (&acc)[2][2][4][2], const pg8::Unit& u, int wr, int wc, int fr, int fq) const {
        const int row0 = u.pm * 256 + wr * 64 + fr, col0 = u.pn * 256 + wc * 32 + 8 * fq;
        const bool rot = (u.pn < 8) && (u.pm < 64);
#pragma unroll
        for (int ai = 0; ai < 2; ++ai)
#pragma unroll
            for (int m = 0; m < 4; ++m) {
                const int row = row0 + ai * 128 + m * 16; bf16_t* rowp = O + (size_t)row * RET_IN + col0;
                const int t = row & 2047;
#pragma unroll
                for (int bj = 0; bj < 2; ++bj) {
                    f32x4 v0 = acc[ai][bj][m][0], v1 = acc[ai][bj][m][1];
                    if (rot) {
                        const f32x2* tb = bj ? (ropeC + (size_t)(t & 63) * 64) : (ropeR + (size_t)(t >> 6) * 64);
                        const int i0 = 16 * wc + 4 * fq;
                        const f32x4 cs0 = *(const f32x4*)(tb + i0), cs1 = *(const f32x4*)(tb + i0 + 2);
                        f32x4 o0, o1;
                        o0[0] = v0[0] * cs0[0] - v0[1] * cs0[1]; o0[1] = v0[0] * cs0[1] + v0[1] * cs0[0];
                        o0[2] = v0[2] * cs0[2] - v0[3] * cs0[3]; o0[3] = v0[2] * cs0[3] + v0[3] * cs0[2];
                        o1[0] = v1[0] * cs1[0] - v1[1] * cs1[1]; o1[1] = v1[0] * cs1[1] + v1[1] * cs1[0];
                        o1[2] = v1[2] * cs1[2] - v1[3] * cs1[3]; o1[3] = v1[2] * cs1[3] + v1[3] * cs1[2];
                        v0 = o0; v1 = o1;
                    }
                    u32x4 w; w.x = pk_bf16(v0[0], v0[1]); w.y = pk_bf16(v0[2], v0[3]); w.z = pk_bf16(v1[0], v1[1]); w.w = pk_bf16(v1[2], v1[3]);
                    *(u32x4*)(rowp + bj * 128) = w;
                }
            }
    }
};
struct EpiHgIn {
    static constexpr bool PERM = true, AFTER_DRAIN = false;
    bf16_t* O; const float* lb; int pn_off;
    DI void operator()(const f32x4 (&acc)[2][2][4][2], const pg8::Unit& u, int wr, int wc, int fr, int fq) const {
        const int pn = u.pn + pn_off;
        const int row0 = u.pm * 256 + wr * 64 + fr, col0 = pn * 256 + wc * 32 + 8 * fq;
        const int region = pn >> 2;
        f32x4 lbv[2][2];
        if (region == 1 || region == 2) {
#pragma unroll
            for (int bj = 0; bj < 2; ++bj)
#pragma unroll
                for (int n = 0; n < 2; ++n) lbv[bj][n] = *(const f32x4*)(lb + (col0 - 1024) + bj * 128 + 4 * n);
        }
#pragma unroll
        for (int ai = 0; ai < 2; ++ai)
#pragma unroll
            for (int m = 0; m < 4; ++m) {
                const int row = row0 + ai * 128 + m * 16; bf16_t* rowp = O + (size_t)row * HG_PITCH + col0;
#pragma unroll
                for (int bj = 0; bj < 2; ++bj) {
                    f32x4 v0 = acc[ai][bj][m][0], v1 = acc[ai][bj][m][1];
                    if (region == 0) {
#pragma unroll
                        for (int j = 0; j < 4; ++j) { v0[j] = silu_f(v0[j]); v1[j] = silu_f(v1[j]); }
                    } else if (region == 1 || region == 2) {
                        f32x4 g0, g1;
#pragma unroll
                        for (int j = 0; j < 4; ++j) {
                            const float l0 = lbv[bj][0][j], l1 = lbv[bj][1][j];
                            const float s0 = fast_sigmoid(v0[j]), s1 = fast_sigmoid(v1[j]);
                            const float f0 = l0 + (1.f - l0) * s0, f1 = l1 + (1.f - l1) * s1;
                            g0[j] = __logf(f0); g1[j] = __logf(f1);
                            v0[j] = (1.f - l0) * (1.f - s0); v1[j] = (1.f - l1) * (1.f - s1);
                        }
                        u32x4 wg; wg.x = pk_bf16(g0[0], g0[1]); wg.y = pk_bf16(g0[2], g0[3]); wg.z = pk_bf16(g1[0], g1[1]); wg.w = pk_bf16(g1[2], g1[3]);
                        *(u32x4*)(rowp + 4096 + bj * 128) = wg;
                    }
                    u32x4 w; w.x = pk_bf16(v0[0], v0[1]); w.y = pk_bf16(v0[2], v0[3]); w.z = pk_bf16(v1[0], v1[1]); w.w = pk_bf16(v1[2], v1[3]);
                    *(u32x4*)(rowp + bj * 128) = w;
                }
            }
    }
};
template <bool SRC16>
struct EpiResidT {
    static constexpr bool PERM = false, AFTER_DRAIN = false;
    const float* src_lat; const float* src_ctx; bf16_t* X; const float* mod; int goff;
    DI void operator()(const f32x4 (&acc)[2][2][4][2], const pg8::Unit& u, int wr, int wc, int fr, int fq) const {
        const int row0 = u.pm * 256 + wr * 64 + fr, col0 = u.pn * 256 + wc * 32 + 4 * fq;
        const int mr = (u.pm < 64) ? (u.pm >> 3) : 8;
        f32x4 gv[2][2];
#pragma unroll
        for (int bj = 0; bj < 2; ++bj)
#pragma unroll
            for (int n = 0; n < 2; ++n) gv[bj][n] = *(const f32x4*)(mod + (size_t)mr * 6144 + goff + col0 + bj * 128 + n * 16);
#pragma unroll
        for (int ai = 0; ai < 2; ++ai)
#pragma unroll
            for (int m = 0; m < 4; ++m) {
                const int row = row0 + ai * 128 + m * 16;
                bf16_t* xp = X + (size_t)row * D + col0;
                if constexpr (SRC16) {
#pragma unroll
                    for (int bj = 0; bj < 2; ++bj)
#pragma unroll
                        for (int n = 0; n < 2; ++n) { const u32x2 t = *(const u32x2*)(xp + bj * 128 + n * 16); const f32x4 s = {bf_lo(t.x), bf_hi(t.x), bf_lo(t.y), bf_hi(t.y)};
                            const f32x4 v = s + gv[bj][n] * acc[ai][bj][m][n]; u32x2 o; o.x = pk_bf16(v[0], v[1]); o.y = pk_bf16(v[2], v[3]); *(u32x2*)(xp + bj * 128 + n * 16) = o; }
                } else {
                    const float* sp = (row < NLAT ? src_lat + (size_t)row * D : src_ctx + (size_t)(row - NLAT) * D) + col0;
#pragma unroll
                    for (int bj = 0; bj < 2; ++bj)
#pragma unroll
                        for (int n = 0; n < 2; ++n) { const f32x4 s = *(const f32x4*)(sp + bj * 128 + n * 16);
                            const f32x4 v = s + gv[bj][n] * acc[ai][bj][m][n]; u32x2 o; o.x = pk_bf16(v[0], v[1]); o.y = pk_bf16(v[2], v[3]); *(u32x2*)(xp + bj * 128 + n * 16) = o; }
                }
            }
    }
};
struct EpiMoe1 {
    static constexpr bool PERM = true, AFTER_DRAIN = false;
    unsigned char* O;
    DI void operator()(const f32x4 (&acc)[2][2][4][2], const pg8::Unit& u, int wr, int wc, int fr, int fq) const {
        const int row0 = u.pm * 256 + wr * 64 + fr, col0 = u.pn * 128 + wc * 32 + 8 * fq;
#pragma unroll
        for (int ai = 0; ai < 2; ++ai)
#pragma unroll
            for (int m = 0; m < 4; ++m) {
                unsigned char* rowp = O + (size_t)(row0 + ai * 128 + m * 16) * FF + col0;
                f32x4 a0 = acc[ai][0][m][0], a1 = acc[ai][0][m][1]; const f32x4 u0 = acc[ai][1][m][0], u1 = acc[ai][1][m][1];
#pragma unroll
                for (int j = 0; j < 4; ++j) { a0[j] = silu_f(a0[j]) * u0[j]; a1[j] = silu_f(a1[j]) * u1[j]; }
                u32x2 w; w.x = pk4_fp8(a0[0], a0[1], a0[2], a0[3]); w.y = pk4_fp8(a1[0], a1[1], a1[2], a1[3]);
                *(u32x2*)rowp = w;
            }
    }
};
struct EpiPlainBf16 {
    static constexpr bool PERM = true, AFTER_DRAIN = false;
    bf16_t* O; int ldc;
    DI void operator()(const f32x4 (&acc)[2][2][4][2], const pg8::Unit& u, int wr, int wc, int fr, int fq) const {
        const int row0 = u.pm * 256 + wr * 64 + fr, col0 = u.pn * 256 + wc * 32 + 8 * fq;
#pragma unroll
        for (int ai = 0; ai < 2; ++ai)
#pragma unroll
            for (int m = 0; m < 4; ++m) {
                bf16_t* rowp = O + (size_t)(row0 + ai * 128 + m * 16) * ldc + col0;
#pragma unroll
                for (int bj = 0; bj < 2; ++bj) {
                    const f32x4 v0 = acc[ai][bj][m][0], v1 = acc[ai][bj][m][1];
                    u32x4 w; w.x = pk_bf16(v0[0], v0[1]); w.y = pk_bf16(v0[2], v0[3]); w.z = pk_bf16(v1[0], v1[1]); w.w = pk_bf16(v1[2], v1[3]);
                    *(u32x4*)(rowp + bj * 128) = w;
                }
            }
    }
};

struct EpiPlainF8 {
    static constexpr bool PERM = true, AFTER_DRAIN = false;
    unsigned char* O; int ldc; float sc;
    DI void operator()(const f32x4 (&acc)[2][2][4][2], const pg8::Unit& u, int wr, int wc, int fr, int fq) const {
        const int row0 = u.pm * 256 + wr * 64 + fr, col0 = u.pn * 256 + wc * 32 + 8 * fq;
#pragma unroll
        for (int ai = 0; ai < 2; ++ai)
#pragma unroll
            for (int m = 0; m < 4; ++m) {
                unsigned char* rowp = O + (size_t)(row0 + ai * 128 + m * 16) * ldc + col0;
#pragma unroll
                for (int bj = 0; bj < 2; ++bj) {
                    const f32x4 v0 = acc[ai][bj][m][0] * sc, v1 = acc[ai][bj][m][1] * sc;
                    u32x2 w; w.x = pk4_fp8(v0[0], v0[1], v0[2], v0[3]); w.y = pk4_fp8(v1[0], v1[1], v1[2], v1[3]);
                    *(u32x2*)(rowp + bj * 128) = w;
                }
            }
    }
};
constexpr float Y_SCALE = 8.0f;

struct CvtTile { const float* src; unsigned char* dst; int ldsrc, rowbytes, col0, kind, n0, k0, f8; float scale; };
constexpr int CT0 = 0, CT1 = CT0 + 96 * 4, CT2 = CT1 + 16 * 8, CT3 = CT2 + 80 * 4, CT4 = CT3 + 16 * 4, CT5 = CT4 + 32 * 88 * 4, CT_END = CT5 + 32 * 16 * 11;
constexpr int GEMV_UNITS = 256;
DI CvtTile cvt_decode(const Args& A, int t) {
    unsigned char* ws = A.ws; CvtTile c;
    if (t < CT1) {
        const int nt = t < 128 ? (t & 31) : 32 + ((t - 128) & 63), kt = t < 128 ? (t >> 5) : ((t - 128) >> 6), n0 = nt * 64;
        c.src = A.in[I_RWIN]; c.ldsrc = 6144; c.col0 = n0; c.kind = n0 < 2048 ? 1 : 0; c.scale = (n0 >= 1024 && n0 < 2048) ? 0.0625f : 1.0f; c.dst = ws + WS_WRI; c.rowbytes = 2048; c.n0 = n0; c.k0 = kt * 256; c.f8 = 0;
    } else if (t < CT2) {
        const int q = t - CT1, nt = q % 16, kt = q / 16;
        c.src = A.in[I_RWOUT]; c.ldsrc = 1024; c.col0 = nt * 64; c.kind = 0; c.scale = 64.0f; c.dst = ws + WS_WRO; c.rowbytes = 2048; c.n0 = nt * 64; c.k0 = kt * 256; c.f8 = 1;
    } else if (t < CT3) {
        const int q = t - CT2, nt = q % 80, kt = q / 80;
        c.src = A.in[I_HWIN]; c.ldsrc = 5120; c.col0 = nt * 64; c.kind = 0; c.scale = 1.0f; c.dst = ws + WS_WHI; c.rowbytes = 2048; c.n0 = nt * 64; c.k0 = kt * 256; c.f8 = 0;
    } else if (t < CT4) {
        const int q = t - CT3, nt = q % 16, kt = q / 16;
        c.src = A.in[I_HWOUT]; c.ldsrc = 1024; c.col0 = nt * 64; c.kind = 0; c.scale = 1.0f; c.dst = ws + WS_WHO; c.rowbytes = 2048; c.n0 = nt * 64; c.k0 = kt * 256; c.f8 = 0;
    } else if (t < CT5) {
        const int q = t - CT4, le = q / 352, r = q % 352, nt = r % 88, kt = r / 88, n0 = nt * 64;
        const int tt = n0 >> 8, j0 = n0 & 255;
        c.src = ((j0 < 128) ? A.in[I_WG] : A.in[I_WU]) + (size_t)le * 1024 * FF; c.ldsrc = FF; c.col0 = tt * 128 + (j0 & 127); c.kind = 0; c.scale = 64.0f;
        c.dst = ws + WS_WM1 + (size_t)le * N1 * 1024; c.rowbytes = 1024; c.n0 = n0; c.k0 = kt * 256; c.f8 = 1;
    } else {
        const int q = t - CT5, le = q / 176, r = q % 176, nt = r % 16, kt = r / 16;
        c.src = A.in[I_WD] + (size_t)le * FF * 1024; c.ldsrc = 1024; c.col0 = nt * 64; c.kind = 0; c.scale = 64.0f; c.dst = ws + WS_WM2 + (size_t)le * 1024 * FF; c.rowbytes = FF; c.n0 = nt * 64; c.k0 = kt * 256; c.f8 = 1;
    }
    return c;
}
#define CVT_LOAD(c, rr) do { int col_ = (c).col0 + lane; if ((c).kind == 1) { const int np = (c).n0 + lane, p = np & 255, hh = p >> 7, i = (p & 127) >> 1, wh = p & 1; col_ = (np - p) + hh * 128 + wh * 64 + i; } \
        const float* sp_ = (c).src + (size_t)(c).k0 * (c).ldsrc + col_; \
        if ((c).f8) { _Pragma("unroll") for (int it = 0; it < 8; ++it) _Pragma("unroll") for (int q = 0; q < 4; ++q) rr[4 * it + q] = __builtin_nontemporal_load(sp_ + (size_t)(32 * it + 4 * w + q) * (c).ldsrc); } \
        else { _Pragma("unroll") for (int it = 0; it < 16; ++it) { const int k = 16 * it + 2 * w; rr[2 * it] = __builtin_nontemporal_load(sp_ + (size_t)k * (c).ldsrc); rr[2 * it + 1] = __builtin_nontemporal_load(sp_ + (size_t)(k + 1) * (c).ldsrc); } } } while (0)

constexpr int WM2L0 = CT5, WM1L1 = CT4 + 5632, WM2L1 = CT5 + 2816;
constexpr int T2_B = WM2L0,  T2_N = 320;
constexpr int T5_B = T2_B + T2_N, T5_N = 2016;
constexpr int T8_B = T5_B + T5_N, T8_N = 480;
constexpr int T9_B = WM1L1, T9_N = 1920;
constexpr int T11_B = T9_B + T9_N, T11_N = 768;
constexpr int T12A_B = T11_B + T11_N, T12A_N = 384;
constexpr int T12B_B = WM2L1, T12B_N = CT_END - WM2L1;
constexpr int T7_N = 640, T7_B = WM1L1 - T7_N;
constexpr int T16_B = T12A_B + T12A_N, T16_N = 768;
constexpr int T2X_N = 384, T2X_B = T7_B - T2X_N;
constexpr int I2_B = CT1, I2_N = T2X_B - CT1;
constexpr int I8_B = T16_B + T16_N, I8_N = CT5 - I8_B;
constexpr int PRO_N0 = CT1, PRO_B1 = CT5, PRO_N1 = 0, PRO_B2 = T8_B + T8_N, PRO_N2 = WM2L1 - PRO_B2;
static_assert(T8_B + T8_N <= WM2L1 && T12A_B + T12A_N <= CT5 && PRO_N1 >= 0 && PRO_N2 >= 0, "conversion schedule");
DI int cvt_map(int mode, int base, int v) {
    if (mode == 0) return base + v;
    return v < PRO_N0 ? v : (v < PRO_N0 + PRO_N1 ? PRO_B1 + (v - PRO_N0) : PRO_B2 + (v - PRO_N0 - PRO_N1));
}
#define CVT_STEP(rr, cur, vload)  do { \
        if ((cur).f8) { _Pragma("unroll") for (int it = 0; it < 8; ++it) L[lane * 129 + 8 * it + w] = pk4_fp8(rr[4 * it] * (cur).scale, rr[4 * it + 1] * (cur).scale, rr[4 * it + 2] * (cur).scale, rr[4 * it + 3] * (cur).scale); } \
        else { _Pragma("unroll") for (int it = 0; it < 16; ++it) L[lane * 129 + 8 * it + w] = pk_bf16(rr[2 * it] * (cur).scale, rr[2 * it + 1] * (cur).scale); } \
        __syncthreads(); \
        const CvtTile old_ = (cur); \
        (cur) = cvt_decode(A, cvt_map(mode, base, (vload) < count ? (vload) : 0)); \
        if ((vload) < count) CVT_LOAD((cur), rr); \
        if (old_.f8) { _Pragma("unroll") for (int j = 0; j < 2; ++j) { const int id = tid + 512 * j, row = id >> 4, ch = id & 15; \
                u32x4 vv; vv.x = L[row * 129 + 4 * ch]; vv.y = L[row * 129 + 4 * ch + 1]; vv.z = L[row * 129 + 4 * ch + 2]; vv.w = L[row * 129 + 4 * ch + 3]; \
                __builtin_nontemporal_store(vv, (u32x4*)(old_.dst + (size_t)(old_.n0 + row) * old_.rowbytes + old_.k0 + 16 * ch)); } } \
        else { _Pragma("unroll") for (int j = 0; j < 4; ++j) { const int id = tid + 512 * j, row = id >> 5, ch = id & 31; \
                u32x4 vv; vv.x = L[row * 129 + 4 * ch]; vv.y = L[row * 129 + 4 * ch + 1]; vv.z = L[row * 129 + 4 * ch + 2]; vv.w = L[row * 129 + 4 * ch + 3]; \
                __builtin_nontemporal_store(vv, (u32x4*)(old_.dst + (size_t)(old_.n0 + row) * old_.rowbytes + 2 * old_.k0 + 16 * ch)); } } \
        __syncthreads(); } while (0)
DI void convert_range(const Args& A, LAS unsigned char* lds, int mode, int base, int count, int first, int stride) {
    const int tid = threadIdx.x, lane = tid & 63, w = tid >> 6;
    LAS unsigned* L = (LAS unsigned*)lds;
    float ra[32], rb[32];
    int v = first;
    CvtTile ca = cvt_decode(A, cvt_map(mode, base, v < count ? v : 0));
    CvtTile cb = cvt_decode(A, cvt_map(mode, base, v + stride < count ? v + stride : 0));
    if (v < count) CVT_LOAD(ca, ra);
    if (v + stride < count) CVT_LOAD(cb, rb);
    while (v < count) {
        CVT_STEP(ra, ca, v + 2 * stride);
        if (v + stride < count) CVT_STEP(rb, cb, v + 3 * stride);
        v += 2 * stride;
    }
}
#undef CVT_STEP
#define CVTF_LOAD(c, rr) do { const float* sp_ = (c).src + (size_t)(c).k0 * (c).ldsrc + (c).col0 + 4 * l16; \
        if ((c).f8) { _Pragma("unroll") for (int it = 0; it < 2; ++it) _Pragma("unroll") for (int q = 0; q < 4; ++q) rr[4 * it + q] = __builtin_nontemporal_load((const f32x4*)(sp_ + (size_t)(128 * it + 4 * kq + q) * (c).ldsrc)); } \
        else { _Pragma("unroll") for (int it = 0; it < 4; ++it) _Pragma("unroll") for (int q = 0; q < 2; ++q) rr[2 * it + q] = __builtin_nontemporal_load((const f32x4*)(sp_ + (size_t)(64 * it + 2 * kq + q) * (c).ldsrc)); } } while (0)
#define CVTF_STEP(rr, cur, vload)  do { const float sc_ = (cur).scale; \
        if ((cur).f8) { _Pragma("unroll") for (int it = 0; it < 2; ++it) _Pragma("unroll") for (int j = 0; j < 4; ++j) \
                L[(4 * l16 + j) * 129 + 32 * it + kq] = pk4_fp8(rr[4 * it][j] * sc_, rr[4 * it + 1][j] * sc_, rr[4 * it + 2][j] * sc_, rr[4 * it + 3][j] * sc_); } \
        else { _Pragma("unroll") for (int it = 0; it < 4; ++it) _Pragma("unroll") for (int j = 0; j < 4; ++j) L[(4 * l16 + j) * 129 + 32 * it + kq] = pk_bf16(rr[2 * it][j] * sc_, rr[2 * it + 1][j] * sc_); } \
        __syncthreads(); \
        const CvtTile old_ = (cur); \
        (cur) = cvt_decode(A, base + ((vload) < count ? (vload) : 0)); \
        if ((vload) < count) CVTF_LOAD((cur), rr); \
        if (old_.f8) { _Pragma("unroll") for (int j = 0; j < 2; ++j) { const int id = tid + 512 * j, row = id >> 4, ch = id & 15; \
                u32x4 vv; vv.x = L[row * 129 + 4 * ch]; vv.y = L[row * 129 + 4 * ch + 1]; vv.z = L[row * 129 + 4 * ch + 2]; vv.w = L[row * 129 + 4 * ch + 3]; \
                __builtin_nontemporal_store(vv, (u32x4*)(old_.dst + (size_t)(old_.n0 + row) * old_.rowbytes + old_.k0 + 16 * ch)); } } \
        else { _Pragma("unroll") for (int j = 0; j < 4; ++j) { const int id = tid + 512 * j, row = id >> 5, ch = id & 31; \
                u32x4 vv; vv.x = L[row * 129 + 4 * ch]; vv.y = L[row * 129 + 4 * ch + 1]; vv.z = L[row * 129 + 4 * ch + 2]; vv.w = L[row * 129 + 4 * ch + 3]; \
                __builtin_nontemporal_store(vv, (u32x4*)(old_.dst + (size_t)(old_.n0 + row) * old_.rowbytes + 2 * old_.k0 + 16 * ch)); } } \
        __syncthreads(); } while (0)
DI void convert_range_fast(const Args& A, LAS unsigned char* lds, int base, int count, int first, int stride) {
    const int tid = threadIdx.x, l16 = tid & 15, kq = tid >> 4;
    LAS unsigned* L = (LAS unsigned*)lds;
    f32x4 ra[8], rb[8];
    int v = first;
    CvtTile ca = cvt_decode(A, base + (v < count ? v : 0));
    CvtTile cb = cvt_decode(A, base + (v + stride < count ? v + stride : 0));
    if (v < count) CVTF_LOAD(ca, ra);
    if (v + stride < count) CVTF_LOAD(cb, rb);
    while (v < count) {
        CVTF_STEP(ra, ca, v + 2 * stride);
        if (v + stride < count) CVTF_STEP(rb, cb, v + 3 * stride);
        v += 2 * stride;
    }
}
#undef CVTF_STEP
#undef CVTF_LOAD
DI void tail_convert(const Args& A, LAS unsigned char* lds, int nwg, int base, int count) {
    const int G = (int)gridDim.x, c = (int)blockIdx.x, rem = nwg % G;
    __syncthreads();
    if (rem == 0) convert_range_fast(A, lds, base, count, c, G);
    else if (c >= rem) convert_range_fast(A, lds, base, count, c - rem, G - rem);
}
#undef CVT_LOAD

DI void p0_prologue(const Args& A, LAS unsigned char* lds) {
    const int tid = threadIdx.x, lane = tid & 63, w = tid >> 6, G = gridDim.x;
    unsigned char* ws = A.ws;
    bool have_s = false;
    LAS float* S = (LAS float*)lds;
    LAS float* RED = (LAS float*)(lds + 9 * 1024 * 4);
    for (int u = blockIdx.x; u < GEMV_UNITS; u += G) {
        if (!have_s) {
            for (int i = tid; i < 9 * 1024; i += NTHREADS) { const int r = i >> 10, k = i & 1023; const float c = (r < 8) ? A.in[I_C][r * 1024 + k] : A.in[I_CCTX][k]; S[i] = silu_f(c); }
            have_s = true;
        }
        __syncthreads();
        const int l = u >> 7, n0 = (u & 127) * 48, cl = lane < 48 ? lane : 47;
        const float* W = A.in[I_WADA] + (size_t)l * 1024 * 6144 + n0 + cl;
        float acc[9];
#pragma unroll
        for (int r = 0; r < 9; ++r) acc[r] = 0.f;
        for (int k0 = 128 * w; k0 < 128 * w + 128; k0 += 16) {
            float wv[16];
#pragma unroll
            for (int q = 0; q < 16; ++q) wv[q] = __builtin_nontemporal_load(W + (size_t)(k0 + q) * 6144);
#pragma unroll
            for (int q4 = 0; q4 < 4; ++q4)
#pragma unroll
                for (int r = 0; r < 9; ++r) { const f32x4 s = *(const LAS f32x4*)(S + r * 1024 + k0 + 4 * q4); acc[r] += s[0] * wv[4 * q4] + s[1] * wv[4 * q4 + 1] + s[2] * wv[4 * q4 + 2] + s[3] * wv[4 * q4 + 3]; }
        }
#pragma unroll
        for (int r = 0; r < 9; ++r) RED[(w * 9 + r) * 64 + lane] = acc[r];
        __syncthreads();
        for (int i = tid; i < 9 * 64; i += NTHREADS) {
            const int r = i >> 6, c = i & 63;
            if (c < 48) {
                float s = 0.f;
#pragma unroll
                for (int ww = 0; ww < 8; ++ww) s += RED[(ww * 9 + r) * 64 + c];
                ((float*)(ws + WS_MOD))[(size_t)(l * 9 + r) * 6144 + n0 + c] = s + A.in[I_BADA][l * 6144 + n0 + c];
            }
        }
        __syncthreads();
    }
    if (blockIdx.x == (unsigned)(G - 1)) {
        f32x2* R = (f32x2*)(ws + WS_ROPE);
        for (int i = tid; i < (32 + 64) * 64; i += NTHREADS) {
            const int pos = (i < 2048) ? (i >> 6) : ((i - 2048) >> 6), f = i & 63;
            const float inv = exp2f(-(float)f * (13.287712379549449f / 64.0f));
            float s, c; sincosf((float)pos * inv, &s, &c); R[i] = (f32x2){c, s};
        }
    }
    if (blockIdx.x == (unsigned)(G - 2 >= 0 ? G - 2 : 0)) {
        float* LB = (float*)(ws + WS_LB);
        for (int i = tid; i < 2048; i += NTHREADS) { const float h0 = A.in[I_HLB][i], h1 = A.in[I_HLB][2048 + i]; LB[i] = 1.0f / (1.0f + __expf(h0 - h1)); }
    }
    __syncthreads();
    const int Gh = (G + 1) >> 1, c = (int)blockIdx.x;
    if (c < Gh) convert_range(A, lds, 0, 0, 128, c, Gh);
    __syncthreads();
    if (G == 1 || c >= Gh) convert_range_fast(A, lds, 128, 256, G == 1 ? 0 : c - Gh, G == 1 ? 1 : G - Gh);
}

template <int MODE, int NR = 2>
DI void row_phase(const Args& A, LAS unsigned char* lds, int nrows, const float* src_lat, const float* src_ctx, const float* normw, const float* mod, int sh_off, int sc_off,
                  const float* cmod, int mper, const float* wrouter) {
    const int tid = threadIdx.x, lane = tid & 63, w = tid >> 6, G = gridDim.x;
    unsigned char* ws = A.ws;
    bf16_t* XB = (bf16_t*)(ws + WS_X); bf16_t* H = (bf16_t*)(ws + WS_H); float* AFF = (float*)(ws + WS_AFF); const int* SLOT = (const int*)(ws + WS_SLOT);
    const unsigned char* Y = ws + WS_R2 + R2_HALF;
    LAS float* WR = (LAS float*)lds;
    if (MODE & 2) {
        for (int i = tid; i < 1024 * 4; i += NTHREADS) { const int k = i >> 2, e4 = i & 3; *(LAS f32x4*)(WR + 4 * (((((k >> 8) * 4 + (k & 3)) * 4 + e4) * 64) + ((k >> 2) & 63))) = *(const f32x4*)(wrouter + 4 * i); }
        __syncthreads();
    }
    f32x4 nw[4];
#pragma unroll
    for (int j = 0; j < 4; ++j) nw[j] = *(const f32x4*)(normw + 256 * j + 4 * lane);
    for (int r0 = (blockIdx.x * 8 + w) * NR; r0 < nrows; r0 += G * 8 * NR) {
        f32x4 x[NR][4]; int sv[NR]; float av[NR];
#pragma unroll
        for (int r = 0; r < NR; ++r) {
            const int row = r0 + r;
            if (MODE == 0) {
                const float* sp = (row < NLAT) ? src_lat + (size_t)row * D : src_ctx + (size_t)(row - NLAT) * D;
#pragma unroll
                for (int j = 0; j < 4; ++j) x[r][j] = *(const f32x4*)(sp + 256 * j + 4 * lane);
            } else {
                const bf16_t* sp = XB + (size_t)row * D;
#pragma unroll
                for (int j = 0; j < 4; ++j) { const u32x2 t = *(const u32x2*)(sp + 256 * j + 4 * lane); x[r][j] = (f32x4){bf_lo(t.x), bf_hi(t.x), bf_lo(t.y), bf_hi(t.y)}; }
            }
            if (MODE & 1) { sv[r] = SLOT[(size_t)row * 16 + (lane & 15)]; av[r] = AFF[(size_t)row * 16 + (lane & 15)]; }
        }
#pragma unroll
        for (int r = 0; r < NR; ++r) {
            const int row = r0 + r;
            const int mr = mod_row(row);
            if (MODE & 1) {
                f32x4 acc[4];
#pragma unroll
                for (int j = 0; j < 4; ++j) acc[j] = (f32x4){0.f, 0.f, 0.f, 0.f};
                const int base = (row < NLAT) ? ((row >> 11) * 256) : (2048 + ((row - NLAT) >> 8) * 32);
                unsigned m = (unsigned)__builtin_amdgcn_readfirstlane((int)(__ballot(sv[r] >= 0) & 0xffffull));
                while (m) {
                    float gts[4]; const unsigned char* yps[4];
#pragma unroll
                    for (int q = 0; q < 4; ++q) {
                        if (m) { const int e = __builtin_ctz(m); m &= m - 1u; const int slot = __builtin_amdgcn_readlane(sv[r], e); gts[q] = (1.0f / Y_SCALE) * __int_as_float(__builtin_amdgcn_readlane(__float_as_int(av[r]), e)); yps[q] = Y + ((size_t)e * mper + base + slot) * D; }
                        else { gts[q] = 0.f; yps[q] = Y; }
                    }
                    unsigned yv[4][4];
#pragma unroll
                    for (int q = 0; q < 4; ++q)
#pragma unroll
                        for (int j = 0; j < 4; ++j) yv[q][j] = __builtin_nontemporal_load((const unsigned*)(yps[q] + 256 * j + 4 * lane));
#pragma unroll
                    for (int q = 0; q < 4; ++q)
#pragma unroll
                        for (int j = 0; j < 4; ++j) { const f32x2 lo = __builtin_amdgcn_cvt_pk_f32_fp8((int)yv[q][j], false), hi = __builtin_amdgcn_cvt_pk_f32_fp8((int)yv[q][j], true);
                            acc[j][0] += gts[q] * lo[0]; acc[j][1] += gts[q] * lo[1]; acc[j][2] += gts[q] * hi[0]; acc[j][3] += gts[q] * hi[1]; }
                }
#pragma unroll
                for (int j = 0; j < 4; ++j) { const f32x4 g = *(const f32x4*)(cmod + (size_t)mr * 6144 + 5 * 1024 + 256 * j + 4 * lane); x[r][j] += g * acc[j]; }
                if (!(MODE & 4)) {
#pragma unroll
                    for (int j = 0; j < 4; ++j) { u32x2 o; o.x = pk_bf16(x[r][j][0], x[r][j][1]); o.y = pk_bf16(x[r][j][2], x[r][j][3]); *(u32x2*)(XB + (size_t)row * D + 256 * j + 4 * lane) = o; }
                }
            }
            float ss = 0.f;
#pragma unroll
            for (int j = 0; j < 4; ++j) ss += x[r][j][0] * x[r][j][0] + x[r][j][1] * x[r][j][1] + x[r][j][2] * x[r][j][2] + x[r][j][3] * x[r][j][3];
            ss = wave_sum(ss);
            const float rs = rsqrtf(ss * (1.0f / 1024.0f) + EPS);
            if (MODE & 4) {
#pragma unroll
                for (int j = 0; j < 4; ++j) __builtin_nontemporal_store(x[r][j] * rs * nw[j], (f32x4*)(A.out + (size_t)row * D + 256 * j + 4 * lane));
            } else {
                f32x4 h[4];
#pragma unroll
                for (int j = 0; j < 4; ++j) {
                    const f32x4 sh = *(const f32x4*)(mod + (size_t)mr * 6144 + sh_off + 256 * j + 4 * lane), sc = *(const f32x4*)(mod + (size_t)mr * 6144 + sc_off + 256 * j + 4 * lane);
                    h[j] = (x[r][j] * rs * nw[j]) * (1.0f + sc) + sh;
                    if (MODE & 2) { *(unsigned*)((unsigned char*)H + (size_t)row * D + 256 * j + 4 * lane) = pk4_fp8(h[j][0], h[j][1], h[j][2], h[j][3]); }
                    else { u32x2 o; o.x = pk_bf16(h[j][0], h[j][1]); o.y = pk_bf16(h[j][2], h[j][3]); *(u32x2*)(H + (size_t)row * D + 256 * j + 4 * lane) = o; }
                }
                if (MODE & 2) {
                    float lg[16];
#pragma unroll
                    for (int e = 0; e < 16; ++e) lg[e] = 0.f;
#pragma unroll
                    for (int j = 0; j < 4; ++j)
#pragma unroll
                        for (int q = 0; q < 4; ++q) {
                            const float hv = h[j][q];
#pragma unroll
                            for (int e4 = 0; e4 < 4; ++e4) { const f32x4 wv = *(const LAS f32x4*)(WR + 4 * ((((j * 4 + q) * 4 + e4) * 64) + lane)); lg[4 * e4] += hv * wv[0]; lg[4 * e4 + 1] += hv * wv[1]; lg[4 * e4 + 2] += hv * wv[2]; lg[4 * e4 + 3] += hv * wv[3]; }
                            asm volatile("" ::: "memory");
                        }
                    const bool b5 = lane & 32, b4 = lane & 16, b3 = lane & 8, b2 = lane & 4;
                    float l8[8], l4[4], l2[2];
#pragma unroll
                    for (int e = 0; e < 8; ++e) { const float snd = b5 ? lg[e] : lg[e + 8], kp = b5 ? lg[e + 8] : lg[e]; l8[e] = kp + __shfl_xor(snd, 32); }
#pragma unroll
                    for (int e = 0; e < 4; ++e) { const float snd = b4 ? l8[e] : l8[e + 4], kp = b4 ? l8[e + 4] : l8[e]; l4[e] = kp + __shfl_xor(snd, 16); }
#pragma unroll
                    for (int e = 0; e < 2; ++e) { const float snd = b3 ? l4[e] : l4[e + 2], kp = b3 ? l4[e + 2] : l4[e]; l2[e] = kp + __shfl_xor(snd, 8); }
                    float l1; { const float snd = b2 ? l2[0] : l2[1], kp = b2 ? l2[1] : l2[0]; l1 = kp + __shfl_xor(snd, 4); }
                    l1 += __shfl_xor(l1, 2); l1 += __shfl_xor(l1, 1);
                    float mx = l1;
                    mx = fmaxf(mx, __shfl_xor(mx, 4)); mx = fmaxf(mx, __shfl_xor(mx, 8)); mx = fmaxf(mx, __shfl_xor(mx, 16)); mx = fmaxf(mx, __shfl_xor(mx, 32));
                    const float ex = __expf(l1 - mx);
                    float sm = ex;
                    sm += __shfl_xor(sm, 4); sm += __shfl_xor(sm, 8); sm += __shfl_xor(sm, 16); sm += __shfl_xor(sm, 32);
                    if ((lane & 3) == 0) AFF[(size_t)row * 16 + ((lane >> 5) & 1) * 8 + ((lane >> 4) & 1) * 4 + ((lane >> 3) & 1) * 2 + ((lane >> 2) & 1)] = ex / sm;
                }
            }
        }
    }
    if (MODE & 2) __syncthreads();
}

DI void topk_phase(const Args& A, LAS unsigned char* lds, int nprob, int mper) {
    const int tid = threadIdx.x, lane = tid & 63, w = tid >> 6, G = gridDim.x;
    unsigned char* ws = A.ws;
    const float* AFF = (const float*)(ws + WS_AFF); int* SLOT = (int*)(ws + WS_SLOT); const bf16_t* H = (const bf16_t*)(ws + WS_H); unsigned char* XE = ws + WS_R2;
    LAS int* SEL = (LAS int*)lds;
    LAS unsigned* PART = (LAS unsigned*)(lds + 1024);
    LAS unsigned* WT = (LAS unsigned*)(lds + 1024 + 256);
    for (int p = blockIdx.x; p < nprob; p += G) {
        const bool lat = p < 128; const int pc = lat ? p : p - 128, b = pc >> 4, e = 2 * (pc & 7) + ((pc >> 3) & 1);
        const int N = lat ? 2048 : 256, cap = lat ? 256 : 32, row0 = lat ? b * 2048 : NLAT + b * 256, base = lat ? b * 256 : 2048 + b * 32;
        unsigned key[4]; bool valid[4];
#pragma unroll
        for (int j = 0; j < 4; ++j) { const int t = 4 * tid + j; valid[j] = t < N; key[j] = valid[j] ? __float_as_uint(AFF[(size_t)(row0 + t) * 16 + e]) : 0u; }
        unsigned T = 0u;
        for (int rnd = 0; rnd < 16; ++rnd) {
            const int sh = 28 - 2 * rnd;
            unsigned c1 = 0, c2 = 0, c3 = 0; unsigned k1, k2, k3;
            if (rnd == 0) { k1 = 1u << 30; k2 = k1; k3 = k1; } else { const int s2 = 30 - 2 * rnd; k1 = T | (1u << s2); k2 = T | (2u << s2); k3 = T | (3u << s2); }
#pragma unroll
            for (int j = 0; j < 4; ++j) { c1 += (unsigned)__popcll(__ballot(valid[j] && key[j] >= k1)); c2 += (unsigned)__popcll(__ballot(valid[j] && key[j] >= k2)); c3 += (unsigned)__popcll(__ballot(valid[j] && key[j] >= k3)); }
            if (lane == 0) { PART[((rnd & 1) * 8 + w) * 4] = c1; PART[((rnd & 1) * 8 + w) * 4 + 1] = c2; PART[((rnd & 1) * 8 + w) * 4 + 2] = c3; }
            __syncthreads();
            unsigned t1 = 0, t2 = 0, t3 = 0;
#pragma unroll
            for (int ww = 0; ww < 8; ++ww) { t1 += PART[((rnd & 1) * 8 + ww) * 4]; t2 += PART[((rnd & 1) * 8 + ww) * 4 + 1]; t3 += PART[((rnd & 1) * 8 + ww) * 4 + 2]; }
            if (rnd == 0) { if (t1 >= (unsigned)cap) T = k1; }
            else T = (t3 >= (unsigned)cap) ? k3 : ((t2 >= (unsigned)cap) ? k2 : ((t1 >= (unsigned)cap) ? k1 : T));
            (void)sh;
        }
        unsigned mine = 0;
#pragma unroll
        for (int j = 0; j < 4; ++j) mine += (valid[j] && key[j] == T ? 1u : 0u) + (valid[j] && key[j] > T ? 0x10000u : 0u);
        unsigned inc = mine;
#pragma unroll
        for (int o = 1; o < 64; o <<= 1) { const unsigned x = __shfl_up(inc, o); inc += (lane >= o) ? x : 0u; }
        __syncthreads();
        if (lane == 63) WT[w] = inc;
        __syncthreads();
        unsigned pre = inc - mine, total = 0;
#pragma unroll
        for (int ww = 0; ww < 8; ++ww) { const unsigned x = WT[ww]; pre += (ww < w) ? x : 0u; total += x; }
        const int n_gt = (int)(total >> 16), need_eq = cap - n_gt;
        int eq_before = (int)(pre & 0xffffu), gt_before = (int)(pre >> 16);
#pragma unroll
        for (int j = 0; j < 4; ++j) if (valid[j]) {
            const bool isgt = key[j] > T, iseq = key[j] == T;
            const bool sel = isgt || (iseq && eq_before < need_eq);
            const int slot = gt_before + (eq_before < need_eq ? eq_before : need_eq);
            const int row = row0 + 4 * tid + j;
            SLOT[(size_t)row * 16 + e] = sel ? slot : -1;
            if (sel) SEL[slot] = row;
            eq_before += iseq ? 1 : 0; gt_before += isgt ? 1 : 0;
        }
        __syncthreads();
        for (int s0 = 0; s0 < cap; s0 += 256) {
            u32x4 v[32];
#pragma unroll
            for (int r = 0; r < 32; ++r) { const int sl = s0 + 8 * r + w; v[r] = *(const u32x4*)((const unsigned char*)H + (size_t)SEL[sl < cap ? sl : 0] * D + 16 * lane); }
#pragma unroll
            for (int r = 0; r < 32; ++r) { const int sl = s0 + 8 * r + w; if (sl < cap) *(u32x4*)(XE + ((size_t)e * mper + base + sl) * D + 16 * lane) = v[r]; }
        }
        __syncthreads();
    }
}

template <bool RET>
DI void readout_phase(const Args& A, int nrows) {
    const int tid = threadIdx.x, lane = tid & 63, w = tid >> 6, G = gridDim.x;
    unsigned char* ws = A.ws;
    constexpr int HD = RET ? 2048 : 1024, PITCH = RET ? RET_IN : HG_PITCH, NJ = HD / 512;
    const bf16_t* OF = (const bf16_t*)(ws + WS_R2); const bf16_t* OB = (const bf16_t*)(ws + WS_R2 + R2_HALF);
    const bf16_t* P = (const bf16_t*)(ws + WS_R1); bf16_t* A2 = (bf16_t*)(ws + WS_A2);
    for (int row = blockIdx.x * 8 + w; row < nrows; row += G * 8) {
#pragma unroll
        for (int j = 0; j < NJ; ++j) {
            const int col = 512 * j + 8 * lane;
            const u32x4 a = __builtin_nontemporal_load((const u32x4*)(OF + (size_t)row * HD + col)), b = __builtin_nontemporal_load((const u32x4*)(OB + (size_t)row * HD + col)), g = __builtin_nontemporal_load((const u32x4*)(P + (size_t)row * PITCH + 4096 + col));
            float o[8];
            o[0] = bf_lo(a.x) + bf_lo(b.x); o[1] = bf_hi(a.x) + bf_hi(b.x); o[2] = bf_lo(a.y) + bf_lo(b.y); o[3] = bf_hi(a.y) + bf_hi(b.y);
            o[4] = bf_lo(a.z) + bf_lo(b.z); o[5] = bf_hi(a.z) + bf_hi(b.z); o[6] = bf_lo(a.w) + bf_lo(b.w); o[7] = bf_hi(a.w) + bf_hi(b.w);
            float ss = 0.f;
#pragma unroll
            for (int q = 0; q < 8; ++q) ss += o[q] * o[q];
            float rs;
            if (RET) { ss = wave_sum(ss); rs = rsqrtf(ss * (1.0f / 512.0f) + EPS); }
            else { ss += __shfl_xor(ss, 1); ss += __shfl_xor(ss, 2); ss += __shfl_xor(ss, 4); ss += __shfl_xor(ss, 8); rs = rsqrtf(ss * (1.0f / 128.0f) + EPS); }
            float gn[8];
            if (RET) {
#pragma unroll
                for (int q = 0; q < 8; ++q) gn[q] = 1.0f;
            } else {
                const f32x4 g0 = *(const f32x4*)(A.in[I_HGN] + (col & 127)), g1 = *(const f32x4*)(A.in[I_HGN] + (col & 127) + 4);
                gn[0] = g0[0]; gn[1] = g0[1]; gn[2] = g0[2]; gn[3] = g0[3]; gn[4] = g1[0]; gn[5] = g1[1]; gn[6] = g1[2]; gn[7] = g1[3];
            }
            const float gt[8] = {bf_lo(g.x), bf_hi(g.x), bf_lo(g.y), bf_hi(g.y), bf_lo(g.z), bf_hi(g.z), bf_lo(g.w), bf_hi(g.w)};
            float r[8];
#pragma unroll
            for (int q = 0; q < 8; ++q) r[q] = silu_f(gt[q]) * (o[q] * rs * gn[q]);
            if (RET) { u32x2 wv; wv.x = pk4_fp8(r[0], r[1], r[2], r[3]); wv.y = pk4_fp8(r[4], r[5], r[6], r[7]); *(u32x2*)((unsigned char*)A2 + (size_t)row * HD + col) = wv; }
            else { u32x4 wv; wv.x = pk_bf16(r[0], r[1]); wv.y = pk_bf16(r[2], r[3]); wv.z = pk_bf16(r[4], r[5]); wv.w = pk_bf16(r[6], r[7]);
                   *(u32x4*)(A2 + (size_t)row * HD + col) = wv; }
        }
    }
}

template <bool RET>
DI void scan_naive_phase(const Args& A, LAS unsigned char* lds, bool ctx_out) {
    constexpr int DK = RET ? 256 : 128, DVS = RET ? 64 : 128, NKG = NTHREADS / DVS, PITCH = RET ? RET_IN : HG_PITCH, HD = RET ? 2048 : 1024;
    constexpr int NUNITS = RET ? 8 * 4 * 2 * 8 : 8 * 8 * 2;
    const int tid = threadIdx.x, G = gridDim.x;
    unsigned char* ws = A.ws;
    const bf16_t* P = (const bf16_t*)(ws + WS_R1);
    LAS bf16_t* Lq = (LAS bf16_t*)lds;
    LAS bf16_t* Lk = Lq + 64 * DK;
    LAS bf16_t* Lg = Lk + 64 * DK;
    LAS bf16_t* Lv = Lg + (RET ? 0 : 64 * DK);
    LAS float* Lp = (LAS float*)(Lv + 64 * DVS);
    const int v = tid % DVS, kg = tid / DVS;
    for (int u = blockIdx.x; u < NUNITS; u += G) {
        int b, h, dir, dvs = 0;
        if (RET) { dvs = u & 7; dir = (u >> 3) & 1; h = (u >> 4) & 3; b = u >> 6; } else { dir = u & 1; h = (u >> 1) & 7; b = u >> 4; }
        const int qoff = RET ? h * 256 : h * 128;
        const int koff = RET ? 1024 + h * 256 : 1024 + dir * 1024 + h * 128;
        const int goff = RET ? 0 : 5120 + dir * 1024 + h * 128;
        const int voff = RET ? 2048 + h * 512 + dvs * 64 : 3072 + h * 128;
        const int ooff = RET ? h * 512 + dvs * 64 : h * 128;
        bf16_t* O = (bf16_t*)(ws + WS_R2 + (dir ? R2_HALF : 0));
        float gam = 1.f;
        if (RET) { const float j = (float)(2 * h + dir); gam = 1.0f - exp2f(-5.0f - 0.5f * j); }
        float S[32];
#pragma unroll
        for (int d = 0; d < 32; ++d) S[d] = 0.f;
        for (int st = 0; st < 36; ++st) {
            const bool isctx = st < 4;
            const int c = isctx ? st : st - 4;
            const int len = isctx ? 256 : 2048, rbase = isctx ? NLAT + b * 256 : b * 2048;
            const int tlo = dir ? (len - 64 - 64 * c) : 64 * c;
            for (int id = tid; id < 64 * DK / 8; id += NTHREADS) {
                const int i = id / (DK / 8), ch = id % (DK / 8); const size_t grow = (size_t)(rbase + tlo + (dir ? 63 - i : i)) * PITCH;
                *(LAS u32x4*)(Lq + i * DK + 8 * ch) = *(const u32x4*)(P + grow + qoff + 8 * ch);
                *(LAS u32x4*)(Lk + i * DK + 8 * ch) = *(const u32x4*)(P + grow + koff + 8 * ch);
                if (!RET) *(LAS u32x4*)(Lg + i * DK + 8 * ch) = *(const u32x4*)(P + grow + goff + 8 * ch);
            }
            for (int id = tid; id < 64 * DVS / 8; id += NTHREADS) {
                const int i = id / (DVS / 8), ch = id % (DVS / 8); const size_t grow = (size_t)(rbase + tlo + (dir ? 63 - i : i)) * PITCH;
                *(LAS u32x4*)(Lv + i * DVS + 8 * ch) = *(const u32x4*)(P + grow + voff + 8 * ch);
            }
            __syncthreads();
            const bool wr_out = ctx_out || !isctx;
            for (int i = 0; i < 64; ++i) {
                const float vv = bf2f(Lv[i * DVS + v]);
                float part = 0.f;
#pragma unroll
                for (int d8 = 0; d8 < 4; ++d8) {
                    const u32x4 qq = *(const LAS u32x4*)(Lq + i * DK + kg * 32 + 8 * d8), kk = *(const LAS u32x4*)(Lk + i * DK + kg * 32 + 8 * d8);
                    u32x4 gg = (u32x4){0u, 0u, 0u, 0u};
                    if (!RET) gg = *(const LAS u32x4*)(Lg + i * DK + kg * 32 + 8 * d8);
                    const unsigned qa[4] = {qq.x, qq.y, qq.z, qq.w}, ka[4] = {kk.x, kk.y, kk.z, kk.w}, ga[4] = {gg.x, gg.y, gg.z, gg.w};
#pragma unroll
                    for (int e = 0; e < 4; ++e) {
                        const float d0 = RET ? gam : __expf(bf_lo(ga[e])), d1 = RET ? gam : __expf(bf_hi(ga[e]));
                        float& s0 = S[8 * d8 + 2 * e]; float& s1 = S[8 * d8 + 2 * e + 1];
                        s0 = d0 * s0 + bf_lo(ka[e]) * vv; s1 = d1 * s1 + bf_hi(ka[e]) * vv;
                        part += s0 * bf_lo(qa[e]) + s1 * bf_hi(qa[e]);
                    }
                }
                Lp[((i & 1) * NKG + kg) * DVS + v] = part;
                __syncthreads();
                if (kg == 0 && wr_out) {
                    float o = 0.f;
#pragma unroll
                    for (int g2 = 0; g2 < NKG; ++g2) o += Lp[((i & 1) * NKG + g2) * DVS + v];
                    O[(size_t)(rbase + tlo + (dir ? 63 - i : i)) * HD + ooff + v] = f2bf(o);
                }
            }
            __syncthreads();
        }
    }
}

typedef short s16x8 __attribute__((ext_vector_type(8)));
typedef short s16x4 __attribute__((ext_vector_type(4)));
DI unsigned offb(unsigned row, unsigned ch) { return 256u * row + 16u * (ch ^ (((row & 3u) << 2) | ((row >> 2) & 3u))); }
DI s16x4 trread(LAS unsigned char* p) { return __builtin_amdgcn_ds_read_tr16_b64_v4i16((LAS s16x4*)p); }
DI s16x8 cat8(s16x4 a, s16x4 b) { return __builtin_shufflevector(a, b, 0, 1, 2, 3, 4, 5, 6, 7); }
#define MFMA16(a, b, c) __builtin_amdgcn_mfma_f32_16x16x32_bf16((a), (b), (c), 0, 0, 0)
DI u32x4 scale8(u32x4 v, float f) { u32x4 r; r.x = pk_bf16(bf_lo(v.x) * f, bf_hi(v.x) * f); r.y = pk_bf16(bf_lo(v.y) * f, bf_hi(v.y) * f); r.z = pk_bf16(bf_lo(v.z) * f, bf_hi(v.z) * f); r.w = pk_bf16(bf_lo(v.w) * f, bf_hi(v.w) * f); return r; }
DI void unpack8(u32x4 v, float (&o)[8]) { o[0] = bf_lo(v.x); o[1] = bf_hi(v.x); o[2] = bf_lo(v.y); o[3] = bf_hi(v.y); o[4] = bf_lo(v.z); o[5] = bf_hi(v.z); o[6] = bf_lo(v.w); o[7] = bf_hi(v.w); }
DI u32x4 pack8(const float (&o)[8]) { u32x4 r; r.x = pk_bf16(o[0], o[1]); r.y = pk_bf16(o[2], o[3]); r.z = pk_bf16(o[4], o[5]); r.w = pk_bf16(o[6], o[7]); return r; }

template <bool RET>
DI void scan_mfma_phase(const Args& A, LAS unsigned char* lds, bool ctx_out) {
    constexpr int DK = RET ? 256 : 128, NT = DK / 128, NS = DK / 32, PITCH = RET ? RET_IN : HG_PITCH, HD = RET ? 2048 : 1024;
    constexpr int NUNITS = RET ? 256 : 128;
    constexpr int TQ = 0, TK = TQ + NT * 16384, TV = TK + NT * 16384, TP = TV + 16384, TE = TP + 9216, CS = TE + 512;
    const int tid = threadIdx.x, lane = tid & 63, w = __builtin_amdgcn_readfirstlane(tid >> 6), G = gridDim.x;
    const int l15 = lane & 15, g4 = lane >> 4, tq_ = (lane & 15) >> 2, tp_ = lane & 3;
    const int sc = tid & 15, rg = tid >> 4;
    unsigned char* ws = A.ws;
    const bf16_t* P = (const bf16_t*)(ws + WS_R1);
    for (int u = blockIdx.x; u < NUNITS; u += G) {
        int b, h, dir, dvs = 0;
        if (RET) {
            int uu = u; if ((G & 7) == 0 && G == NUNITS) { const int x = u & 7, y = u >> 3; uu = ((x * (G >> 6) + (y >> 3)) << 3) | (y & 7); }
            dvs = uu & 3; dir = (uu >> 2) & 1; h = (uu >> 3) & 3; b = uu >> 5;
        } else {
            int uu = u; if (G == 2 * NUNITS || G == NUNITS) { const int x = u & 7, y = u >> 3; uu = ((x * (NUNITS >> 4) + (y >> 1)) << 1) | (y & 1); }
            dir = uu & 1; h = (uu >> 1) & 7; b = uu >> 4;
        }
        const int qoff = RET ? h * 256 : h * 128;
        const int koff = RET ? 1024 + h * 256 : 1024 + dir * 1024 + h * 128;
        const int goff = RET ? 0 : 5120 + dir * 1024 + h * 128;
        const int voff = RET ? 2048 + h * 512 + dvs * 128 : 3072 + h * 128;
        const int ooff = RET ? h * 512 + dvs * 128 : h * 128;
        bf16_t* O = (bf16_t*)(ws + WS_R2 + (dir ? R2_HALF : 0));
        float fq0 = 1.f, fq1 = 1.f, fk0 = 1.f, fk1 = 1.f, e64 = 1.f;
        if (RET) {
            const float gam = 1.0f - exp2f(-5.0f - 0.5f * (float)(2 * h + dir)), lg = log2f(gam);
            fq0 = exp2f((float)(2 * rg + 1) * lg); fq1 = exp2f((float)(2 * rg + 2) * lg); fk0 = exp2f(-(float)(2 * rg + 1) * lg); fk1 = exp2f(-(float)(2 * rg + 2) * lg); e64 = exp2f(64.0f * lg);
        }
        f32x4 S[2 * NS];
#pragma unroll
        for (int i = 0; i < 2 * NS; ++i) S[i] = (f32x4){0.f, 0.f, 0.f, 0.f};
        u32x4 rq[NT][2], rk[NT][2], rgv[2], rv[2];
#define SCAN_ROWBASE(st_) (((st_) < 4) ? (NLAT + b * 256 + (dir ? 256 - 64 - 64 * (st_) : 64 * (st_))) : (b * 2048 + (dir ? 2048 - 64 - 64 * ((st_) - 4) : 64 * ((st_) - 4))))
#define SCAN_LOAD(st_) do { const int rb_ = SCAN_ROWBASE(st_); _Pragma("unroll") for (int j = 0; j < 2; ++j) { const int i_ = 2 * rg + j; const bf16_t* gp = P + (size_t)(rb_ + (dir ? 63 - i_ : i_)) * PITCH + 8 * sc; \
            _Pragma("unroll") for (int t = 0; t < NT; ++t) { rq[t][j] = *(const u32x4*)(gp + qoff + 128 * t); rk[t][j] = *(const u32x4*)(gp + koff + 128 * t); } \
            if (!RET) rgv[j] = *(const u32x4*)(gp + goff); rv[j] = *(const u32x4*)(gp + voff); } } while (0)
        SCAN_LOAD(0);
        for (int st = 0; st < 36; ++st) {
            const bool wr_out = ctx_out || st >= 4;
            const int rowbase = SCAN_ROWBASE(st);
            float tsum[8], g0[8], g1[8];
            if (!RET) {
                unpack8(rgv[0], g0); unpack8(rgv[1], g1);
#pragma unroll
                for (int c = 0; c < 8; ++c) {
                    float t = g0[c] + g1[c];
                    float x = __shfl_up(t, 16); t += (lane >= 16) ? x : 0.f;
                    x = __shfl_up(t, 32); t += (lane >= 32) ? x : 0.f;
                    tsum[c] = t;
                }
                if (lane >= 48) {
                    *(LAS f32x4*)(lds + CS + (w * 128 + 8 * sc) * 4) = (f32x4){tsum[0], tsum[1], tsum[2], tsum[3]};
                    *(LAS f32x4*)(lds + CS + (w * 128 + 8 * sc + 4) * 4) = (f32x4){tsum[4], tsum[5], tsum[6], tsum[7]};
                }
            }
            __syncthreads();
            if (RET) {
#pragma unroll
                for (int j = 0; j < 2; ++j) {
                    const int i_ = 2 * rg + j; const float fq = j ? fq1 : fq0, fk = j ? fk1 : fk0;
#pragma unroll
                    for (int t = 0; t < NT; ++t) {
                        *(LAS u32x4*)(lds + TQ + t * 16384 + offb(i_, sc)) = scale8(rq[t][j], fq);
                        *(LAS u32x4*)(lds + TK + t * 16384 + offb(i_, sc)) = scale8(rk[t][j], fk);
                    }
                    *(LAS u32x4*)(lds + TV + offb(i_, sc)) = rv[j];
                }
            } else {
                float off[8];
#pragma unroll
                for (int c = 0; c < 8; ++c) off[c] = 0.f;
                for (int ww = 0; ww < w; ++ww) {
                    const f32x4 a0 = *(const LAS f32x4*)(lds + CS + (ww * 128 + 8 * sc) * 4), a1 = *(const LAS f32x4*)(lds + CS + (ww * 128 + 8 * sc + 4) * 4);
                    off[0] += a0[0]; off[1] += a0[1]; off[2] += a0[2]; off[3] += a0[3]; off[4] += a1[0]; off[5] += a1[1]; off[6] += a1[2]; off[7] += a1[3];
                }
                float q0[8], q1[8], k0[8], k1[8], ee[8];
                unpack8(rq[0][0], q0); unpack8(rq[0][1], q1); unpack8(rk[0][0], k0); unpack8(rk[0][1], k1);
#pragma unroll
                for (int c = 0; c < 8; ++c) {
                    const float b0 = off[c] + tsum[c] - g1[c], b1 = b0 + g1[c];
                    const float e0 = __expf(b0), e1 = __expf(b1);
                    q0[c] *= e0; q1[c] *= e1; k0[c] *= __builtin_amdgcn_rcpf(e0); k1[c] *= __builtin_amdgcn_rcpf(e1); ee[c] = e1;
                }
                *(LAS u32x4*)(lds + TQ + offb(2 * rg, sc)) = pack8(q0); *(LAS u32x4*)(lds + TQ + offb(2 * rg + 1, sc)) = pack8(q1);
                *(LAS u32x4*)(lds + TK + offb(2 * rg, sc)) = pack8(k0); *(LAS u32x4*)(lds + TK + offb(2 * rg + 1, sc)) = pack8(k1);
                *(LAS u32x4*)(lds + TV + offb(2 * rg, sc)) = rv[0]; *(LAS u32x4*)(lds + TV + offb(2 * rg + 1, sc)) = rv[1];
                if (rg == 31) { *(LAS f32x4*)(lds + TE + (8 * sc) * 4) = (f32x4){ee[0], ee[1], ee[2], ee[3]}; *(LAS f32x4*)(lds + TE + (8 * sc + 4) * 4) = (f32x4){ee[4], ee[5], ee[6], ee[7]}; }
            }
            __syncthreads();
            if (st + 1 < 36) SCAN_LOAD(st + 1);
            if (wr_out) {
                const int mi = w >> 1;
#pragma unroll
                for (int nn = 0; nn < 2; ++nn) {
                    const int nj = 2 * (w & 1) + nn;
                    f32x4 pa = (f32x4){0.f, 0.f, 0.f, 0.f};
                    if (nj <= mi) {
#pragma unroll
                        for (int s = 0; s < NS; ++s) {
                            const s16x8 ka = *(const LAS s16x8*)(lds + TK + (s >> 2) * 16384 + offb(l15 + 16 * nj, 4 * (s & 3) + g4));
                            const s16x8 qb = *(const LAS s16x8*)(lds + TQ + (s >> 2) * 16384 + offb(l15 + 16 * mi, 4 * (s & 3) + g4));
                            pa = MFMA16(ka, qb, pa);
                        }
#pragma unroll
                        for (int r = 0; r < 4; ++r) pa[r] = (16 * nj + 4 * g4 + r > 16 * mi + l15) ? 0.f : pa[r];
                    }
                    u32x2 pk; pk.x = pk_bf16(pa[0], pa[1]); pk.y = pk_bf16(pa[2], pa[3]);
                    *(LAS u32x2*)(lds + TP + (16 * mi + l15) * 144 + 2 * (16 * nj + 4 * g4)) = pk;
                }
            }
            __syncthreads();
            s16x8 vf[2];
#pragma unroll
            for (int ks = 0; ks < 2; ++ks) {
                const s16x4 t0 = trread(lds + TV + offb(32 * ks + 8 * g4 + tq_, 2 * w + (tp_ >> 1)) + 8 * (tp_ & 1));
                const s16x4 t1 = trread(lds + TV + offb(32 * ks + 8 * g4 + 4 + tq_, 2 * w + (tp_ >> 1)) + 8 * (tp_ & 1));
                vf[ks] = cat8(t0, t1);
            }
            if (wr_out) {
                f32x4 OT[4];
#pragma unroll
                for (int m = 0; m < 4; ++m) OT[m] = (f32x4){0.f, 0.f, 0.f, 0.f};
#pragma unroll
                for (int s = 0; s < NS; ++s) {
                    u32x4 sp; sp.x = pk_bf16(S[2 * s][0], S[2 * s][1]); sp.y = pk_bf16(S[2 * s][2], S[2 * s][3]); sp.z = pk_bf16(S[2 * s + 1][0], S[2 * s + 1][1]); sp.w = pk_bf16(S[2 * s + 1][2], S[2 * s + 1][3]);
                    const s16x8 sa = __builtin_bit_cast(s16x8, sp);
#pragma unroll
                    for (int m = 0; m < 4; ++m) {
                        const s16x8 qb = *(const LAS s16x8*)(lds + TQ + (s >> 2) * 16384 + offb(l15 + 16 * m, 4 * (s & 3) + g4));
                        OT[m] = MFMA16(sa, qb, OT[m]);
                    }
                }
#pragma unroll
                for (int ks = 0; ks < 2; ++ks)
#pragma unroll
                    for (int m = 0; m < 4; ++m) {
                        if (ks == 0 || m >= 2) {
                            const s16x8 pb = *(const LAS s16x8*)(lds + TP + (16 * m + l15) * 144 + 2 * (32 * ks + 8 * g4));
                            OT[m] = MFMA16(vf[ks], pb, OT[m]);
                        }
                    }
#pragma unroll
                for (int m = 0; m < 4; ++m) {
                    const int i_ = 16 * m + l15;
                    u32x2 o; o.x = pk_bf16(OT[m][0], OT[m][1]); o.y = pk_bf16(OT[m][2], OT[m][3]);
                    *(u32x2*)(O + (size_t)(rowbase + (dir ? 63 - i_ : i_)) * HD + ooff + 16 * w + 4 * g4) = o;
                }
            }
#pragma unroll
            for (int s = 0; s < NS; ++s)
#pragma unroll
                for (int u2 = 0; u2 < 2; ++u2) {
#pragma unroll
                    for (int ks = 0; ks < 2; ++ks) {
                        const s16x4 a0 = trread(lds + TK + (s >> 2) * 16384 + offb(32 * ks + 8 * g4 + tq_, 4 * (s & 3) + tp_) + 8 * u2);
                        const s16x4 a1 = trread(lds + TK + (s >> 2) * 16384 + offb(32 * ks + 8 * g4 + 4 + tq_, 4 * (s & 3) + tp_) + 8 * u2);
                        S[2 * s + u2] = MFMA16(cat8(a0, a1), vf[ks], S[2 * s + u2]);
                    }
                    if (RET) S[2 * s + u2] *= e64;
                    else { const f32x4 ev = *(const LAS f32x4*)(lds + TE + (32 * s + 8 * g4 + 4 * u2) * 4); S[2 * s + u2] *= ev; }
                }
        }
        __syncthreads();
#undef SCAN_ROWBASE
#undef SCAN_LOAD
    }
}

#ifndef PROBE_SCAN
#define PROBE_SCAN 0
#endif
template <bool RET>
DI void scan_v3_phase(const Args& A, LAS unsigned char* lds, bool ctx_out) {
    constexpr int DK = RET ? 256 : 128, NT = DK / 128, NS = DK / 32, PITCH = RET ? RET_IN : HG_PITCH, HD = RET ? 2048 : 1024;
    constexpr int NUNITS = RET ? 256 : 128, C = 32, NSTEP = 2304 / C, NCTX = 256 / C, RN = 4;
    constexpr int TQ = 0, TK = TQ + NT * C * 256, TV = TK + NT * C * 256, TV2 = TV + C * 256, TP = TV2 + (RET ? C * 256 : 0), TE = TP + C * 80, BUF = TE + 512;
    static_assert(2 * BUF <= 131072, "scan LDS");
    const int tid = threadIdx.x, lane = tid & 63, w = __builtin_amdgcn_readfirstlane(tid >> 6), G = gridDim.x;
    const int l15 = lane & 15, g4 = lane >> 4, tq_ = (lane & 15) >> 2, tp_ = lane & 3;
    const bool cons = w < 4;
    const int pw = w & 3, ptid = tid & 255;
    unsigned char* ws = A.ws;
    const bf16_t* P = (const bf16_t*)(ws + WS_R1);
    for (int u = blockIdx.x; u < NUNITS; u += G) {
        int b, h, dir, dvs = 0;
        if (RET) {
            int uu = u; if ((G & 7) == 0 && G == NUNITS) { const int x = u & 7, y = u >> 3; uu = ((x * (G >> 6) + (y >> 3)) << 3) | (y & 7); }
            dvs = uu & 3; dir = (uu >> 2) & 1; h = (uu >> 3) & 3; b = uu >> 5;
        } else {
            int uu = u; if (G == 2 * NUNITS || G == NUNITS) { const int x = u & 7, y = u >> 3; uu = ((x * (NUNITS >> 4) + (y >> 1)) << 1) | (y & 1); }
            dir = uu & 1; h = (uu >> 1) & 7; b = uu >> 4;
        }
        const int qoff = RET ? h * 256 : h * 128;
        const int koff = RET ? 1024 + h * 256 : 1024 + dir * 1024 + h * 128;
        const int goff = RET ? 0 : 5120 + dir * 1024 + h * 128;
        const int voff = RET ? 2048 + h * 512 + dvs * 128 : 3072 + h * 128;
        const int ooff = RET ? h * 512 + dvs * 128 : h * 128;
        bf16_t* O = (bf16_t*)(ws + WS_R2 + (dir ? R2_HALF : 0));
        float lg = 0.f;
        if (RET) lg = log2f(1.0f - exp2f(-5.0f - 0.5f * (float)(2 * h + dir)));
#define V3_ROWBASE(st_) (((st_) < NCTX) ? (NLAT + b * 256 + (dir ? 256 - C - C * (st_) : C * (st_))) : (b * 2048 + (dir ? 2048 - C - C * ((st_) - NCTX) : C * ((st_) - NCTX))))
        if (cons) {
            f32x4 S[2][2 * NS];
#pragma unroll
            for (int n = 0; n < 2; ++n)
#pragma unroll
                for (int i = 0; i < 2 * NS; ++i) S[n][i] = (f32x4){0.f, 0.f, 0.f, 0.f};
            __syncthreads(); __syncthreads();
#pragma unroll (RET ? 1 : 2)
            for (int st = 0; st < NSTEP; ++st) {
                LAS unsigned char* B = lds + (st & 1) * BUF;
                const bool wr_out = ctx_out || st >= NCTX;
                const int mm = st & (RN - 1);
                for (int rep_ = 0; rep_ < (((PROBE_SCAN & 2) && !RET) ? 2 : 1); ++rep_)
                if (wr_out) {
                    const int rowbase = V3_ROWBASE(st);
                    f32x4 OT[2][2];
#pragma unroll
                    for (int n = 0; n < 2; ++n)
#pragma unroll
                        for (int m = 0; m < 2; ++m) OT[n][m] = (f32x4){0.f, 0.f, 0.f, 0.f};
#pragma unroll
                    for (int s = 0; s < NS; ++s) {
                        s16x8 sa[2];
#pragma unroll
                        for (int n = 0; n < 2; ++n) { u32x4 sp; sp.x = pk_bf16(S[n][2 * s][0], S[n][2 * s][1]); sp.y = pk_bf16(S[n][2 * s][2], S[n][2 * s][3]); sp.z = pk_bf16(S[n][2 * s + 1][0], S[n][2 * s + 1][1]); sp.w = pk_bf16(S[n][2 * s + 1][2], S[n][2 * s + 1][3]); sa[n] = __builtin_bit_cast(s16x8, sp); }
#pragma unroll
                        for (int m = 0; m < 2; ++m) {
                            const s16x8 qb = *(const LAS s16x8*)(B + TQ + (s >> 2) * (C * 256) + offb(l15 + 16 * m, 4 * (s & 3) + g4));
#pragma unroll
                            for (int n = 0; n < 2; ++n) OT[n][m] = MFMA16(sa[n], qb, OT[n][m]);
                        }
                    }
                    if (RET) {
#pragma unroll
                        for (int m = 0; m < 2; ++m) { const float fo = exp2f((float)(C * mm + 16 * m + l15 + 1) * lg);
#pragma unroll
                            for (int n = 0; n < 2; ++n) OT[n][m] *= fo; }
                    }
#pragma unroll
                    for (int n = 0; n < 2; ++n) {
                        const int cc = 2 * w + n;
                        const s16x4 t0 = trread(B + TV + offb(8 * g4 + tq_, 2 * cc + (tp_ >> 1)) + 8 * (tp_ & 1));
                        const s16x4 t1 = trread(B + TV + offb(8 * g4 + 4 + tq_, 2 * cc + (tp_ >> 1)) + 8 * (tp_ & 1));
                        const s16x8 vf = cat8(t0, t1);
#pragma unroll
                        for (int m = 0; m < 2; ++m) {
                            const s16x8 pb = *(const LAS s16x8*)(B + TP + (16 * m + l15) * 80 + 16 * g4);
                            OT[n][m] = MFMA16(vf, pb, OT[n][m]);
                        }
                    }
#pragma unroll
                    for (int n = 0; n < 2; ++n)
#pragma unroll
                        for (int m = 0; m < 2; ++m) {
                            const int i_ = 16 * m + l15;
                            u32x2 o; o.x = pk_bf16(OT[n][m][0], OT[n][m][1]); o.y = pk_bf16(OT[n][m][2], OT[n][m][3]);
                            *(u32x2*)(O + (size_t)(rowbase + (dir ? C - 1 - i_ : i_)) * HD + ooff + 32 * w + 16 * n + 4 * g4) = o;
                        }
                }
                __syncthreads();
                if ((PROBE_SCAN & 4) && !RET) { __syncthreads(); __syncthreads(); }
                {
                    s16x8 vb[2];
#pragma unroll
                    for (int n = 0; n < 2; ++n) {
                        const int cc = 2 * w + n;
                        const s16x4 t0 = trread(B + (RET ? TV2 : TV) + offb(8 * g4 + tq_, 2 * cc + (tp_ >> 1)) + 8 * (tp_ & 1));
                        const s16x4 t1 = trread(B + (RET ? TV2 : TV) + offb(8 * g4 + 4 + tq_, 2 * cc + (tp_ >> 1)) + 8 * (tp_ & 1));
                        vb[n] = cat8(t0, t1);
                    }
#pragma unroll
                    for (int s = 0; s < NS; ++s)
#pragma unroll
                        for (int u2 = 0; u2 < 2; ++u2) {
                            const s16x4 a0 = trread(B + TK + (s >> 2) * (C * 256) + offb(8 * g4 + tq_, 4 * (s & 3) + tp_) + 8 * u2);
                            const s16x4 a1 = trread(B + TK + (s >> 2) * (C * 256) + offb(8 * g4 + 4 + tq_, 4 * (s & 3) + tp_) + 8 * u2);
                            const s16x8 ka = cat8(a0, a1);
#pragma unroll
                            for (int n = 0; n < 2; ++n) S[n][2 * s + u2] = MFMA16(ka, vb[n], S[n][2 * s + u2]);
                            if ((PROBE_SCAN & 8) && !RET) { const s16x4 b0 = trread(B + TK + (s >> 2) * (C * 256) + offb(8 * g4 + tq_, 4 * (s & 3) + tp_) + 8 * u2); const s16x4 b1 = trread(B + TK + (s >> 2) * (C * 256) + offb(8 * g4 + 4 + tq_, 4 * (s & 3) + tp_) + 8 * u2);
                                f32x4 dmy = (f32x4){0.f, 0.f, 0.f, 0.f}; dmy = MFMA16(cat8(b0, b1), vb[0], dmy); dmy = MFMA16(cat8(b0, b1), vb[1], dmy); asm volatile("" :: "v"(dmy)); }
                            if (!RET) { const f32x4 ev = *(const LAS f32x4*)(B + TE + (32 * s + 8 * g4 + 4 * u2) * 4);
#pragma unroll
                                for (int n = 0; n < 2; ++n) S[n][2 * s + u2] *= ev; }
                        }
                    if (RET && mm == RN - 1) {
                        const float er = exp2f((float)(C * RN) * lg);
#pragma unroll
                        for (int n = 0; n < 2; ++n)
#pragma unroll
                            for (int i = 0; i < 2 * NS; ++i) S[n][i] *= er;
                    }
                }
                __syncthreads();
            }
        } else {
            constexpr int NQ = RET ? 4 : 2;
            u32x4 rq[2][NQ], rk[2][NQ], rgv[2][2], rv[2][2];
            const int c4 = lane & 3, rg = lane >> 2;
#define V3_LOAD(set_, st_) do { const int rb_ = V3_ROWBASE(st_); \
                if (RET) { _Pragma("unroll") for (int j = 0; j < 4; ++j) { const int id = ptid + 256 * j, i_ = id >> 5, ch = id & 31; const bf16_t* gp = P + (size_t)(rb_ + (dir ? C - 1 - i_ : i_)) * PITCH + 8 * ch; \
                        rq[set_][j] = *(const u32x4*)(gp + qoff); rk[set_][j] = *(const u32x4*)(gp + koff); } \
                    _Pragma("unroll") for (int j = 0; j < 2; ++j) { const int id = ptid + 256 * j, i_ = id >> 4, ch = id & 15; rv[set_][j] = *(const u32x4*)(P + (size_t)(rb_ + (dir ? C - 1 - i_ : i_)) * PITCH + voff + 8 * ch); } } \
                else { _Pragma("unroll") for (int j = 0; j < 2; ++j) { const int i_ = 2 * rg + j; const bf16_t* gp = P + (size_t)(rb_ + (dir ? C - 1 - i_ : i_)) * PITCH + 8 * (4 * pw + c4); \
                        rq[set_][j] = *(const u32x4*)(gp + qoff); rk[set_][j] = *(const u32x4*)(gp + koff); rgv[set_][j] = *(const u32x4*)(gp + goff); rv[set_][j] = *(const u32x4*)(gp + voff); } } } while (0)
#define V3_STAGE(set_, st_) do { LAS unsigned char* Bn = lds + ((st_) & 1) * BUF; \
                if (RET) { const int mmn = (st_) & (RN - 1); \
                    _Pragma("unroll") for (int j = 0; j < 4; ++j) { const int id = ptid + 256 * j, i_ = id >> 5, ch = id & 31; \
                        *(LAS u32x4*)(Bn + TQ + (ch >> 4) * (C * 256) + offb(i_, ch & 15)) = rq[set_][j]; *(LAS u32x4*)(Bn + TK + (ch >> 4) * (C * 256) + offb(i_, ch & 15)) = rk[set_][j]; } \
                    _Pragma("unroll") for (int j = 0; j < 2; ++j) { const int id = ptid + 256 * j, i_ = id >> 4, ch = id & 15; \
                        *(LAS u32x4*)(Bn + TV + offb(i_, ch)) = rv[set_][j]; *(LAS u32x4*)(Bn + TV2 + offb(i_, ch)) = scale8(rv[set_][j], exp2f(-(float)(C * mmn + i_ + 1) * lg)); } } \
                else { float g0[8], g1[8], q0[8], q1[8], k0[8], k1[8], ee[8]; unpack8(rgv[set_][0], g0); unpack8(rgv[set_][1], g1); \
                    unpack8(rq[set_][0], q0); unpack8(rq[set_][1], q1); unpack8(rk[set_][0], k0); unpack8(rk[set_][1], k1); \
                    _Pragma("unroll") for (int c = 0; c < 8; ++c) { float t = g0[c] + g1[c]; float x = __shfl_up(t, 4); t += (lane >= 4) ? x : 0.f; x = __shfl_up(t, 8); t += (lane >= 8) ? x : 0.f; \
                        x = __shfl_up(t, 16); t += (lane >= 16) ? x : 0.f; x = __shfl_up(t, 32); t += (lane >= 32) ? x : 0.f; \
                        const float b0 = t - g1[c], b1 = t; const float e0 = __expf(b0), e1 = __expf(b1); \
                        q0[c] *= e0; q1[c] *= e1; k0[c] *= __builtin_amdgcn_rcpf(e0); k1[c] *= __builtin_amdgcn_rcpf(e1); ee[c] = e1; } \
                    const int cch = 4 * pw + c4; \
                    *(LAS u32x4*)(Bn + TQ + offb(2 * rg, cch)) = pack8(q0); *(LAS u32x4*)(Bn + TQ + offb(2 * rg + 1, cch)) = pack8(q1); \
                    *(LAS u32x4*)(Bn + TK + offb(2 * rg, cch)) = pack8(k0); *(LAS u32x4*)(Bn + TK + offb(2 * rg + 1, cch)) = pack8(k1); \
                    *(LAS u32x4*)(Bn + TV + offb(2 * rg, cch)) = rv[set_][0]; *(LAS u32x4*)(Bn + TV + offb(2 * rg + 1, cch)) = rv[set_][1]; \
                    if (rg == 15) { *(LAS f32x4*)(Bn + TE + (8 * cch) * 4) = (f32x4){ee[0], ee[1], ee[2], ee[3]}; *(LAS f32x4*)(Bn + TE + (8 * cch + 4) * 4) = (f32x4){ee[4], ee[5], ee[6], ee[7]}; } } } while (0)
            const int mi = pw >> 1, nj = pw & 1;
            float pf[4];
#pragma unroll
            for (int r = 0; r < 4; ++r) pf[r] = RET ? exp2f((float)(16 * (mi - nj) + l15 - 4 * g4 - r) * lg) : 1.0f;
#define V3_PTILE(st_) do { LAS unsigned char* Bn = lds + ((st_) & 1) * BUF; f32x4 pa = (f32x4){0.f, 0.f, 0.f, 0.f}; \
                if (nj <= mi) { _Pragma("unroll") for (int s = 0; s < NS; ++s) { \
                        const s16x8 ka = *(const LAS s16x8*)(Bn + TK + (s >> 2) * (C * 256) + offb(l15 + 16 * nj, 4 * (s & 3) + g4)); \
                        const s16x8 qb = *(const LAS s16x8*)(Bn + TQ + (s >> 2) * (C * 256) + offb(l15 + 16 * mi, 4 * (s & 3) + g4)); \
                        pa = MFMA16(ka, qb, pa); } \
                    _Pragma("unroll") for (int r = 0; r < 4; ++r) pa[r] = (16 * nj + 4 * g4 + r > 16 * mi + l15) ? 0.f : pa[r] * pf[r]; } \
                u32x2 pk; pk.x = pk_bf16(pa[0], pa[1]); pk.y = pk_bf16(pa[2], pa[3]); \
                *(LAS u32x2*)(Bn + TP + (16 * mi + l15) * 80 + 2 * (16 * nj + 4 * g4)) = pk; } while (0)
            V3_LOAD(0, 0); V3_LOAD(1, 1);
            V3_STAGE(0, 0);
            V3_LOAD(0, 2);
            __syncthreads();
            if (ctx_out || 0 >= NCTX) V3_PTILE(0);
            __syncthreads();
            for (int st = 0; st < NSTEP; st += 2) {
                if (st + 1 < NSTEP) V3_STAGE(1, st + 1);
                if ((PROBE_SCAN & 1) && !RET && st + 1 < NSTEP) V3_STAGE(1, st + 1);
                { const int sl_ = st + 3 < NSTEP ? st + 3 : NSTEP - 1; V3_LOAD(1, sl_); }
                __syncthreads();
                if ((PROBE_SCAN & 4) && !RET) { __syncthreads(); __syncthreads(); }
                if (st + 1 < NSTEP && (ctx_out || st + 1 >= NCTX)) V3_PTILE(st + 1);
                __syncthreads();
                if (st + 2 < NSTEP) V3_STAGE(0, st + 2);
                if ((PROBE_SCAN & 1) && !RET && st + 2 < NSTEP) V3_STAGE(0, st + 2);
                { const int sl_ = st + 4 < NSTEP ? st + 4 : NSTEP - 1; V3_LOAD(0, sl_); }
                __syncthreads();
                if ((PROBE_SCAN & 4) && !RET) { __syncthreads(); __syncthreads(); }
                if (st + 2 < NSTEP && (ctx_out || st + 2 >= NCTX)) V3_PTILE(st + 2);
                __syncthreads();
            }
#undef V3_LOAD
#undef V3_STAGE
#undef V3_PTILE
        }
        __syncthreads();
#undef V3_ROWBASE
    }
}

constexpr int NPHASES = 20;
#ifndef GEMM_STAGGER_TICKS
#define GEMM_STAGGER_TICKS 0
#endif
#ifndef SCAN_IMPL
#define SCAN_IMPL scan_v3_phase
#endif
template <class Epi, bool F8 = false>
DI void run_gemm(LAS unsigned char* lds, const bf16_t* Aop, const bf16_t* Bt, int M, int N, int K, int pmg, size_t bgs, const Epi& E, int G = -1, int c = -1, int rb = 0, int re = 1 << 30) {
    pg8::Gemm g{Aop, Bt, M, N, K, pmg, bgs};
    if (G < 0) { G = (int)gridDim.x; c = (int)blockIdx.x; }
    pg8::StaticOrder S; S.init(M, N, G, c, (pmg < 64) ? pmg : 8); S.ib = rb; S.ie = re;
    if (GEMM_STAGGER_TICKS > 0 && (M / 256) * (N / 256) >= 4 * (int)gridDim.x) {
        const unsigned long long t0 = __builtin_amdgcn_s_memrealtime(), dl = (unsigned long long)((blockIdx.x & 7u) * GEMM_STAGGER_TICKS);
        while (__builtin_amdgcn_s_memrealtime() - t0 < dl) __builtin_amdgcn_s_sleep(8);
    }
    pg8::gemm_phase<Epi, pg8::StaticOrder, false, F8>((PG8_LAS unsigned char*)lds, g, S, E, nullptr);
}

template <class Epi, bool F8 = false>
DI void run_gemm_cvt(const Args& A, LAS unsigned char* lds, const bf16_t* Aop, const bf16_t* Bt, int M, int N, int K, int pmg, size_t bgs, const Epi& E, int base, int count) {
    const int G = (int)gridDim.x, c = (int)blockIdx.x, nwg = (M / 256) * (N / 256), R = (nwg + G - 1) / G;
    const int sp = ((c & 7) % R) + 1;
    run_gemm<Epi, F8>(lds, Aop, Bt, M, N, K, pmg, bgs, E, -1, -1, 0, sp);
    __syncthreads();
    convert_range_fast(A, lds, base, count, c, G);
    __syncthreads();
    run_gemm<Epi, F8>(lds, Aop, Bt, M, N, K, pmg, bgs, E, -1, -1, sp, 1 << 30);
}

__global__ void __launch_bounds__(NTHREADS, 2) mk_fwd(Args A) {
    extern __shared__ __attribute__((aligned(16))) unsigned char lds_raw[];
    LAS unsigned char* lds = (LAS unsigned char*)lds_raw;
    unsigned char* ws = A.ws;
    const int lo = A.ph_lo, hi = A.ph_hi;
    XcdBarrier bar; bar.bar = (unsigned*)(ws + WS_BAR); bar.x = 0; bar.st = nullptr;
    if (hi - lo > 1) {
        volatile LAS unsigned* st = (volatile LAS unsigned*)(lds + MISC_OFF);
        if (threadIdx.x == 0) { st[0] = 0u; st[1] = 0u; st[2] = 0u; st[3] = 0u; }
        __syncthreads();
        bar = xcd_barrier_post((unsigned*)(ws + WS_BAR), st);
    }
#ifndef REP_MASK
#define REP_MASK 0
#endif
#ifdef ONLY_PHASE
#define IN(k) ((k) == ONLY_PHASE && lo <= (k) && (k) < hi)
#else
#define IN(k) (lo <= (k) && (k) < hi)
#endif
#define SEAM(k) do { if (IN(k) && IN((k) + 1)) xcd_barrier(bar); } while (0)
    const float* MOD0 = (const float*)(ws + WS_MOD); const float* MOD1 = MOD0 + 9 * 6144;
    bf16_t* X = (bf16_t*)(ws + WS_X); bf16_t* H = (bf16_t*)(ws + WS_H); bf16_t* PROJ = (bf16_t*)(ws + WS_R1); bf16_t* A2 = (bf16_t*)(ws + WS_A2);
    const bf16_t* XE = (const bf16_t*)(ws + WS_R2); bf16_t* Y = (bf16_t*)(ws + WS_R2 + R2_HALF); unsigned char* ACT = ws + WS_R1;

    if (IN(0)) { p0_prologue(A, lds); if (REP_MASK >> 0 & 1) { __syncthreads(); p0_prologue(A, lds); } }
    SEAM(0);
    if (IN(1)) { row_phase<0, 3>(A, lds, NTOK, A.in[I_X], A.in[I_CTX], A.in[I_NMIX], MOD0, 0, 1024, nullptr, 0, nullptr); if (REP_MASK >> 1 & 1) { __syncthreads(); row_phase<0, 3>(A, lds, NTOK, A.in[I_X], A.in[I_CTX], A.in[I_NMIX], MOD0, 0, 1024, nullptr, 0, nullptr); } }
    SEAM(1);
    if (IN(2)) { { EpiRetIn E{PROJ, (const f32x2*)(ws + WS_ROPE), (const f32x2*)(ws + WS_ROPE) + 2048}; run_gemm_cvt(A, lds, H, (const bf16_t*)(ws + WS_WRI), NTOK, RET_IN, 1024, 1 << 20, 0, E, I2_B, I2_N); } if (REP_MASK >> 2 & 1) { __syncthreads(); { EpiRetIn E{PROJ, (const f32x2*)(ws + WS_ROPE), (const f32x2*)(ws + WS_ROPE) + 2048}; run_gemm(lds, H, (const bf16_t*)(ws + WS_WRI), NTOK, RET_IN, 1024, 1 << 20, 0, E); } } }
    if (IN(2)) { tail_convert(A, lds, (NTOK / 256) * (RET_IN / 256), T2_B, T2_N); tail_convert(A, lds, (NTOK / 256) * (RET_IN / 256), T2X_B, T2X_N); }
    SEAM(2);
    if (IN(3)) { SCAN_IMPL<true>(A, lds, true); if (REP_MASK >> 3 & 1) { __syncthreads(); SCAN_IMPL<true>(A, lds, true); } }
    SEAM(3);
    if (IN(4)) { readout_phase<true>(A, NTOK); if (REP_MASK >> 4 & 1) { __syncthreads(); readout_phase<true>(A, NTOK); } }
    SEAM(4);
    if (IN(5)) { { EpiResidT<false> E{A.in[I_X], A.in[I_CTX], X, MOD0, 2048}; run_gemm<EpiResidT<false>, true>(lds, A2, (const bf16_t*)(ws + WS_WRO), NTOK, 1024, 1024, 1 << 20, 0, E); } if (REP_MASK >> 5 & 1) { __syncthreads(); { EpiResidT<false> E{A.in[I_X], A.in[I_CTX], X, MOD0, 2048}; run_gemm<EpiResidT<false>, true>(lds, A2, (const bf16_t*)(ws + WS_WRO), NTOK, 1024, 1024, 1 << 20, 0, E); } } }
    if (IN(5)) tail_convert(A, lds, (NTOK / 256) * 4, T5_B, T5_N);
    SEAM(5);
    if (IN(6)) { row_phase<2, 3>(A, lds, NTOK, nullptr, nullptr, A.in[I_NFFN], MOD0, 3 * 1024, 4 * 1024, nullptr, 0, A.in[I_ROUTER]); if (REP_MASK >> 6 & 1) { __syncthreads(); row_phase<2, 3>(A, lds, NTOK, nullptr, nullptr, A.in[I_NFFN], MOD0, 3 * 1024, 4 * 1024, nullptr, 0, A.in[I_ROUTER]); } }
    SEAM(6);
    if (IN(7)) { topk_phase(A, lds, 256, MPER0); if (REP_MASK >> 7 & 1) { __syncthreads(); topk_phase(A, lds, 256, MPER0); } }
    if (IN(7) && (int)gridDim.x > 128) { __syncthreads(); if ((int)blockIdx.x >= 128) convert_range_fast(A, lds, T7_B, T7_N, (int)blockIdx.x - 128, (int)gridDim.x - 128); }
    else if (IN(7)) { __syncthreads(); convert_range_fast(A, lds, T7_B, T7_N, (int)blockIdx.x, (int)gridDim.x); }
    SEAM(7);
    if (IN(8)) { { EpiMoe1 E{ACT}; run_gemm_cvt<EpiMoe1, true>(A, lds, XE, (const bf16_t*)(ws + WS_WM1), NE * MPER0, N1, 512, MPER0 / 256, (size_t)N1 * 1024, E, I8_B, I8_N); } if (REP_MASK >> 8 & 1) { __syncthreads(); { EpiMoe1 E{ACT}; run_gemm<EpiMoe1, true>(lds, XE, (const bf16_t*)(ws + WS_WM1), NE * MPER0, N1, 512, MPER0 / 256, (size_t)N1 * 1024, E); } } }
    if (IN(8)) tail_convert(A, lds, (NE * MPER0 / 256) * (N1 / 256), T8_B, T8_N);
    SEAM(8);
    if (IN(9)) { { EpiPlainF8 E{(unsigned char*)Y, 1024, Y_SCALE}; run_gemm<EpiPlainF8, true>(lds, (const bf16_t*)ACT, (const bf16_t*)(ws + WS_WM2), NE * MPER0, 1024, FF / 2, MPER0 / 256, (size_t)1024 * FF, E); } if (REP_MASK >> 9 & 1) { __syncthreads(); { EpiPlainF8 E{(unsigned char*)Y, 1024, Y_SCALE}; run_gemm<EpiPlainF8, true>(lds, (const bf16_t*)ACT, (const bf16_t*)(ws + WS_WM2), NE * MPER0, 1024, FF / 2, MPER0 / 256, (size_t)1024 * FF, E); } } }
    if (IN(9)) tail_convert(A, lds, (NE * MPER0 / 256) * 4, T9_B, T9_N);
    SEAM(9);
    if (IN(10)) { row_phase<1, 3>(A, lds, NTOK, nullptr, nullptr, A.in[I_NMIX] + 1024, MOD1, 0, 1024, MOD0, MPER0, nullptr); if (REP_MASK >> 10 & 1) { __syncthreads(); row_phase<1, 3>(A, lds, NTOK, nullptr, nullptr, A.in[I_NMIX] + 1024, MOD1, 0, 1024, MOD0, MPER0, nullptr); } }
    SEAM(10);
    if (IN(11)) { { EpiHgIn E{PROJ, (const float*)(ws + WS_LB), 0}; run_gemm(lds, H, (const bf16_t*)(ws + WS_WHI), NTOK, HG_IN - 1024, 1024, 1 << 20, 0, E); } if (REP_MASK >> 11 & 1) { __syncthreads(); { EpiHgIn E{PROJ, (const float*)(ws + WS_LB), 0}; run_gemm(lds, H, (const bf16_t*)(ws + WS_WHI), NTOK, HG_IN - 1024, 1024, 1 << 20, 0, E); } } }
    if (IN(11)) tail_convert(A, lds, (NTOK / 256) * ((HG_IN - 1024) / 256), T11_B, T11_N);
    SEAM(11);
    if (IN(12)) {
        const int G = (int)gridDim.x;
        EpiHgIn Eg{PROJ, (const float*)(ws + WS_LB), 16};
        if (G > 128) { if ((int)blockIdx.x >= 128) { run_gemm(lds, H, (const bf16_t*)(ws + WS_WHI) + (size_t)4096 * 1024, NLAT, 1024, 1024, 1 << 20, 0, Eg, G - 128, (int)blockIdx.x - 128);
                                                     __syncthreads(); convert_range_fast(A, lds, T12A_B, T12A_N, (int)blockIdx.x - 128, G - 128); convert_range_fast(A, lds, T12B_B, T12B_N, (int)blockIdx.x - 128, G - 128); }
                       else { SCAN_IMPL<false>(A, lds, false); if (REP_MASK >> 12 & 1) SCAN_IMPL<false>(A, lds, false); } }
        else { SCAN_IMPL<false>(A, lds, false); __syncthreads(); run_gemm(lds, H, (const bf16_t*)(ws + WS_WHI) + (size_t)4096 * 1024, NLAT, 1024, 1024, 1 << 20, 0, Eg);
               __syncthreads(); convert_range_fast(A, lds, T12A_B, T12A_N, (int)blockIdx.x, G); convert_range_fast(A, lds, T12B_B, T12B_N, (int)blockIdx.x, G); }
    }
    SEAM(12);
    if (IN(13)) { readout_phase<false>(A, NLAT); if (REP_MASK >> 13 & 1) { __syncthreads(); readout_phase<false>(A, NLAT); } }
    SEAM(13);
    if (IN(14)) { { EpiResidT<true> E{nullptr, nullptr, X, MOD1, 2048}; run_gemm(lds, A2, (const bf16_t*)(ws + WS_WHO), NLAT, 1024, 1024, 1 << 20, 0, E); } if (REP_MASK >> 14 & 1) { __syncthreads(); { EpiResidT<true> E{nullptr, nullptr, X, MOD1, 2048}; run_gemm(lds, A2, (const bf16_t*)(ws + WS_WHO), NLAT, 1024, 1024, 1 << 20, 0, E); } } }
    SEAM(14);
    if (IN(15)) { row_phase<2, 4>(A, lds, NLAT, nullptr, nullptr, A.in[I_NFFN] + 1024, MOD1, 3 * 1024, 4 * 1024, nullptr, 0, A.in[I_ROUTER] + 1024 * 16); if (REP_MASK >> 15 & 1) { __syncthreads(); row_phase<2, 4>(A, lds, NLAT, nullptr, nullptr, A.in[I_NFFN] + 1024, MOD1, 3 * 1024, 4 * 1024, nullptr, 0, A.in[I_ROUTER] + 1024 * 16); } }
    SEAM(15);
    if (IN(16)) { topk_phase(A, lds, 128, MPER1); if (REP_MASK >> 16 & 1) { __syncthreads(); topk_phase(A, lds, 128, MPER1); } }
    if (IN(16) && (int)gridDim.x > 128) { __syncthreads(); if ((int)blockIdx.x >= 128) convert_range_fast(A, lds, T16_B, T16_N, (int)blockIdx.x - 128, (int)gridDim.x - 128); }
    else if (IN(16)) { __syncthreads(); convert_range_fast(A, lds, T16_B, T16_N, (int)blockIdx.x, (int)gridDim.x); }
    SEAM(16);
    if (IN(17)) { { EpiMoe1 E{ACT}; run_gemm<EpiMoe1, true>(lds, XE, (const bf16_t*)(ws + WS_WM1 + (size_t)16 * N1 * 1024), NE * MPER1, N1, 512, MPER1 / 256, (size_t)N1 * 1024, E); } if (REP_MASK >> 17 & 1) { __syncthreads(); { EpiMoe1 E{ACT}; run_gemm<EpiMoe1, true>(lds, XE, (const bf16_t*)(ws + WS_WM1 + (size_t)16 * N1 * 1024), NE * MPER1, N1, 512, MPER1 / 256, (size_t)N1 * 1024, E); } } }
    SEAM(17);
    if (IN(18)) { { EpiPlainF8 E{(unsigned char*)Y, 1024, Y_SCALE}; run_gemm<EpiPlainF8, true>(lds, (const bf16_t*)ACT, (const bf16_t*)(ws + WS_WM2 + (size_t)16 * 1024 * FF), NE * MPER1, 1024, FF / 2, MPER1 / 256, (size_t)1024 * FF, E); } if (REP_MASK >> 18 & 1) { __syncthreads(); { EpiPlainF8 E{(unsigned char*)Y, 1024, Y_SCALE}; run_gemm<EpiPlainF8, true>(lds, (const bf16_t*)ACT, (const bf16_t*)(ws + WS_WM2 + (size_t)16 * 1024 * FF), NE * MPER1, 1024, FF / 2, MPER1 / 256, (size_t)1024 * FF, E); } } }
    SEAM(18);
    if (IN(19)) { row_phase<5>(A, lds, NLAT, nullptr, nullptr, A.in[I_NFIN], nullptr, 0, 0, MOD1, MPER1, nullptr); if (REP_MASK >> 19 & 1) { __syncthreads(); row_phase<5>(A, lds, NLAT, nullptr, nullptr, A.in[I_NFIN], nullptr, 0, 0, MOD1, MPER1, nullptr); } }
#undef IN
#undef SEAM
}

extern "C" void kernel_launch(void* const* d_in, const int* in_sizes, int n_in, void* d_out, int out_size, void* d_ws, size_t ws_size, hipStream_t stream) {
    static int grid = 0;
    if (grid == 0) {
        if (n_in != 19 || out_size != NLAT * D || ws_size < WS_END) { fprintf(stderr, "kernel_launch: unexpected shapes (n_in %d, out %d, ws %zu < %zu)\n", n_in, out_size, ws_size, (size_t)WS_END); grid = -1; return; }
        int dev = 0, cus = 0, per_cu = 0;
        if (hipGetDevice(&dev) != hipSuccess || hipDeviceGetAttribute(&cus, hipDeviceAttributeMultiprocessorCount, dev) != hipSuccess) { grid = -1; return; }
        if (hipFuncSetAttribute((const void*)mk_fwd, hipFuncAttributeMaxDynamicSharedMemorySize, LDS_BYTES) != hipSuccess) { fprintf(stderr, "kernel_launch: hipFuncSetAttribute failed\n"); grid = -1; return; }
        if (hipOccupancyMaxActiveBlocksPerMultiprocessor(&per_cu, (const void*)mk_fwd, NTHREADS, LDS_BYTES) != hipSuccess || per_cu < 1) { fprintf(stderr, "kernel_launch: occupancy query says %d\n", per_cu); }
        (void)hipGetLastError();
        grid = cus;
    }
    if (grid < 0) return;
    (void)hipMemsetAsync((char*)d_ws + WS_BAR, 0, 16384, stream);
    Args a{};
    for (int i = 0; i < 19; ++i) a.in[i] = (const float*)d_in[i];
    a.out = (float*)d_out; a.ws = (unsigned char*)d_ws;
#if MK_PER_PHASE
    for (int p = 0; p < NPHASES; ++p) { a.ph_lo = p; a.ph_hi = p + 1; hipLaunchKernelGGL(mk_fwd, dim3(grid), dim3(NTHREADS), LDS_BYTES, stream, a); }
#else
    a.ph_lo = 0; a.ph_hi = NPHASES;
    hipLaunchKernelGGL(mk_fwd, dim3(grid), dim3(NTHREADS), LDS_BYTES, stream, a);
#endif
}
```

```cpp
#include <hip/hip_runtime.h>
#include <cstdio>
#include <cstdint>
#ifndef MK_PER_PHASE
#define MK_PER_PHASE 0
#endif
namespace pg8 {
#define PG8_LAS __attribute__((address_space(3)))
typedef unsigned short bf16_t;
typedef short bf16x8 __attribute__((ext_vector_type(8)));
typedef float f32x4 __attribute__((ext_vector_type(4)));
typedef unsigned u32x4 __attribute__((ext_vector_type(4)));
constexpr int BM = 256, BK = 64, HALF = 128, HTB = HALF * BK * 2  , STAGE_BYTES = 8 * HTB, NXCD = 8, WGM = 8;

__host__ __device__ __forceinline__ int lds_byte(int r, int c) { const int st = (r >> 4) * 2 + (c >> 5), rr = r & 15, cc = c & 31, ob = rr * 64 + cc * 2; return st * 1024 + (ob ^ (((ob >> 9) & 1) << 5)); }
__host__ __device__ __forceinline__ void stage_rc(int b, int& R, int& C) { const int st = b / 1024, sb = b % 1024, swz = sb ^ (((sb >> 9) & 1) << 5); R = (st >> 1) * 16 + swz / 64; C = (st & 1) * 32 + (swz % 64) / 2; }
__host__ __device__ __forceinline__ int perm32(int rho) { const int n = rho >> 4, i = rho & 15; return 8 * (i >> 2) + 4 * n + (i & 3); }

struct Unit { int pm, pn; };
struct Gemm { const bf16_t* A; const bf16_t* Bt; int M, N, K; int pmg; size_t bgs; };

struct StaticOrder {
    int ib = 0, ie = 1 << 30;
    int nM, nN, nwg, G, c, wgm;
    __host__ __device__ void init(int M, int N, int G_, int c_, int wgm_ = WGM) { nM = M / BM; nN = N / BM; nwg = nM * nN; G = G_; c = c_; wgm = wgm_; }
    __host__ __device__ bool next(int i, Unit& u) const {
        const long ii = (long)i + ib; if (ii >= ie) return false;
        const long L = ii * G + c; if (L >= nwg) return false;
        int wgid = (int)L; { const int q = nwg / NXCD, r = nwg % NXCD, xcd = wgid % NXCD, off = wgid / NXCD; wgid = (xcd < r ? xcd * (q + 1) : r * (q + 1) + (xcd - r) * q) + off; }
        const int nig = wgm * nN, gid = wgid / nig, fm = gid * wgm, gsz = (nM - fm) < wgm ? (nM - fm) : wgm;
        u.pm = fm + ((wgid % nig) % gsz); u.pn = (wgid % nig) / gsz; return true;
    }
    __device__ __forceinline__ void a_ready(const Unit&) const {}
    __device__ __forceinline__ void done(const Unit&) const {}
};
__device__ __forceinline__ unsigned cvt_pk_bf16(float lo, float hi) { unsigned r; asm volatile("v_cvt_pk_bf16_f32 %0, %1, %2" : "=v"(r) : "v"(lo), "v"(hi)); return r; }

template <class Epi, class Sched, bool STAMP = false, bool F8 = false>
__device__ __forceinline__ void gemm_phase(PG8_LAS unsigned char* lds, const Gemm g, const Sched& S, const Epi& E, unsigned long long* stamps) {
    const int tid = threadIdx.x, wid = __builtin_amdgcn_readfirstlane(tid >> 6), lane = tid & 63, wr = wid >> 2, wc = wid & 3, fr = lane & 15, fq = lane >> 4;
    int K_ = g.K; if constexpr (F8) { asm volatile("" : "+s"(K_)); }
    const int K = K_, nt = K / BK;
    const int f8_scale_w = 0x79797979, f8_scale_a = 0x7f7f7f7f;
    int ts_lo = 0, ts_hi = 0, nts = 0; const unsigned long long rt_entry = STAMP ? (unsigned long long)wall_clock64() : 0ull;
#define PG8_STAMP() do { if (STAMP && wid == 0 && nts < 64) { const unsigned long long _c = (unsigned long long)clock64(); \
        ts_lo = (lane == nts) ? (int)(unsigned)_c : ts_lo; ts_hi = (lane == nts) ? (int)(unsigned)(_c >> 32) : ts_hi; ++nts; } } while (0)
    PG8_STAMP();
    unsigned voffA[2], voffB[2];
#pragma unroll
    for (int i = 0; i < 2; ++i) { int R, C; stage_rc(tid * 16 + i * 8192, R, C); const int Rb = Epi::PERM ? ((R & ~31) + perm32(R & 31)) : R;
        voffA[i] = (unsigned)(R * K + C) * 2u; voffB[i] = (unsigned)(Rb * K + C) * 2u; }
    const size_t kstep = (size_t)(BK * 2);
    const size_t hstep = (size_t)HALF * K * 2;
    const size_t tstep = 2 * hstep;
    const unsigned ldsw = (unsigned)wid * 1024u;
    const int aoff = lds_byte(wr * 64 + fr, fq * 8), boff = lds_byte(wc * 32 + fr, fq * 8);
#define PG8_SA(b, h) (((b) * 2 + (h)) * HTB)
#define PG8_SB(b, h) ((4 + (b) * 2 + (h)) * HTB)
#define PG8_STAGE(bufoff, gbase, voff) do { _Pragma("unroll") for (int _i = 0; _i < 2; ++_i) \
        __builtin_amdgcn_global_load_lds((const unsigned*)((const char*)(gbase) + (voff)[_i]), (PG8_LAS unsigned*)(lds + (bufoff) + ldsw + _i * 8192), 16, 0, 0); } while (0)
#define PG8_LDA(dst, b, h) do { _Pragma("unroll") for (int m = 0; m < 4; ++m) { const bf16x8 lo_ = *(const PG8_LAS bf16x8*)(lds + PG8_SA(b, h) + aoff + m * 2048), hi_ = *(const PG8_LAS bf16x8*)(lds + PG8_SA(b, h) + aoff + m * 2048 + 1024); \
        dst[m] = __builtin_shufflevector(lo_, hi_, 0, 1, 2, 3, 4, 5, 6, 7, 8, 9, 10, 11, 12, 13, 14, 15); } } while (0)
#define PG8_LDB(dst, b, h) do { _Pragma("unroll") for (int n = 0; n < 2; ++n) { const bf16x8 lo_ = *(const PG8_LAS bf16x8*)(lds + PG8_SB(b, h) + boff + n * 2048), hi_ = *(const PG8_LAS bf16x8*)(lds + PG8_SB(b, h) + boff + n * 2048 + 1024); \
        dst[n] = __builtin_shufflevector(lo_, hi_, 0, 1, 2, 3, 4, 5, 6, 7, 8, 9, 10, 11, 12, 13, 14, 15); } } while (0)
#define PG8_MMA(ai, bj, At, Bt) do { __builtin_amdgcn_s_setprio(1); _Pragma("unroll") for (int m = 0; m < 4; ++m) _Pragma("unroll") for (int n = 0; n < 2; ++n) { \
        if constexpr (F8) { asm volatile("v_mfma_scale_f32_16x16x128_f8f6f4 %0, %1, %2, %0, %3, %4 op_sel_hi:[0,0,0]" : "+v"(acc[ai][bj][m][n]) : "v"(__builtin_bit_cast(i32x8_, Bt[n])), "v"(__builtin_bit_cast(i32x8_, At[m])), "v"(f8_scale_w), "v"(f8_scale_a)); } \
        else { acc[ai][bj][m][n] = __builtin_amdgcn_mfma_f32_16x16x32_bf16(__builtin_shufflevector(Bt[n], Bt[n], 0, 1, 2, 3, 4, 5, 6, 7), __builtin_shufflevector(At[m], At[m], 0, 1, 2, 3, 4, 5, 6, 7), acc[ai][bj][m][n], 0, 0, 0); \
               acc[ai][bj][m][n] = __builtin_amdgcn_mfma_f32_16x16x32_bf16(__builtin_shufflevector(Bt[n], Bt[n], 8, 9, 10, 11, 12, 13, 14, 15), __builtin_shufflevector(At[m], At[m], 8, 9, 10, 11, 12, 13, 14, 15), acc[ai][bj][m][n], 0, 0, 0); } } \
        __builtin_amdgcn_s_setprio(0); } while (0)
#define PG8_WAIT_V(n) asm volatile("s_waitcnt vmcnt(" #n ")" ::: "memory")
#define PG8_WAIT_L(n) asm volatile("s_waitcnt lgkmcnt(" #n ")" ::: "memory")
#define PG8_BAR __builtin_amdgcn_s_barrier()
#define PG8_SCHED __builtin_amdgcn_sched_barrier(0)
    Unit cur, nxt; int ui = 0;
    if (!S.next(0, cur)) return;
    f32x4 acc[2][2][4][2];
#pragma unroll
    for (int a = 0; a < 2; ++a)
#pragma unroll
        for (int b = 0; b < 2; ++b)
#pragma unroll
            for (int m = 0; m < 4; ++m)
#pragma unroll
                for (int n = 0; n < 2; ++n) acc[a][b][m][n] = (f32x4){0.f, 0.f, 0.f, 0.f};
    typedef short s16x16_ __attribute__((ext_vector_type(16))); typedef int i32x8_ __attribute__((ext_vector_type(8)));
    s16x16_ At[4], B0[2], B1[2];
    const char* cA = (const char*)g.A + (size_t)cur.pm * tstep; const char* cB = (const char*)g.Bt + (size_t)(cur.pm / g.pmg) * g.bgs + (size_t)cur.pn * tstep;
    S.a_ready(cur);
    PG8_STAGE(PG8_SB(0, 0), cB, voffB); PG8_STAGE(PG8_SA(0, 0), cA, voffA); PG8_STAGE(PG8_SB(0, 1), cB + hstep, voffB); PG8_STAGE(PG8_SA(0, 1), cA + hstep, voffA);
    if (wr == 1) PG8_BAR;
    PG8_WAIT_V(4); PG8_BAR;
    PG8_STAGE(PG8_SB(1, 0), cB + kstep, voffB); PG8_STAGE(PG8_SA(1, 0), cA + kstep, voffA); PG8_STAGE(PG8_SB(1, 1), cB + hstep + kstep, voffB);
    PG8_WAIT_V(6); PG8_BAR;
    PG8_STAMP();
    for (;;) {
        const bool has_next = S.next(ui + 1, nxt);
        const char* nA = has_next ? (const char*)g.A + (size_t)nxt.pm * tstep : cA; const char* nB = has_next ? (const char*)g.Bt + (size_t)(nxt.pm / g.pmg) * g.bgs + (size_t)nxt.pn * tstep : cB;
        for (int t = 0; t < nt; t += 2) {
            const bool last = (t == nt - 2);
            const char* a1 = cA + (size_t)(t + 1) * kstep;
            const char* a2 = last ? nA : cA + (size_t)(t + 2) * kstep; const char* b2 = last ? nB : cB + (size_t)(t + 2) * kstep;
            const char* a3 = a2 + kstep; const char* b3 = b2 + kstep;
            if (last && has_next) S.a_ready(nxt);
            PG8_LDB(B0, 0, 0); PG8_SCHED; PG8_LDA(At, 0, 0); PG8_STAGE(PG8_SA(1, 1), a1 + hstep, voffA);
            PG8_WAIT_L(8); PG8_BAR; PG8_WAIT_L(0); PG8_MMA(0, 0, At, B0); PG8_BAR; PG8_SCHED;
            PG8_LDB(B1, 0, 1); PG8_STAGE(PG8_SB(0, 0), b2, voffB);
            PG8_BAR; PG8_WAIT_L(0); PG8_MMA(0, 1, At, B1); PG8_BAR;
            PG8_LDA(At, 0, 1); PG8_STAGE(PG8_SA(0, 0), a2, voffA);
            PG8_BAR; PG8_WAIT_L(0); PG8_MMA(1, 0, At, B0); PG8_BAR; PG8_SCHED;
            PG8_STAGE(PG8_SB(0, 1), b2 + hstep, voffB);
            PG8_WAIT_V(6); PG8_BAR; PG8_MMA(1, 1, At, B1); PG8_BAR;
            PG8_LDB(B0, 1, 0); PG8_SCHED; PG8_LDA(At, 1, 0); PG8_STAGE(PG8_SA(0, 1), a2 + hstep, voffA);
            PG8_WAIT_L(8); PG8_BAR; PG8_WAIT_L(0); PG8_MMA(0, 0, At, B0); PG8_BAR; PG8_SCHED;
            PG8_LDB(B1, 1, 1); PG8_STAGE(PG8_SB(1, 0), b3, voffB);
            PG8_BAR; PG8_WAIT_L(0); PG8_MMA(0, 1, At, B1); PG8_BAR;
            PG8_LDA(At, 1, 1); PG8_STAGE(PG8_SA(1, 0), a3, voffA);
            PG8_BAR; PG8_WAIT_L(0); PG8_MMA(1, 0, At, B0); PG8_BAR; PG8_SCHED;
            PG8_STAGE(PG8_SB(1, 1), b3 + hstep, voffB);
            PG8_WAIT_V(6); PG8_BAR; PG8_MMA(1, 1, At, B1); PG8_BAR;
        }
        PG8_STAMP();
        if constexpr (!Epi::AFTER_DRAIN) { E(acc, cur, wr, wc, fr, fq); S.done(cur); }
        PG8_STAMP();
        if (!has_next) break;
#pragma unroll
        for (int a = 0; a < 2; ++a)
#pragma unroll
            for (int b = 0; b < 2; ++b)
#pragma unroll
                for (int m = 0; m < 4; ++m)
#pragma unroll
                    for (int n = 0; n < 2; ++n) acc[a][b][m][n] = (f32x4){0.f, 0.f, 0.f, 0.f};
        cur = nxt; cA = nA; cB = nB; ++ui;
    }
    PG8_WAIT_V(0);
    if (wr == 0) PG8_BAR;
    PG8_BAR;
    if constexpr (Epi::AFTER_DRAIN) { E.fused(acc, cur, wr, wc, fr, fq, lds, wid, lane); S.done(cur); }
    PG8_STAMP();
    if (STAMP && wid == 0) { stamps[lane] = lane < nts ? (((unsigned long long)(unsigned)ts_hi << 32) | (unsigned)ts_lo) : 0ull;
        if (lane == 62) stamps[62] = rt_entry; if (lane == 63) stamps[63] = (unsigned long long)wall_clock64(); }
#undef PG8_STAMP
#undef PG8_SA
#undef PG8_SB
#undef PG8_STAGE
#undef PG8_LDA
#undef PG8_LDB
#undef PG8_MMA
#undef PG8_WAIT_V
#undef PG8_WAIT_L
#undef PG8_BAR
#undef PG8_SCHED
}
}
#define XB_TMO      128
#define XB_XCNT(j)  (256  + 64 * (j))
#define XB_XSUB(j)  (1280 + 64 * (j))
#define XB_XGEN(j)  (2304 + 64 * (j))
#define XB_TOP      3328
#define XB_TOPGEN   3392
#define XCD_BAR_WORDS 3456
#define XB_SPIN_CAP (1u << 18)
#define LAS __attribute__((address_space(3)))

__device__ __forceinline__ unsigned xb_ld(unsigned* p)              { return __hip_atomic_load(p, __ATOMIC_RELAXED, __HIP_MEMORY_SCOPE_AGENT); }
__device__ __forceinline__ unsigned xb_add(unsigned* p, unsigned v) { return __hip_atomic_fetch_add(p, v, __ATOMIC_RELAXED, __HIP_MEMORY_SCOPE_AGENT); }
__device__ __forceinline__ unsigned xb_xcc_id() { return (unsigned)__builtin_amdgcn_s_getreg((3 << 11) | 20) & 0xFu; }
#define XB_SPIN(cond, bar) do { unsigned _sp = 0; while (cond) { __builtin_amdgcn_s_sleep(1); \
    if ((++_sp & 255u) == 0u) { if (xb_ld(&(bar)[XB_TMO])) break; if (_sp > XB_SPIN_CAP) { atomicAdd(&(bar)[XB_TMO], 1u); break; } } } } while (0)

struct XcdBarrier {
    unsigned* bar; unsigned x;
    volatile LAS unsigned* st;
};

__device__ __forceinline__ XcdBarrier xcd_barrier_post(unsigned* bar, volatile LAS unsigned* st) {
    XcdBarrier b; b.bar = bar; b.x = xb_xcc_id(); b.st = st;
    if (threadIdx.x == 0) (void)xb_add(&bar[XB_XCNT(b.x)], 1u);
    return b;
}
__device__ __forceinline__ void xcd_barrier_complete(unsigned* bar, unsigned x, unsigned& nloc, unsigned& nx) {
    const unsigned G = gridDim.x * gridDim.y * gridDim.z;
    unsigned sum, cnt, mine, sp = 0u;
    for (;;) {
        sum = 0u; cnt = 0u; mine = 0u;
#pragma unroll
        for (unsigned j = 0; j < 16; ++j) { const unsigned c = xb_ld(&bar[XB_XCNT(j)]); sum += c; cnt += (c > 0u) ? 1u : 0u; mine = (j == x) ? c : mine; }
        if (sum == G) break;
        __builtin_amdgcn_s_sleep(1);
        if ((++sp & 255u) == 0u) { if (xb_ld(&bar[XB_TMO])) break; if (sp > XB_SPIN_CAP) { atomicAdd(&bar[XB_TMO], 1u); break; } }
    }
    nloc = mine > 0u ? mine : 1u; nx = cnt > 0u ? cnt : 1u;
}

__device__ __forceinline__ void xcd_barrier(const XcdBarrier& b) {
    asm volatile("s_waitcnt vmcnt(0)" ::: "memory");
    __syncthreads();
    if (threadIdx.x == 0) {
        unsigned* bar = b.bar;
        __builtin_amdgcn_s_waitcnt(0);
        unsigned nloc = b.st[0], nx = b.st[1];
        if (nloc == 0u) { xcd_barrier_complete(bar, b.x, nloc, nx); b.st[0] = nloc; b.st[1] = nx; }
        const unsigned old = xb_add(&bar[XB_XSUB(b.x)], 1u);
        const unsigned gen = old / nloc;
        if (old + 1u == (gen + 1u) * nloc) {
            __builtin_amdgcn_fence(__ATOMIC_RELEASE, "agent");
            asm volatile("s_waitcnt vmcnt(0)" ::: "memory");
            const unsigned og = xb_add(&bar[XB_TOP], 1u);
            const unsigned tg = og / nx;
            if (og + 1u == (tg + 1u) * nx) xb_add(&bar[XB_TOPGEN], 1u);
            else XB_SPIN(xb_ld(&bar[XB_TOPGEN]) == tg, bar);
            __builtin_amdgcn_fence(__ATOMIC_ACQUIRE, "agent");
            xb_add(&bar[XB_XGEN(b.x)], 1u);
            asm volatile("s_waitcnt vmcnt(0)" ::: "memory");
        } else {
            XB_SPIN(xb_ld(&bar[XB_XGEN(b.x)]) == gen, bar);
            __builtin_amdgcn_fence(__ATOMIC_ACQUIRE, "agent");
            asm volatile("s_waitcnt vmcnt(0)" ::: "memory");
        }
    }
    __syncthreads();
}


typedef unsigned short bf16_t;
typedef float f32x4 __attribute__((ext_vector_type(4)));
typedef float f32x2 __attribute__((ext_vector_type(2)));
typedef unsigned u32x4 __attribute__((ext_vector_type(4)));
typedef unsigned u32x2 __attribute__((ext_vector_type(2)));
typedef __bf16 bf16x2_t __attribute__((ext_vector_type(2)));
#define DI __device__ __forceinline__

constexpr int D = 1024, NB = 8, SEQ = 2048, CTXL = 256;
constexpr int NLAT = NB * SEQ, NCTX = NB * CTXL, NTOK = NLAT + NCTX;
constexpr int RET_IN = 6144, HG_IN = 5120, HG_PITCH = 7168;
constexpr int NE = 16, FF = 2816, N1 = 2 * FF;
constexpr int MPER0 = 2304, MPER1 = 2048;
constexpr float EPS = 1e-6f;
constexpr int NTHREADS = 512;
constexpr int LDS_BYTES = 131072 + 256;
constexpr int MISC_OFF = 131072;

constexpr size_t al256(size_t x) { return (x + 255) & ~(size_t)255; }
constexpr size_t WS_BAR  = 0;
constexpr size_t WS_MOD  = 16384;
constexpr size_t WS_ROPE = WS_MOD + al256(2 * 9 * 6144 * 4);
constexpr size_t WS_LB   = WS_ROPE + al256((32 * 64 + 64 * 64) * 8);
constexpr size_t WS_AFF  = WS_LB + al256(2 * 1024 * 4);
constexpr size_t WS_SLOT = WS_AFF + al256((size_t)NTOK * 16 * 4);
constexpr size_t WS_WRI  = WS_SLOT + al256((size_t)NTOK * 16 * 4);
constexpr size_t WS_WRO  = WS_WRI + al256((size_t)6144 * 1024 * 2);
constexpr size_t WS_WHI  = WS_WRO + al256((size_t)1024 * 2048 * 2);
constexpr size_t WS_WHO  = WS_WHI + al256((size_t)5120 * 1024 * 2);
constexpr size_t WS_WM1  = WS_WHO + al256((size_t)1024 * 1024 * 2);
constexpr size_t WS_WM2  = WS_WM1 + al256((size_t)32 * N1 * 1024 * 2);
constexpr size_t WS_X    = WS_WM2 + al256((size_t)32 * 1024 * FF * 2);
constexpr size_t WS_H    = WS_X + al256((size_t)NTOK * 1024 * 4);
constexpr size_t WS_R1   = WS_H + al256((size_t)NTOK * 1024 * 2);
constexpr size_t WS_R2   = WS_R1 + al256((size_t)NTOK * HG_PITCH * 2);
constexpr size_t WS_A2   = WS_R2 + al256((size_t)NTOK * 2048 * 2 * 2);
constexpr size_t WS_END  = WS_A2 + al256((size_t)NTOK * 2048 * 2);
constexpr size_t R2_HALF = (size_t)NTOK * 2048 * 2;

struct Args { const float* in[19]; float* out; unsigned char* ws; int ph_lo, ph_hi; };
enum { I_X = 0, I_C, I_CTX, I_CCTX, I_WADA, I_BADA, I_NMIX, I_NFFN, I_RWIN, I_RWOUT, I_HWIN, I_HGN, I_HLB, I_HWOUT, I_ROUTER, I_WG, I_WU, I_WD, I_NFIN };

DI unsigned pk_bf16(float lo, float hi) { f32x2 v = {lo, hi}; bf16x2_t b = __builtin_convertvector(v, bf16x2_t); return __builtin_bit_cast(unsigned, b); }
DI unsigned pk4_fp8(float a, float b, float c, float d) { int p = __builtin_amdgcn_cvt_pk_fp8_f32(a, b, 0, false); p = __builtin_amdgcn_cvt_pk_fp8_f32(c, d, p, true); return (unsigned)p; }
DI float bf_lo(unsigned u) { return __uint_as_float(u << 16); }
DI float bf_hi(unsigned u) { return __uint_as_float(u & 0xffff0000u); }
DI float bf2f(bf16_t h) { return __uint_as_float(((unsigned)h) << 16); }
DI bf16_t f2bf(float f) { return (bf16_t)(pk_bf16(f, 0.f) & 0xffffu); }
DI float fast_sigmoid(float x) { return __builtin_amdgcn_rcpf(1.0f + __expf(-x)); }
DI float silu_f(float x) { return x * fast_sigmoid(x); }
DI float wave_sum(float v) {
#pragma unroll
    for (int o = 32; o >= 1; o >>= 1) v += __shfl_xor(v, o);
    return v;
}
DI int mod_row(int row) { return row < NLAT ? (row >> 11) : 8; }

struct EpiRetIn {
    static constexpr bool PERM = true, AFTER_DRAIN = false;
    bf16_t* O; const f32x2* ropeR; const f32x2* ropeC;
    DI void operator()(const f32x4 (&acc)[2][2][4][2], const pg8::Unit& u, int wr, int wc, int fr, int fq) const {
        const int row0 = u.pm * 256 + wr * 64 + fr, col0 = u.pn * 256 + wc * 32 + 8 * fq;
        const bool rot = (u.pn < 8) && (u.pm < 64);
#pragma unroll
        for (int ai = 0; ai < 2; ++ai)
#pragma unroll
            for (int m = 0; m < 4; ++m) {
                const int row = row0 + ai * 128 + m * 16; bf16_t* rowp = O + (size_t)row * RET_IN + col0;
                const int t = row & 2047;
#pragma unroll
                for (int bj = 0; bj < 2; ++bj) {
                    f32x4 v0 = acc[ai][bj][m][0], v1 = acc[ai][bj][m][1];
                    if (rot) {
                        const f32x2* tb = bj ? (ropeC + (size_t)(t & 63) * 64) : (ropeR + (size_t)(t >> 6) * 64);
                        const int i0 = 16 * wc + 4 * fq;
                        const f32x4 cs0 = *(const f32x4*)(tb + i0), cs1 = *(const f32x4*)(tb + i0 + 2);
                        f32x4 o0, o1;
                        o0[0] = v0[0] * cs0[0] - v0[1] * cs0[1]; o0[1] = v0[0] * cs0[1] + v0[1] * cs0[0];
                        o0[2] = v0[2] * cs0[2] - v0[3] * cs0[3]; o0[3] = v0[2] * cs0[3] + v0[3] * cs0[2];
                        o1[0] = v1[0] * cs1[0] - v1[1] * cs1[1]; o1[1] = v1[0] * cs1[1] + v1[1] * cs1[0];
                        o1[2] = v1[2] * cs1[2] - v1[3] * cs1[3]; o1[3] = v1[2] * cs1[3] + v1[3] * cs1[2];
                        v0 = o0; v1 = o1;
                    }
                    u32x4 w; w.x = pk_bf16(v0[0], v0[1]); w.y = pk_bf16(v0[2], v0[3]); w.z = pk_bf16(v1[0], v1[1]); w.w = pk_bf16(v1[2], v1[3]);
                    *(u32x4*)(rowp + bj * 128) = w;
                }
            }
    }
};
struct EpiHgIn {
    static constexpr bool PERM = true, AFTER_DRAIN = false;
    bf16_t* O; const float* lb; int pn_off;
    DI void operator()(const f32x4 (&acc)[2][2][4][2], const pg8::Unit& u, int wr, int wc, int fr, int fq) const {
        const int pn = u.pn + pn_off;
        const int row0 = u.pm * 256 + wr * 64 + fr, col0 = pn * 256 + wc * 32 + 8 * fq;
        const int region = pn >> 2;
        f32x4 lbv[2][2];
        if (region == 1 || region == 2) {
#pragma unroll
            for (int bj = 0; bj < 2; ++bj)
#pragma unroll
                for (int n = 0; n < 2; ++n) lbv[bj][n] = *(const f32x4*)(lb + (col0 - 1024) + bj * 128 + 4 * n);
        }
#pragma unroll
        for (int ai = 0; ai < 2; ++ai)
#pragma unroll
            for (int m = 0; m < 4; ++m) {
                const int row = row0 + ai * 128 + m * 16; bf16_t* rowp = O + (size_t)row * HG_PITCH + col0;
#pragma unroll
                for (int bj = 0; bj < 2; ++bj) {
                    f32x4 v0 = acc[ai][bj][m][0], v1 = acc[ai][bj][m][1];
                    if (region == 0) {
#pragma unroll
                        for (int j = 0; j < 4; ++j) { v0[j] = silu_f(v0[j]); v1[j] = silu_f(v1[j]); }
                    } else if (region == 1 || region == 2) {
                        f32x4 g0, g1;
#pragma unroll
                        for (int j = 0; j < 4; ++j) {
                            const float l0 = lbv[bj][0][j], l1 = lbv[bj][1][j];
                            const float s0 = fast_sigmoid(v0[j]), s1 = fast_sigmoid(v1[j]);
                            const float f0 = l0 + (1.f - l0) * s0, f1 = l1 + (1.f - l1) * s1;
                            g0[j] = __logf(f0); g1[j] = __logf(f1);
                            v0[j] = (1.f - l0) * (1.f - s0); v1[j] = (1.f - l1) * (1.f - s1);
                        }
                        u32x4 wg; wg.x = pk_bf16(g0[0], g0[1]); wg.y = pk_bf16(g0[2], g0[3]); wg.z = pk_bf16(g1[0], g1[1]); wg.w = pk_bf16(g1[2], g1[3]);
                        *(u32x4*)(rowp + 4096 + bj * 128) = wg;
                    }
                    u32x4 w; w.x = pk_bf16(v0[0], v0[1]); w.y = pk_bf16(v0[2], v0[3]); w.z = pk_bf16(v1[0], v1[1]); w.w = pk_bf16(v1[2], v1[3]);
                    *(u32x4*)(rowp + bj * 128) = w;
                }
            }
    }
};
template <bool SRC16>
struct EpiResidT {
    static constexpr bool PERM = false, AFTER_DRAIN = false;
    const float* src_lat; const float* src_ctx; bf16_t* X; const float* mod; int goff;
    DI void operator()(const f32x4 (&acc)[2][2][4][2], const pg8::Unit& u, int wr, int wc, int fr, int fq) const {
        const int row0 = u.pm * 256 + wr * 64 + fr, col0 = u.pn * 256 + wc * 32 + 4 * fq;
        const int mr = (u.pm < 64) ? (u.pm >> 3) : 8;
        f32x4 gv[2][2];
#pragma unroll
        for (int bj = 0; bj < 2; ++bj)
#pragma unroll
            for (int n = 0; n < 2; ++n) gv[bj][n] = *(const f32x4*)(mod + (size_t)mr * 6144 + goff + col0 + bj * 128 + n * 16);
#pragma unroll
        for (int ai = 0; ai < 2; ++ai)
#pragma unroll
            for (int m = 0; m < 4; ++m) {
                const int row = row0 + ai * 128 + m * 16;
                bf16_t* xp = X + (size_t)row * D + col0;
                if constexpr (SRC16) {
#pragma unroll
                    for (int bj = 0; bj < 2; ++bj)
#pragma unroll
                        for (int n = 0; n < 2; ++n) { const u32x2 t = *(const u32x2*)(xp + bj * 128 + n * 16); const f32x4 s = {bf_lo(t.x), bf_hi(t.x), bf_lo(t.y), bf_hi(t.y)};
                            const f32x4 v = s + gv[bj][n] * acc[ai][bj][m][n]; u32x2 o; o.x = pk_bf16(v[0], v[1]); o.y = pk_bf16(v[2], v[3]); *(u32x2*)(xp + bj * 128 + n * 16) = o; }
                } else {
                    const float* sp = (row < NLAT ? src_lat + (size_t)row * D : src_ctx + (size_t)(row - NLAT) * D) + col0;
#pragma unroll
                    for (int bj = 0; bj < 2; ++bj)
#pragma unroll
                        for (int n = 0; n < 2; ++n) { const f32x4 s = *(const f32x4*)(sp + bj * 128 + n * 16);
                            const f32x4 v = s + gv[bj][n] * acc[ai][bj][m][n]; u32x2 o; o.x = pk_bf16(v[0], v[1]); o.y = pk_bf16(v[2], v[3]); *(u32x2*)(xp + bj * 128 + n * 16) = o; }
                }
            }
    }
};
struct EpiMoe1 {
    static constexpr bool PERM = true, AFTER_DRAIN = false;
    unsigned char* O;
    DI void operator()(const f32x4 (&acc)[2][2][4][2], const pg8::Unit& u, int wr, int wc, int fr, int fq) const {
        const int row0 = u.pm * 256 + wr * 64 + fr, col0 = u.pn * 128 + wc * 32 + 8 * fq;
#pragma unroll
        for (int ai = 0; ai < 2; ++ai)
#pragma unroll
            for (int m = 0; m < 4; ++m) {
                unsigned char* rowp = O + (size_t)(row0 + ai * 128 + m * 16) * FF + col0;
                f32x4 a0 = acc[ai][0][m][0], a1 = acc[ai][0][m][1]; const f32x4 u0 = acc[ai][1][m][0], u1 = acc[ai][1][m][1];
#pragma unroll
                for (int j = 0; j < 4; ++j) { a0[j] = silu_f(a0[j]) * u0[j]; a1[j] = silu_f(a1[j]) * u1[j]; }
                u32x2 w; w.x = pk4_fp8(a0[0], a0[1], a0[2], a0[3]); w.y = pk4_fp8(a1[0], a1[1], a1[2], a1[3]);
                *(u32x2*)rowp = w;
            }
    }
};
struct EpiPlainBf16 {
    static constexpr bool PERM = true, AFTER_DRAIN = false;
    bf16_t* O; int ldc;
    DI void operator()(const f32x4 (&acc)[2][2][4][2], const pg8::Unit& u, int wr, int wc, int fr, int fq) const {
        const int row0 = u.pm * 256 + wr * 64 + fr, col0 = u.pn * 256 + wc * 32 + 8 * fq;
#pragma unroll
        for (int ai = 0; ai < 2; ++ai)
#pragma unroll
            for (int m = 0; m < 4; ++m) {
                bf16_t* rowp = O + (size_t)(row0 + ai * 128 + m * 16) * ldc + col0;
#pragma unroll
                for (int bj = 0; bj < 2; ++bj) {
                    const f32x4 v0 = acc[ai][bj][m][0], v1 = acc[ai][bj][m][1];
                    u32x4 w; w.x = pk_bf16(v0[0], v0[1]); w.y = pk_bf16(v0[2], v0[3]); w.z = pk_bf16(v1[0], v1[1]); w.w = pk_bf16(v1[2], v1[3]);
                    *(u32x4*)(rowp + bj * 128) = w;
                }
            }
    }
};

struct EpiPlainF8 {
    static constexpr bool PERM = true, AFTER_DRAIN = false;
    unsigned char* O; int ldc; float sc;
    DI void operator()(const f32x4 (&acc)[2][2][4][2], const pg8::Unit& u, int wr, int wc, int fr, int fq) const {
        const int row0 = u.pm * 256 + wr * 64 + fr, col0 = u.pn * 256 + wc * 32 + 8 * fq;
#pragma unroll
        for (int ai = 0; ai < 2; ++ai)
#pragma unroll
            for (int m = 0; m < 4; ++m) {
                unsigned char* rowp = O + (size_t)(row0 + ai * 128 + m * 16) * ldc + col0;
#pragma unroll
                for (int bj = 0; bj < 2; ++bj) {
                    const f32x4 v0 = acc[ai][bj][m][0] * sc, v1 = acc[ai][bj][m][1] * sc;
                    u32x2 w; w.x = pk4_fp8(v0[0], v0[1], v0[2], v0[3]); w.y = pk4_fp8(v1[0], v1[1], v1[2], v1[3]);
                    *(u32x2*)(rowp + bj * 128) = w;
                }
            }
    }
};
constexpr float Y_SCALE = 8.0f;

struct CvtTile { const float* src; unsigned char* dst; int ldsrc, rowbytes, col0, kind, n0, k0, f8; float scale; };
constexpr int CT0 = 0, CT1 = CT0 + 96 * 4, CT2 = CT1 + 16 * 8, CT3 = CT2 + 80 * 4, CT4 = CT3 + 16 * 4, CT5 = CT4 + 32 * 88 * 4, CT_END = CT5 + 32 * 16 * 11;
constexpr int GEMV_UNITS = 256;
DI CvtTile cvt_decode(const Args& A, int t) {
    unsigned char* ws = A.ws; CvtTile c;
    if (t < CT1) {
        const int nt = t < 128 ? (t & 31) : 32 + ((t - 128) & 63), kt = t < 128 ? (t >> 5) : ((t - 128) >> 6), n0 = nt * 64;
        c.src = A.in[I_RWIN]; c.ldsrc = 6144; c.col0 = n0; c.kind = n0 < 2048 ? 1 : 0; c.scale = (n0 >= 1024 && n0 < 2048) ? 0.0625f : 1.0f; c.dst = ws + WS_WRI; c.rowbytes = 2048; c.n0 = n0; c.k0 = kt * 256; c.f8 = 0;
    } else if (t < CT2) {
        const int q = t - CT1, nt = q % 16, kt = q / 16;
        c.src = A.in[I_RWOUT]; c.ldsrc = 1024; c.col0 = nt * 64; c.kind = 0; c.scale = 64.0f; c.dst = ws + WS_WRO; c.rowbytes = 2048; c.n0 = nt * 64; c.k0 = kt * 256; c.f8 = 1;
    } else if (t < CT3) {
        const int q = t - CT2, nt = q % 80, kt = q / 80;
        c.src = A.in[I_HWIN]; c.ldsrc = 5120; c.col0 = nt * 64; c.kind = 0; c.scale = 1.0f; c.dst = ws + WS_WHI; c.rowbytes = 2048; c.n0 = nt * 64; c.k0 = kt * 256; c.f8 = 0;
    } else if (t < CT4) {
        const int q = t - CT3, nt = q % 16, kt = q / 16;
        c.src = A.in[I_HWOUT]; c.ldsrc = 1024; c.col0 = nt * 64; c.kind = 0; c.scale = 1.0f; c.dst = ws + WS_WHO; c.rowbytes = 2048; c.n0 = nt * 64; c.k0 = kt * 256; c.f8 = 0;
    } else if (t < CT5) {
        const int q = t - CT4, le = q / 352, r = q % 352, nt = r % 88, kt = r / 88, n0 = nt * 64;
        const int tt = n0 >> 8, j0 = n0 & 255;
        c.src = ((j0 < 128) ? A.in[I_WG] : A.in[I_WU]) + (size_t)le * 1024 * FF; c.ldsrc = FF; c.col0 = tt * 128 + (j0 & 127); c.kind = 0; c.scale = 64.0f;
        c.dst = ws + WS_WM1 + (size_t)le * N1 * 1024; c.rowbytes = 1024; c.n0 = n0; c.k0 = kt * 256; c.f8 = 1;
    } else {
        const int q = t - CT5, le = q / 176, r = q % 176, nt = r % 16, kt = r / 16;
        c.src = A.in[I_WD] + (size_t)le * FF * 1024; c.ldsrc = 1024; c.col0 = nt * 64; c.kind = 0; c.scale = 64.0f; c.dst = ws + WS_WM2 + (size_t)le * 1024 * FF; c.rowbytes = FF; c.n0 = nt * 64; c.k0 = kt * 256; c.f8 = 1;
    }
    return c;
}
#define CVT_LOAD(c, rr) do { int col_ = (c).col0 + lane; if ((c).kind == 1) { const int np = (c).n0 + lane, p = np & 255, hh = p >> 7, i = (p & 127) >> 1, wh = p & 1; col_ = (np - p) + hh * 128 + wh * 64 + i; } \
        const float* sp_ = (c).src + (size_t)(c).k0 * (c).ldsrc + col_; \
        if ((c).f8) { _Pragma("unroll") for (int it = 0; it < 8; ++it) _Pragma("unroll") for (int q = 0; q < 4; ++q) rr[4 * it + q] = __builtin_nontemporal_load(sp_ + (size_t)(32 * it + 4 * w + q) * (c).ldsrc); } \
        else { _Pragma("unroll") for (int it = 0; it < 16; ++it) { const int k = 16 * it + 2 * w; rr[2 * it] = __builtin_nontemporal_load(sp_ + (size_t)k * (c).ldsrc); rr[2 * it + 1] = __builtin_nontemporal_load(sp_ + (size_t)(k + 1) * (c).ldsrc); } } } while (0)

constexpr int WM2L0 = CT5, WM1L1 = CT4 + 5632, WM2L1 = CT5 + 2816;
constexpr int T2_B = WM2L0,  T2_N = 320;
constexpr int T5_B = T2_B + T2_N, T5_N = 2016;
constexpr int T8_B = T5_B + T5_N, T8_N = 480;
constexpr int T9_B = WM1L1, T9_N = 1920;
constexpr int T11_B = T9_B + T9_N, T11_N = 768;
constexpr int T12A_B = T11_B + T11_N, T12A_N = 384 + 896;
constexpr int T12B_B = WM2L1, T12B_N = CT_END - WM2L1;
constexpr int T7_N = 640, T7_B = WM1L1 - T7_N;
constexpr int T16_B = T12A_B + T12A_N, T16_N = 768;
constexpr int T2X_N = 384, T2X_B = T7_B - T2X_N;
constexpr int I2_B = CT1, I2_N = T2X_B - CT1;
constexpr int I8_B = T16_B + T16_N, I8_N = CT5 - I8_B;
constexpr int PRO_N0 = CT1, PRO_B1 = CT5, PRO_N1 = 0, PRO_B2 = T8_B + T8_N, PRO_N2 = WM2L1 - PRO_B2;
static_assert(T8_B + T8_N <= WM2L1 && T12A_B + T12A_N <= CT5 && PRO_N1 >= 0 && PRO_N2 >= 0, "conversion schedule");
DI int cvt_map(int mode, int base, int v) {
    if (mode == 0) return base + v;
    return v < PRO_N0 ? v : (v < PRO_N0 + PRO_N1 ? PRO_B1 + (v - PRO_N0) : PRO_B2 + (v - PRO_N0 - PRO_N1));
}
#define CVT_STEP(rr, cur, vload)  do { \
        if ((cur).f8) { _Pragma("unroll") for (int it = 0; it < 8; ++it) L[lane * 129 + 8 * it + w] = pk4_fp8(rr[4 * it] * (cur).scale, rr[4 * it + 1] * (cur).scale, rr[4 * it + 2] * (cur).scale, rr[4 * it + 3] * (cur).scale); } \
        else { _Pragma("unroll") for (int it = 0; it < 16; ++it) L[lane * 129 + 8 * it + w] = pk_bf16(rr[2 * it] * (cur).scale, rr[2 * it + 1] * (cur).scale); } \
        __syncthreads(); \
        const CvtTile old_ = (cur); \
        (cur) = cvt_decode(A, cvt_map(mode, base, (vload) < count ? (vload) : 0)); \
        if ((vload) < count) CVT_LOAD((cur), rr); \
        if (old_.f8) { _Pragma("unroll") for (int j = 0; j < 2; ++j) { const int id = tid + 512 * j, row = id >> 4, ch = id & 15; \
                u32x4 vv; vv.x = L[row * 129 + 4 * ch]; vv.y = L[row * 129 + 4 * ch + 1]; vv.z = L[row * 129 + 4 * ch + 2]; vv.w = L[row * 129 + 4 * ch + 3]; \
                __builtin_nontemporal_store(vv, (u32x4*)(old_.dst + (size_t)(old_.n0 + row) * old_.rowbytes + old_.k0 + 16 * ch)); } } \
        else { _Pragma("unroll") for (int j = 0; j < 4; ++j) { const int id = tid + 512 * j, row = id >> 5, ch = id & 31; \
                u32x4 vv; vv.x = L[row * 129 + 4 * ch]; vv.y = L[row * 129 + 4 * ch + 1]; vv.z = L[row * 129 + 4 * ch + 2]; vv.w = L[row * 129 + 4 * ch + 3]; \
                __builtin_nontemporal_store(vv, (u32x4*)(old_.dst + (size_t)(old_.n0 + row) * old_.rowbytes + 2 * old_.k0 + 16 * ch)); } } \
        __syncthreads(); } while (0)
DI void convert_range(const Args& A, LAS unsigned char* lds, int mode, int base, int count, int first, int stride) {
    const int tid = threadIdx.x, lane = tid & 63, w = tid >> 6;
    LAS unsigned* L = (LAS unsigned*)lds;
    float ra[32], rb[32];
    int v = first;
    CvtTile ca = cvt_decode(A, cvt_map(mode, base, v < count ? v : 0));
    CvtTile cb = cvt_decode(A, cvt_map(mode, base, v + stride < count ? v + stride : 0));
    if (v < count) CVT_LOAD(ca, ra);
    if (v + stride < count) CVT_LOAD(cb, rb);
    while (v < count) {
        CVT_STEP(ra, ca, v + 2 * stride);
        if (v + stride < count) CVT_STEP(rb, cb, v + 3 * stride);
        v += 2 * stride;
    }
}
#undef CVT_STEP
#define CVTF_LOAD(c, rr) do { const float* sp_ = (c).src + (size_t)(c).k0 * (c).ldsrc + (c).col0 + 4 * l16; \
        if ((c).f8) { _Pragma("unroll") for (int it = 0; it < 2; ++it) _Pragma("unroll") for (int q = 0; q < 4; ++q) rr[4 * it + q] = __builtin_nontemporal_load((const f32x4*)(sp_ + (size_t)(128 * it + 4 * kq + q) * (c).ldsrc)); } \
        else { _Pragma("unroll") for (int it = 0; it < 4; ++it) _Pragma("unroll") for (int q = 0; q < 2; ++q) rr[2 * it + q] = __builtin_nontemporal_load((const f32x4*)(sp_ + (size_t)(64 * it + 2 * kq + q) * (c).ldsrc)); } } while (0)
#define CVTF_STEP(rr, cur, vload)  do { const float sc_ = (cur).scale; \
        if ((cur).f8) { _Pragma("unroll") for (int it = 0; it < 2; ++it) _Pragma("unroll") for (int j = 0; j < 4; ++j) \
                L[(4 * l16 + j) * 129 + 32 * it + kq] = pk4_fp8(rr[4 * it][j] * sc_, rr[4 * it + 1][j] * sc_, rr[4 * it + 2][j] * sc_, rr[4 * it + 3][j] * sc_); } \
        else { _Pragma("unroll") for (int it = 0; it < 4; ++it) _Pragma("unroll") for (int j = 0; j < 4; ++j) L[(4 * l16 + j) * 129 + 32 * it + kq] = pk_bf16(rr[2 * it][j] * sc_, rr[2 * it + 1][j] * sc_); } \
        __syncthreads(); \
        const CvtTile old_ = (cur); \
        (cur) = cvt_decode(A, base + ((vload) < count ? (vload) : 0)); \
        if ((vload) < count) CVTF_LOAD((cur), rr); \
        if (old_.f8) { _Pragma("unroll") for (int j = 0; j < 2; ++j) { const int id = tid + 512 * j, row = id >> 4, ch = id & 15; \
                u32x4 vv; vv.x = L[row * 129 + 4 * ch]; vv.y = L[row * 129 + 4 * ch + 1]; vv.z = L[row * 129 + 4 * ch + 2]; vv.w = L[row * 129 + 4 * ch + 3]; \
                __builtin_nontemporal_store(vv, (u32x4*)(old_.dst + (size_t)(old_.n0 + row) * old_.rowbytes + old_.k0 + 16 * ch)); } } \
        else { _Pragma("unroll") for (int j = 0; j < 4; ++j) { const int id = tid + 512 * j, row = id >> 5, ch = id & 31; \
                u32x4 vv; vv.x = L[row * 129 + 4 * ch]; vv.y = L[row * 129 + 4 * ch + 1]; vv.z = L[row * 129 + 4 * ch + 2]; vv.w = L[row * 129 + 4 * ch + 3]; \
                __builtin_nontemporal_store(vv, (u32x4*)(old_.dst + (size_t)(old_.n0 + row) * old_.rowbytes + 2 * old_.k0 + 16 * ch)); } } \
        __syncthreads(); } while (0)
DI void convert_range_fast(const Args& A, LAS unsigned char* lds, int base, int count, int first, int stride) {
    const int tid = threadIdx.x, l16 = tid & 15, kq = tid >> 4;
    LAS unsigned* L = (LAS unsigned*)lds;
    f32x4 ra[8], rb[8];
    int v = first;
    CvtTile ca = cvt_decode(A, base + (v < count ? v : 0));
    CvtTile cb = cvt_decode(A, base + (v + stride < count ? v + stride : 0));
    if (v < count) CVTF_LOAD(ca, ra);
    if (v + stride < count) CVTF_LOAD(cb, rb);
    while (v < count) {
        CVTF_STEP(ra, ca, v + 2 * stride);
        if (v + stride < count) CVTF_STEP(rb, cb, v + 3 * stride);
        v += 2 * stride;
    }
}
#undef CVTF_STEP
#undef CVTF_LOAD
DI void tail_convert(const Args& A, LAS unsigned char* lds, int nwg, int base, int count) {
    const int G = (int)gridDim.x, c = (int)blockIdx.x, rem = nwg % G;
    __syncthreads();
    if (rem == 0) convert_range_fast(A, lds, base, count, c, G);
    else if (c >= rem) convert_range_fast(A, lds, base, count, c - rem, G - rem);
}
#undef CVT_LOAD

DI void p0_prologue(const Args& A, LAS unsigned char* lds) {
    const int tid = threadIdx.x, lane = tid & 63, w = tid >> 6, G = gridDim.x;
    unsigned char* ws = A.ws;
    bool have_s = false;
    LAS float* S = (LAS float*)lds;
    LAS float* RED = (LAS float*)(lds + 9 * 1024 * 4);
    for (int u = blockIdx.x; u < GEMV_UNITS; u += G) {
        if (!have_s) {
            for (int i = tid; i < 9 * 1024; i += NTHREADS) { const int r = i >> 10, k = i & 1023; const float c = (r < 8) ? A.in[I_C][r * 1024 + k] : A.in[I_CCTX][k]; S[i] = silu_f(c); }
            have_s = true;
        }
        __syncthreads();
        const int l = u >> 7, n0 = (u & 127) * 48, cl = lane < 48 ? lane : 47;
        const float* W = A.in[I_WADA] + (size_t)l * 1024 * 6144 + n0 + cl;
        float acc[9];
#pragma unroll
        for (int r = 0; r < 9; ++r) acc[r] = 0.f;
        for (int k0 = 128 * w; k0 < 128 * w + 128; k0 += 16) {
            float wv[16];
#pragma unroll
            for (int q = 0; q < 16; ++q) wv[q] = __builtin_nontemporal_load(W + (size_t)(k0 + q) * 6144);
#pragma unroll
            for (int q4 = 0; q4 < 4; ++q4)
#pragma unroll
                for (int r = 0; r < 9; ++r) { const f32x4 s = *(const LAS f32x4*)(S + r * 1024 + k0 + 4 * q4); acc[r] += s[0] * wv[4 * q4] + s[1] * wv[4 * q4 + 1] + s[2] * wv[4 * q4 + 2] + s[3] * wv[4 * q4 + 3]; }
        }
#pragma unroll
        for (int r = 0; r < 9; ++r) RED[(w * 9 + r) * 64 + lane] = acc[r];
        __syncthreads();
        for (int i = tid; i < 9 * 64; i += NTHREADS) {
            const int r = i >> 6, c = i & 63;
            if (c < 48) {
                float s = 0.f;
#pragma unroll
                for (int ww = 0; ww < 8; ++ww) s += RED[(ww * 9 + r) * 64 + c];
                ((float*)(ws + WS_MOD))[(size_t)(l * 9 + r) * 6144 + n0 + c] = s + A.in[I_BADA][l * 6144 + n0 + c];
            }
        }
        __syncthreads();
    }
    if (blockIdx.x == (unsigned)(G - 1)) {
        f32x2* R = (f32x2*)(ws + WS_ROPE);
        for (int i = tid; i < (32 + 64) * 64; i += NTHREADS) {
            const int pos = (i < 2048) ? (i >> 6) : ((i - 2048) >> 6), f = i & 63;
            const float inv = exp2f(-(float)f * (13.287712379549449f / 64.0f));
            float s, c; sincosf((float)pos * inv, &s, &c); R[i] = (f32x2){c, s};
        }
    }
    if (blockIdx.x == (unsigned)(G - 2 >= 0 ? G - 2 : 0)) {
        float* LB = (float*)(ws + WS_LB);
        for (int i = tid; i < 2048; i += NTHREADS) { const float h0 = A.in[I_HLB][i], h1 = A.in[I_HLB][2048 + i]; LB[i] = 1.0f / (1.0f + __expf(h0 - h1)); }
    }
    __syncthreads();
    const int Gh = (G + 1) >> 1, c = (int)blockIdx.x;
    if (c < Gh) convert_range(A, lds, 0, 0, 128, c, Gh);
    __syncthreads();
    if (G == 1 || c >= Gh) convert_range_fast(A, lds, 128, 256, G == 1 ? 0 : c - Gh, G == 1 ? 1 : G - Gh);
}

template <int MODE, int NR = 2>
DI void row_phase(const Args& A, LAS unsigned char* lds, int nrows, const float* src_lat, const float* src_ctx, const float* normw, const float* mod, int sh_off, int sc_off,
                  const float* cmod, int mper, const float* wrouter) {
    const int tid = threadIdx.x, lane = tid & 63, w = tid >> 6, G = gridDim.x;
    unsigned char* ws = A.ws;
    bf16_t* XB = (bf16_t*)(ws + WS_X); bf16_t* H = (bf16_t*)(ws + WS_H); float* AFF = (float*)(ws + WS_AFF); const int* SLOT = (const int*)(ws + WS_SLOT);
    const unsigned char* Y = ws + WS_R2 + R2_HALF;
    LAS float* WR = (LAS float*)lds;
    if (MODE & 2) {
        for (int i = tid; i < 1024 * 4; i += NTHREADS) { const int k = i >> 2, e4 = i & 3; *(LAS f32x4*)(WR + 4 * (((((k >> 8) * 4 + (k & 3)) * 4 + e4) * 64) + ((k >> 2) & 63))) = *(const f32x4*)(wrouter + 4 * i); }
        __syncthreads();
    }
    f32x4 nw[4];
#pragma unroll
    for (int j = 0; j < 4; ++j) nw[j] = *(const f32x4*)(normw + 256 * j + 4 * lane);
    for (int r0 = (blockIdx.x * 8 + w) * NR; r0 < nrows; r0 += G * 8 * NR) {
        f32x4 x[NR][4]; int sv[NR]; float av[NR];
#pragma unroll
        for (int r = 0; r < NR; ++r) {
            const int row = r0 + r;
            if (MODE == 0) {
                const float* sp = (row < NLAT) ? src_lat + (size_t)row * D : src_ctx + (size_t)(row - NLAT) * D;
#pragma unroll
                for (int j = 0; j < 4; ++j) x[r][j] = *(const f32x4*)(sp + 256 * j + 4 * lane);
            } else {
                const bf16_t* sp = XB + (size_t)row * D;
#pragma unroll
                for (int j = 0; j < 4; ++j) { const u32x2 t = *(const u32x2*)(sp + 256 * j + 4 * lane); x[r][j] = (f32x4){bf_lo(t.x), bf_hi(t.x), bf_lo(t.y), bf_hi(t.y)}; }
            }
            if (MODE & 1) { sv[r] = SLOT[(size_t)row * 16 + (lane & 15)]; av[r] = AFF[(size_t)row * 16 + (lane & 15)]; }
        }
#pragma unroll
        for (int r = 0; r < NR; ++r) {
            const int row = r0 + r;
            const int mr = mod_row(row);
            if (MODE & 1) {
                f32x4 acc[4];
#pragma unroll
                for (int j = 0; j < 4; ++j) acc[j] = (f32x4){0.f, 0.f, 0.f, 0.f};
                const int base = (row < NLAT) ? ((row >> 11) * 256) : (2048 + ((row - NLAT) >> 8) * 32);
                unsigned m = (unsigned)__builtin_amdgcn_readfirstlane((int)(__ballot(sv[r] >= 0) & 0xffffull));
                while (m) {
                    float gts[4]; const unsigned char* yps[4];
#pragma unroll
                    for (int q = 0; q < 4; ++q) {
                        if (m) { const int e = __builtin_ctz(m); m &= m - 1u; const int slot = __builtin_amdgcn_readlane(sv[r], e); gts[q] = (1.0f / Y_SCALE) * __int_as_float(__builtin_amdgcn_readlane(__float_as_int(av[r]), e)); yps[q] = Y + ((size_t)e * mper + base + slot) * D; }
                        else { gts[q] = 0.f; yps[q] = Y; }
                    }
                    unsigned yv[4][4];
#pragma unroll
                    for (int q = 0; q < 4; ++q)
#pragma unroll
                        for (int j = 0; j < 4; ++j) yv[q][j] = __builtin_nontemporal_load((const unsigned*)(yps[q] + 256 * j + 4 * lane));
#pragma unroll
                    for (int q = 0; q < 4; ++q)
#pragma unroll
                        for (int j = 0; j < 4; ++j) { const f32x2 lo = __builtin_amdgcn_cvt_pk_f32_fp8((int)yv[q][j], false), hi = __builtin_amdgcn_cvt_pk_f32_fp8((int)yv[q][j], true);
                            acc[j][0] += gts[q] * lo[0]; acc[j][1] += gts[q] * lo[1]; acc[j][2] += gts[q] * hi[0]; acc[j][3] += gts[q] * hi[1]; }
                }
#pragma unroll
                for (int j = 0; j < 4; ++j) { const f32x4 g = *(const f32x4*)(cmod + (size_t)mr * 6144 + 5 * 1024 + 256 * j + 4 * lane); x[r][j] += g * acc[j]; }
                if (!(MODE & 4)) {
#pragma unroll
                    for (int j = 0; j < 4; ++j) { u32x2 o; o.x = pk_bf16(x[r][j][0], x[r][j][1]); o.y = pk_bf16(x[r][j][2], x[r][j][3]); *(u32x2*)(XB + (size_t)row * D + 256 * j + 4 * lane) = o; }
                }
            }
            float ss = 0.f;
#pragma unroll
            for (int j = 0; j < 4; ++j) ss += x[r][j][0] * x[r][j][0] + x[r][j][1] * x[r][j][1] + x[r][j][2] * x[r][j][2] + x[r][j][3] * x[r][j][3];
            ss = wave_sum(ss);
            const float rs = rsqrtf(ss * (1.0f / 1024.0f) + EPS);
            if (MODE & 4) {
#pragma unroll
                for (int j = 0; j < 4; ++j) __builtin_nontemporal_store(x[r][j] * rs * nw[j], (f32x4*)(A.out + (size_t)row * D + 256 * j + 4 * lane));
            } else {
                f32x4 h[4];
#pragma unroll
                for (int j = 0; j < 4; ++j) {
                    const f32x4 sh = *(const f32x4*)(mod + (size_t)mr * 6144 + sh_off + 256 * j + 4 * lane), sc = *(const f32x4*)(mod + (size_t)mr * 6144 + sc_off + 256 * j + 4 * lane);
                    h[j] = (x[r][j] * rs * nw[j]) * (1.0f + sc) + sh;
                    if (MODE & 2) { *(unsigned*)((unsigned char*)H + (size_t)row * D + 256 * j + 4 * lane) = pk4_fp8(h[j][0], h[j][1], h[j][2], h[j][3]); }
                    else { u32x2 o; o.x = pk_bf16(h[j][0], h[j][1]); o.y = pk_bf16(h[j][2], h[j][3]); *(u32x2*)(H + (size_t)row * D + 256 * j + 4 * lane) = o; }
                }
                if (MODE & 2) {
                    float lg[16];
#pragma unroll
                    for (int e = 0; e < 16; ++e) lg[e] = 0.f;
#pragma unroll
                    for (int j = 0; j < 4; ++j)
#pragma unroll
                        for (int q = 0; q < 4; ++q) {
                            const float hv = h[j][q];
#pragma unroll
                            for (int e4 = 0; e4 < 4; ++e4) { const f32x4 wv = *(const LAS f32x4*)(WR + 4 * ((((j * 4 + q) * 4 + e4) * 64) + lane)); lg[4 * e4] += hv * wv[0]; lg[4 * e4 + 1] += hv * wv[1]; lg[4 * e4 + 2] += hv * wv[2]; lg[4 * e4 + 3] += hv * wv[3]; }
                            asm volatile("" ::: "memory");
                        }
                    const bool b5 = lane & 32, b4 = lane & 16, b3 = lane & 8, b2 = lane & 4;
                    float l8[8], l4[4], l2[2];
#pragma unroll
                    for (int e = 0; e < 8; ++e) { const float snd = b5 ? lg[e] : lg[e + 8], kp = b5 ? lg[e + 8] : lg[e]; l8[e] = kp + __shfl_xor(snd, 32); }
#pragma unroll
                    for (int e = 0; e < 4; ++e) { const float snd = b4 ? l8[e] : l8[e + 4], kp = b4 ? l8[e + 4] : l8[e]; l4[e] = kp + __shfl_xor(snd, 16); }
#pragma unroll
                    for (int e = 0; e < 2; ++e) { const float snd = b3 ? l4[e] : l4[e + 2], kp = b3 ? l4[e + 2] : l4[e]; l2[e] = kp + __shfl_xor(snd, 8); }
                    float l1; { const float snd = b2 ? l2[0] : l2[1], kp = b2 ? l2[1] : l2[0]; l1 = kp + __shfl_xor(snd, 4); }
                    l1 += __shfl_xor(l1, 2); l1 += __shfl_xor(l1, 1);
                    float mx = l1;
                    mx = fmaxf(mx, __shfl_xor(mx, 4)); mx = fmaxf(mx, __shfl_xor(mx, 8)); mx = fmaxf(mx, __shfl_xor(mx, 16)); mx = fmaxf(mx, __shfl_xor(mx, 32));
                    const float ex = __expf(l1 - mx);
                    float sm = ex;
                    sm += __shfl_xor(sm, 4); sm += __shfl_xor(sm, 8); sm += __shfl_xor(sm, 16); sm += __shfl_xor(sm, 32);
                    if ((lane & 3) == 0) AFF[(size_t)row * 16 + ((lane >> 5) & 1) * 8 + ((lane >> 4) & 1) * 4 + ((lane >> 3) & 1) * 2 + ((lane >> 2) & 1)] = ex / sm;
                }
            }
        }
    }
    if (MODE & 2) __syncthreads();
}

DI void topk_phase(const Args& A, LAS unsigned char* lds, int nprob, int mper) {
    const int tid = threadIdx.x, lane = tid & 63, w = tid >> 6, G = gridDim.x;
    unsigned char* ws = A.ws;
    const float* AFF = (const float*)(ws + WS_AFF); int* SLOT = (int*)(ws + WS_SLOT); const bf16_t* H = (const bf16_t*)(ws + WS_H); unsigned char* XE = ws + WS_R2;
    LAS int* SEL = (LAS int*)lds;
    LAS unsigned* PART = (LAS unsigned*)(lds + 1024);
    LAS unsigned* WT = (LAS unsigned*)(lds + 1024 + 256);
    for (int p = blockIdx.x; p < nprob; p += G) {
        const bool lat = p < 128; const int pc = lat ? p : p - 128, b = pc >> 4, e = 2 * (pc & 7) + ((pc >> 3) & 1);
        const int N = lat ? 2048 : 256, cap = lat ? 256 : 32, row0 = lat ? b * 2048 : NLAT + b * 256, base = lat ? b * 256 : 2048 + b * 32;
        unsigned key[4]; bool valid[4];
#pragma unroll
        for (int j = 0; j < 4; ++j) { const int t = 4 * tid + j; valid[j] = t < N; key[j] = valid[j] ? __float_as_uint(AFF[(size_t)(row0 + t) * 16 + e]) : 0u; }
        unsigned T = 0u;
        for (int rnd = 0; rnd < 16; ++rnd) {
            const int sh = 28 - 2 * rnd;
            unsigned c1 = 0, c2 = 0, c3 = 0; unsigned k1, k2, k3;
            if (rnd == 0) { k1 = 1u << 30; k2 = k1; k3 = k1; } else { const int s2 = 30 - 2 * rnd; k1 = T | (1u << s2); k2 = T | (2u << s2); k3 = T | (3u << s2); }
#pragma unroll
            for (int j = 0; j < 4; ++j) { c1 += (unsigned)__popcll(__ballot(valid[j] && key[j] >= k1)); c2 += (unsigned)__popcll(__ballot(valid[j] && key[j] >= k2)); c3 += (unsigned)__popcll(__ballot(valid[j] && key[j] >= k3)); }
            if (lane == 0) { PART[((rnd & 1) * 8 + w) * 4] = c1; PART[((rnd & 1) * 8 + w) * 4 + 1] = c2; PART[((rnd & 1) * 8 + w) * 4 + 2] = c3; }
            __syncthreads();
            unsigned t1 = 0, t2 = 0, t3 = 0;
#pragma unroll
            for (int ww = 0; ww < 8; ++ww) { t1 += PART[((rnd & 1) * 8 + ww) * 4]; t2 += PART[((rnd & 1) * 8 + ww) * 4 + 1]; t3 += PART[((rnd & 1) * 8 + ww) * 4 + 2]; }
            if (rnd == 0) { if (t1 >= (unsigned)cap) T = k1; }
            else T = (t3 >= (unsigned)cap) ? k3 : ((t2 >= (unsigned)cap) ? k2 : ((t1 >= (unsigned)cap) ? k1 : T));
            (void)sh;
        }
        unsigned mine = 0;
#pragma unroll
        for (int j = 0; j < 4; ++j) mine += (valid[j] && key[j] == T ? 1u : 0u) + (valid[j] && key[j] > T ? 0x10000u : 0u);
        unsigned inc = mine;
#pragma unroll
        for (int o = 1; o < 64; o <<= 1) { const unsigned x = __shfl_up(inc, o); inc += (lane >= o) ? x : 0u; }
        __syncthreads();
        if (lane == 63) WT[w] = inc;
        __syncthreads();
        unsigned pre = inc - mine, total = 0;
#pragma unroll
        for (int ww = 0; ww < 8; ++ww) { const unsigned x = WT[ww]; pre += (ww < w) ? x : 0u; total += x; }
        const int n_gt = (int)(total >> 16), need_eq = cap - n_gt;
        int eq_before = (int)(pre & 0xffffu), gt_before = (int)(pre >> 16);
#pragma unroll
        for (int j = 0; j < 4; ++j) if (valid[j]) {
            const bool isgt = key[j] > T, iseq = key[j] == T;
            const bool sel = isgt || (iseq && eq_before < need_eq);
            const int slot = gt_before + (eq_before < need_eq ? eq_before : need_eq);
            const int row = row0 + 4 * tid + j;
            SLOT[(size_t)row * 16 + e] = sel ? slot : -1;
            if (sel) SEL[slot] = row;
            eq_before += iseq ? 1 : 0; gt_before += isgt ? 1 : 0;
        }
        __syncthreads();
        for (int s0 = 0; s0 < cap; s0 += 256) {
            u32x4 v[32];
#pragma unroll
            for (int r = 0; r < 32; ++r) { const int sl = s0 + 8 * r + w; v[r] = *(const u32x4*)((const unsigned char*)H + (size_t)SEL[sl < cap ? sl : 0] * D + 16 * lane); }
#pragma unroll
            for (int r = 0; r < 32; ++r) { const int sl = s0 + 8 * r + w; if (sl < cap) *(u32x4*)(XE + ((size_t)e * mper + base + sl) * D + 16 * lane) = v[r]; }
        }
        __syncthreads();
    }
}

template <bool RET>
DI void readout_phase(const Args& A, int nrows) {
    const int tid = threadIdx.x, lane = tid & 63, w = tid >> 6, G = gridDim.x;
    unsigned char* ws = A.ws;
    constexpr int HD = RET ? 2048 : 1024, PITCH = RET ? RET_IN : HG_PITCH, NJ = HD / 512;
    const bf16_t* OF = (const bf16_t*)(ws + WS_R2); const bf16_t* OB = (const bf16_t*)(ws + WS_R2 + R2_HALF);
    const bf16_t* P = (const bf16_t*)(ws + WS_R1); bf16_t* A2 = (bf16_t*)(ws + WS_A2);
    for (int row = blockIdx.x * 8 + w; row < nrows; row += G * 8) {
#pragma unroll
        for (int j = 0; j < NJ; ++j) {
            const int col = 512 * j + 8 * lane;
            const u32x4 a = __builtin_nontemporal_load((const u32x4*)(OF + (size_t)row * HD + col)), b = __builtin_nontemporal_load((const u32x4*)(OB + (size_t)row * HD + col)), g = __builtin_nontemporal_load((const u32x4*)(P + (size_t)row * PITCH + 4096 + col));
            float o[8];
            o[0] = bf_lo(a.x) + bf_lo(b.x); o[1] = bf_hi(a.x) + bf_hi(b.x); o[2] = bf_lo(a.y) + bf_lo(b.y); o[3] = bf_hi(a.y) + bf_hi(b.y);
            o[4] = bf_lo(a.z) + bf_lo(b.z); o[5] = bf_hi(a.z) + bf_hi(b.z); o[6] = bf_lo(a.w) + bf_lo(b.w); o[7] = bf_hi(a.w) + bf_hi(b.w);
            float ss = 0.f;
#pragma unroll
            for (int q = 0; q < 8; ++q) ss += o[q] * o[q];
            float rs;
            if (RET) { ss = wave_sum(ss); rs = rsqrtf(ss * (1.0f / 512.0f) + EPS); }
            else { ss += __shfl_xor(ss, 1); ss += __shfl_xor(ss, 2); ss += __shfl_xor(ss, 4); ss += __shfl_xor(ss, 8); rs = rsqrtf(ss * (1.0f / 128.0f) + EPS); }
            float gn[8];
            if (RET) {
#pragma unroll
                for (int q = 0; q < 8; ++q) gn[q] = 1.0f;
            } else {
                const f32x4 g0 = *(const f32x4*)(A.in[I_HGN] + (col & 127)), g1 = *(const f32x4*)(A.in[I_HGN] + (col & 127) + 4);
                gn[0] = g0[0]; gn[1] = g0[1]; gn[2] = g0[2]; gn[3] = g0[3]; gn[4] = g1[0]; gn[5] = g1[1]; gn[6] = g1[2]; gn[7] = g1[3];
            }
            const float gt[8] = {bf_lo(g.x), bf_hi(g.x), bf_lo(g.y), bf_hi(g.y), bf_lo(g.z), bf_hi(g.z), bf_lo(g.w), bf_hi(g.w)};
            float r[8];
#pragma unroll
            for (int q = 0; q < 8; ++q) r[q] = silu_f(gt[q]) * (o[q] * rs * gn[q]);
            if (RET) { u32x2 wv; wv.x = pk4_fp8(r[0], r[1], r[2], r[3]); wv.y = pk4_fp8(r[4], r[5], r[6], r[7]); *(u32x2*)((unsigned char*)A2 + (size_t)row * HD + col) = wv; }
            else { u32x4 wv; wv.x = pk_bf16(r[0], r[1]); wv.y = pk_bf16(r[2], r[3]); wv.z = pk_bf16(r[4], r[5]); wv.w = pk_bf16(r[6], r[7]);
                   *(u32x4*)(A2 + (size_t)row * HD + col) = wv; }
        }
    }
}

template <bool RET>
DI void scan_naive_phase(const Args& A, LAS unsigned char* lds, bool ctx_out) {
    constexpr int DK = RET ? 256 : 128, DVS = RET ? 64 : 128, NKG = NTHREADS / DVS, PITCH = RET ? RET_IN : HG_PITCH, HD = RET ? 2048 : 1024;
    constexpr int NUNITS = RET ? 8 * 4 * 2 * 8 : 8 * 8 * 2;
    const int tid = threadIdx.x, G = gridDim.x;
    unsigned char* ws = A.ws;
    const bf16_t* P = (const bf16_t*)(ws + WS_R1);
    LAS bf16_t* Lq = (LAS bf16_t*)lds;
    LAS bf16_t* Lk = Lq + 64 * DK;
    LAS bf16_t* Lg = Lk + 64 * DK;
    LAS bf16_t* Lv = Lg + (RET ? 0 : 64 * DK);
    LAS float* Lp = (LAS float*)(Lv + 64 * DVS);
    const int v = tid % DVS, kg = tid / DVS;
    for (int u = blockIdx.x; u < NUNITS; u += G) {
        int b, h, dir, dvs = 0;
        if (RET) { dvs = u & 7; dir = (u >> 3) & 1; h = (u >> 4) & 3; b = u >> 6; } else { dir = u & 1; h = (u >> 1) & 7; b = u >> 4; }
        const int qoff = RET ? h * 256 : h * 128;
        const int koff = RET ? 1024 + h * 256 : 1024 + dir * 1024 + h * 128;
        const int goff = RET ? 0 : 5120 + dir * 1024 + h * 128;
        const int voff = RET ? 2048 + h * 512 + dvs * 64 : 3072 + h * 128;
        const int ooff = RET ? h * 512 + dvs * 64 : h * 128;
        bf16_t* O = (bf16_t*)(ws + WS_R2 + (dir ? R2_HALF : 0));
        float gam = 1.f;
        if (RET) { const float j = (float)(2 * h + dir); gam = 1.0f - exp2f(-5.0f - 0.5f * j); }
        float S[32];
#pragma unroll
        for (int d = 0; d < 32; ++d) S[d] = 0.f;
        for (int st = 0; st < 36; ++st) {
            const bool isctx = st < 4;
            const int c = isctx ? st : st - 4;
            const int len = isctx ? 256 : 2048, rbase = isctx ? NLAT + b * 256 : b * 2048;
            const int tlo = dir ? (len - 64 - 64 * c) : 64 * c;
            for (int id = tid; id < 64 * DK / 8; id += NTHREADS) {
                const int i = id / (DK / 8), ch = id % (DK / 8); const size_t grow = (size_t)(rbase + tlo + (dir ? 63 - i : i)) * PITCH;
                *(LAS u32x4*)(Lq + i * DK + 8 * ch) = *(const u32x4*)(P + grow + qoff + 8 * ch);
                *(LAS u32x4*)(Lk + i * DK + 8 * ch) = *(const u32x4*)(P + grow + koff + 8 * ch);
                if (!RET) *(LAS u32x4*)(Lg + i * DK + 8 * ch) = *(const u32x4*)(P + grow + goff + 8 * ch);
            }
            for (int id = tid; id < 64 * DVS / 8; id += NTHREADS) {
                const int i = id / (DVS / 8), ch = id % (DVS / 8); const size_t grow = (size_t)(rbase + tlo + (dir ? 63 - i : i)) * PITCH;
                *(LAS u32x4*)(Lv + i * DVS + 8 * ch) = *(const u32x4*)(P + grow + voff + 8 * ch);
            }
            __syncthreads();
            const bool wr_out = ctx_out || !isctx;
            for (int i = 0; i < 64; ++i) {
                const float vv = bf2f(Lv[i * DVS + v]);
                float part = 0.f;
#pragma unroll
                for (int d8 = 0; d8 < 4; ++d8) {
                    const u32x4 qq = *(const LAS u32x4*)(Lq + i * DK + kg * 32 + 8 * d8), kk = *(const LAS u32x4*)(Lk + i * DK + kg * 32 + 8 * d8);
                    u32x4 gg = (u32x4){0u, 0u, 0u, 0u};
                    if (!RET) gg = *(const LAS u32x4*)(Lg + i * DK + kg * 32 + 8 * d8);
                    const unsigned qa[4] = {qq.x, qq.y, qq.z, qq.w}, ka[4] = {kk.x, kk.y, kk.z, kk.w}, ga[4] = {gg.x, gg.y, gg.z, gg.w};
#pragma unroll
                    for (int e = 0; e < 4; ++e) {
                        const float d0 = RET ? gam : __expf(bf_lo(ga[e])), d1 = RET ? gam : __expf(bf_hi(ga[e]));
                        float& s0 = S[8 * d8 + 2 * e]; float& s1 = S[8 * d8 + 2 * e + 1];
                        s0 = d0 * s0 + bf_lo(ka[e]) * vv; s1 = d1 * s1 + bf_hi(ka[e]) * vv;
                        part += s0 * bf_lo(qa[e]) + s1 * bf_hi(qa[e]);
                    }
                }
                Lp[((i & 1) * NKG + kg) * DVS + v] = part;
                __syncthreads();
                if (kg == 0 && wr_out) {
                    float o = 0.f;
#pragma unroll
                    for (int g2 = 0; g2 < NKG; ++g2) o += Lp[((i & 1) * NKG + g2) * DVS + v];
                    O[(size_t)(rbase + tlo + (dir ? 63 - i : i)) * HD + ooff + v] = f2bf(o);
                }
            }
            __syncthreads();
        }
    }
}

typedef short s16x8 __attribute__((ext_vector_type(8)));
typedef short s16x4 __attribute__((ext_vector_type(4)));
DI unsigned offb(unsigned row, unsigned ch) { return 256u * row + 16u * (ch ^ (((row & 3u) << 2) | ((row >> 2) & 3u))); }
DI s16x4 trread(LAS unsigned char* p) { return __builtin_amdgcn_ds_read_tr16_b64_v4i16((LAS s16x4*)p); }
DI s16x8 cat8(s16x4 a, s16x4 b) { return __builtin_shufflevector(a, b, 0, 1, 2, 3, 4, 5, 6, 7); }
#define MFMA16(a, b, c) __builtin_amdgcn_mfma_f32_16x16x32_bf16((a), (b), (c), 0, 0, 0)
DI u32x4 scale8(u32x4 v, float f) { u32x4 r; r.x = pk_bf16(bf_lo(v.x) * f, bf_hi(v.x) * f); r.y = pk_bf16(bf_lo(v.y) * f, bf_hi(v.y) * f); r.z = pk_bf16(bf_lo(v.z) * f, bf_hi(v.z) * f); r.w = pk_bf16(bf_lo(v.w) * f, bf_hi(v.w) * f); return r; }
DI void unpack8(u32x4 v, float (&o)[8]) { o[0] = bf_lo(v.x); o[1] = bf_hi(v.x); o[2] = bf_lo(v.y); o[3] = bf_hi(v.y); o[4] = bf_lo(v.z); o[5] = bf_hi(v.z); o[6] = bf_lo(v.w); o[7] = bf_hi(v.w); }
DI u32x4 pack8(const float (&o)[8]) { u32x4 r; r.x = pk_bf16(o[0], o[1]); r.y = pk_bf16(o[2], o[3]); r.z = pk_bf16(o[4], o[5]); r.w = pk_bf16(o[6], o[7]); return r; }

template <bool RET>
DI void scan_mfma_phase(const Args& A, LAS unsigned char* lds, bool ctx_out) {
    constexpr int DK = RET ? 256 : 128, NT = DK / 128, NS = DK / 32, PITCH = RET ? RET_IN : HG_PITCH, HD = RET ? 2048 : 1024;
    constexpr int NUNITS = RET ? 256 : 128;
    constexpr int TQ = 0, TK = TQ + NT * 16384, TV = TK + NT * 16384, TP = TV + 16384, TE = TP + 9216, CS = TE + 512;
    const int tid = threadIdx.x, lane = tid & 63, w = __builtin_amdgcn_readfirstlane(tid >> 6), G = gridDim.x;
    const int l15 = lane & 15, g4 = lane >> 4, tq_ = (lane & 15) >> 2, tp_ = lane & 3;
    const int sc = tid & 15, rg = tid >> 4;
    unsigned char* ws = A.ws;
    const bf16_t* P = (const bf16_t*)(ws + WS_R1);
    for (int u = blockIdx.x; u < NUNITS; u += G) {
        int b, h, dir, dvs = 0;
        if (RET) {
            int uu = u; if ((G & 7) == 0 && G == NUNITS) { const int x = u & 7, y = u >> 3; uu = ((x * (G >> 6) + (y >> 3)) << 3) | (y & 7); }
            dvs = uu & 3; dir = (uu >> 2) & 1; h = (uu >> 3) & 3; b = uu >> 5;
        } else {
            int uu = u; if (G == 2 * NUNITS || G == NUNITS) { const int x = u & 7, y = u >> 3; uu = ((x * (NUNITS >> 4) + (y >> 1)) << 1) | (y & 1); }
            dir = uu & 1; h = (uu >> 1) & 7; b = uu >> 4;
        }
        const int qoff = RET ? h * 256 : h * 128;
        const int koff = RET ? 1024 + h * 256 : 1024 + dir * 1024 + h * 128;
        const int goff = RET ? 0 : 5120 + dir * 1024 + h * 128;
        const int voff = RET ? 2048 + h * 512 + dvs * 128 : 3072 + h * 128;
        const int ooff = RET ? h * 512 + dvs * 128 : h * 128;
        bf16_t* O = (bf16_t*)(ws + WS_R2 + (dir ? R2_HALF : 0));
        float fq0 = 1.f, fq1 = 1.f, fk0 = 1.f, fk1 = 1.f, e64 = 1.f;
        if (RET) {
            const float gam = 1.0f - exp2f(-5.0f - 0.5f * (float)(2 * h + dir)), lg = log2f(gam);
            fq0 = exp2f((float)(2 * rg + 1) * lg); fq1 = exp2f((float)(2 * rg + 2) * lg); fk0 = exp2f(-(float)(2 * rg + 1) * lg); fk1 = exp2f(-(float)(2 * rg + 2) * lg); e64 = exp2f(64.0f * lg);
        }
        f32x4 S[2 * NS];
#pragma unroll
        for (int i = 0; i < 2 * NS; ++i) S[i] = (f32x4){0.f, 0.f, 0.f, 0.f};
        u32x4 rq[NT][2], rk[NT][2], rgv[2], rv[2];
#define SCAN_ROWBASE(st_) (((st_) < 4) ? (NLAT + b * 256 + (dir ? 256 - 64 - 64 * (st_) : 64 * (st_))) : (b * 2048 + (dir ? 2048 - 64 - 64 * ((st_) - 4) : 64 * ((st_) - 4))))
#define SCAN_LOAD(st_) do { const int rb_ = SCAN_ROWBASE(st_); _Pragma("unroll") for (int j = 0; j < 2; ++j) { const int i_ = 2 * rg + j; const bf16_t* gp = P + (size_t)(rb_ + (dir ? 63 - i_ : i_)) * PITCH + 8 * sc; \
            _Pragma("unroll") for (int t = 0; t < NT; ++t) { rq[t][j] = *(const u32x4*)(gp + qoff + 128 * t); rk[t][j] = *(const u32x4*)(gp + koff + 128 * t); } \
            if (!RET) rgv[j] = *(const u32x4*)(gp + goff); rv[j] = *(const u32x4*)(gp + voff); } } while (0)
        SCAN_LOAD(0);
        for (int st = 0; st < 36; ++st) {
            const bool wr_out = ctx_out || st >= 4;
            const int rowbase = SCAN_ROWBASE(st);
            float tsum[8], g0[8], g1[8];
            if (!RET) {
                unpack8(rgv[0], g0); unpack8(rgv[1], g1);
#pragma unroll
                for (int c = 0; c < 8; ++c) {
                    float t = g0[c] + g1[c];
                    float x = __shfl_up(t, 16); t += (lane >= 16) ? x : 0.f;
                    x = __shfl_up(t, 32); t += (lane >= 32) ? x : 0.f;
                    tsum[c] = t;
                }
                if (lane >= 48) {
                    *(LAS f32x4*)(lds + CS + (w * 128 + 8 * sc) * 4) = (f32x4){tsum[0], tsum[1], tsum[2], tsum[3]};
                    *(LAS f32x4*)(lds + CS + (w * 128 + 8 * sc + 4) * 4) = (f32x4){tsum[4], tsum[5], tsum[6], tsum[7]};
                }
            }
            __syncthreads();
            if (RET) {
#pragma unroll
                for (int j = 0; j < 2; ++j) {
                    const int i_ = 2 * rg + j; const float fq = j ? fq1 : fq0, fk = j ? fk1 : fk0;
#pragma unroll
                    for (int t = 0; t < NT; ++t) {
                        *(LAS u32x4*)(lds + TQ + t * 16384 + offb(i_, sc)) = scale8(rq[t][j], fq);
                        *(LAS u32x4*)(lds + TK + t * 16384 + offb(i_, sc)) = scale8(rk[t][j], fk);
                    }
                    *(LAS u32x4*)(lds + TV + offb(i_, sc)) = rv[j];
                }
            } else {
                float off[8];
#pragma unroll
                for (int c = 0; c < 8; ++c) off[c] = 0.f;
                for (int ww = 0; ww < w; ++ww) {
                    const f32x4 a0 = *(const LAS f32x4*)(lds + CS + (ww * 128 + 8 * sc) * 4), a1 = *(const LAS f32x4*)(lds + CS + (ww * 128 + 8 * sc + 4) * 4);
                    off[0] += a0[0]; off[1] += a0[1]; off[2] += a0[2]; off[3] += a0[3]; off[4] += a1[0]; off[5] += a1[1]; off[6] += a1[2]; off[7] += a1[3];
                }
                float q0[8], q1[8], k0[8], k1[8], ee[8];
                unpack8(rq[0][0], q0); unpack8(rq[0][1], q1); unpack8(rk[0][0], k0); unpack8(rk[0][1], k1);
#pragma unroll
                for (int c = 0; c < 8; ++c) {
                    const float b0 = off[c] + tsum[c] - g1[c], b1 = b0 + g1[c];
                    const float e0 = __expf(b0), e1 = __expf(b1);
                    q0[c] *= e0; q1[c] *= e1; k0[c] *= __builtin_amdgcn_rcpf(e0); k1[c] *= __builtin_amdgcn_rcpf(e1); ee[c] = e1;
                }
                *(LAS u32x4*)(lds + TQ + offb(2 * rg, sc)) = pack8(q0); *(LAS u32x4*)(lds + TQ + offb(2 * rg + 1, sc)) = pack8(q1);
                *(LAS u32x4*)(lds + TK + offb(2 * rg, sc)) = pack8(k0); *(LAS u32x4*)(lds + TK + offb(2 * rg + 1, sc)) = pack8(k1);
                *(LAS u32x4*)(lds + TV + offb(2 * rg, sc)) = rv[0]; *(LAS u32x4*)(lds + TV + offb(2 * rg + 1, sc)) = rv[1];
                if (rg == 31) { *(LAS f32x4*)(lds + TE + (8 * sc) * 4) = (f32x4){ee[0], ee[1], ee[2], ee[3]}; *(LAS f32x4*)(lds + TE + (8 * sc + 4) * 4) = (f32x4){ee[4], ee[5], ee[6], ee[7]}; }
            }
            __syncthreads();
            if (st + 1 < 36) SCAN_LOAD(st + 1);
            if (wr_out) {
                const int mi = w >> 1;
#pragma unroll
                for (int nn = 0; nn < 2; ++nn) {
                    const int nj = 2 * (w & 1) + nn;
                    f32x4 pa = (f32x4){0.f, 0.f, 0.f, 0.f};
                    if (nj <= mi) {
#pragma unroll
                        for (int s = 0; s < NS; ++s) {
                            const s16x8 ka = *(const LAS s16x8*)(lds + TK + (s >> 2) * 16384 + offb(l15 + 16 * nj, 4 * (s & 3) + g4));
                            const s16x8 qb = *(const LAS s16x8*)(lds + TQ + (s >> 2) * 16384 + offb(l15 + 16 * mi, 4 * (s & 3) + g4));
                            pa = MFMA16(ka, qb, pa);
                        }
#pragma unroll
                        for (int r = 0; r < 4; ++r) pa[r] = (16 * nj + 4 * g4 + r > 16 * mi + l15) ? 0.f : pa[r];
                    }
                    u32x2 pk; pk.x = pk_bf16(pa[0], pa[1]); pk.y = pk_bf16(pa[2], pa[3]);
                    *(LAS u32x2*)(lds + TP + (16 * mi + l15) * 144 + 2 * (16 * nj + 4 * g4)) = pk;
                }
            }
            __syncthreads();
            s16x8 vf[2];
#pragma unroll
            for (int ks = 0; ks < 2; ++ks) {
                const s16x4 t0 = trread(lds + TV + offb(32 * ks + 8 * g4 + tq_, 2 * w + (tp_ >> 1)) + 8 * (tp_ & 1));
                const s16x4 t1 = trread(lds + TV + offb(32 * ks + 8 * g4 + 4 + tq_, 2 * w + (tp_ >> 1)) + 8 * (tp_ & 1));
                vf[ks] = cat8(t0, t1);
            }
            if (wr_out) {
                f32x4 OT[4];
#pragma unroll
                for (int m = 0; m < 4; ++m) OT[m] = (f32x4){0.f, 0.f, 0.f, 0.f};
#pragma unroll
                for (int s = 0; s < NS; ++s) {
                    u32x4 sp; sp.x = pk_bf16(S[2 * s][0], S[2 * s][1]); sp.y = pk_bf16(S[2 * s][2], S[2 * s][3]); sp.z = pk_bf16(S[2 * s + 1][0], S[2 * s + 1][1]); sp.w = pk_bf16(S[2 * s + 1][2], S[2 * s + 1][3]);
                    const s16x8 sa = __builtin_bit_cast(s16x8, sp);
#pragma unroll
                    for (int m = 0; m < 4; ++m) {
                        const s16x8 qb = *(const LAS s16x8*)(lds + TQ + (s >> 2) * 16384 + offb(l15 + 16 * m, 4 * (s & 3) + g4));
                        OT[m] = MFMA16(sa, qb, OT[m]);
                    }
                }
#pragma unroll
                for (int ks = 0; ks < 2; ++ks)
#pragma unroll
                    for (int m = 0; m < 4; ++m) {
                        if (ks == 0 || m >= 2) {
                            const s16x8 pb = *(const LAS s16x8*)(lds + TP + (16 * m + l15) * 144 + 2 * (32 * ks + 8 * g4));
                            OT[m] = MFMA16(vf[ks], pb, OT[m]);
                        }
                    }
#pragma unroll
                for (int m = 0; m < 4; ++m) {
                    const int i_ = 16 * m + l15;
                    u32x2 o; o.x = pk_bf16(OT[m][0], OT[m][1]); o.y = pk_bf16(OT[m][2], OT[m][3]);
                    *(u32x2*)(O + (size_t)(rowbase + (dir ? 63 - i_ : i_)) * HD + ooff + 16 * w + 4 * g4) = o;
                }
            }
#pragma unroll
            for (int s = 0; s < NS; ++s)
#pragma unroll
                for (int u2 = 0; u2 < 2; ++u2) {
#pragma unroll
                    for (int ks = 0; ks < 2; ++ks) {
                        const s16x4 a0 = trread(lds + TK + (s >> 2) * 16384 + offb(32 * ks + 8 * g4 + tq_, 4 * (s & 3) + tp_) + 8 * u2);
                        const s16x4 a1 = trread(lds + TK + (s >> 2) * 16384 + offb(32 * ks + 8 * g4 + 4 + tq_, 4 * (s & 3) + tp_) + 8 * u2);
                        S[2 * s + u2] = MFMA16(cat8(a0, a1), vf[ks], S[2 * s + u2]);
                    }
                    if (RET) S[2 * s + u2] *= e64;
                    else { const f32x4 ev = *(const LAS f32x4*)(lds + TE + (32 * s + 8 * g4 + 4 * u2) * 4); S[2 * s + u2] *= ev; }
                }
        }
        __syncthreads();
#undef SCAN_ROWBASE
#undef SCAN_LOAD
    }
}

#ifndef PROBE_SCAN
#define PROBE_SCAN 0
#endif
template <bool RET>
DI void scan_v3_phase(const Args& A, LAS unsigned char* lds, bool ctx_out) {
    constexpr int DK = RET ? 256 : 128, NT = DK / 128, NS = DK / 32, PITCH = RET ? RET_IN : HG_PITCH, HD = RET ? 2048 : 1024;
    constexpr int NUNITS = RET ? 256 : 128, C = 32, NSTEP = 2304 / C, NCTX = 256 / C, RN = 4;
    constexpr int TQ = 0, TK = TQ + NT * C * 256, TV = TK + NT * C * 256, TV2 = TV + C * 256, TP = TV2 + (RET ? C * 256 : 0), TE = TP + C * 80, BUF = TE + 512;
    static_assert(2 * BUF <= 131072, "scan LDS");
    const int tid = threadIdx.x, lane = tid & 63, w = __builtin_amdgcn_readfirstlane(tid >> 6), G = gridDim.x;
    const int l15 = lane & 15, g4 = lane >> 4, tq_ = (lane & 15) >> 2, tp_ = lane & 3;
    const bool cons = w < 4;
    const int pw = w & 3, ptid = tid & 255;
    unsigned char* ws = A.ws;
    const bf16_t* P = (const bf16_t*)(ws + WS_R1);
    for (int u = blockIdx.x; u < NUNITS; u += G) {
        int b, h, dir, dvs = 0;
        if (RET) {
            int uu = u; if ((G & 7) == 0 && G == NUNITS) { const int x = u & 7, y = u >> 3; uu = ((x * (G >> 6) + (y >> 3)) << 3) | (y & 7); }
            dvs = uu & 3; dir = (uu >> 2) & 1; h = (uu >> 3) & 3; b = uu >> 5;
        } else {
            int uu = u; if (G == 2 * NUNITS || G == NUNITS) { const int x = u & 7, y = u >> 3; uu = ((x * (NUNITS >> 4) + (y >> 1)) << 1) | (y & 1); }
            dir = uu & 1; h = (uu >> 1) & 7; b = uu >> 4;
        }
        const int qoff = RET ? h * 256 : h * 128;
        const int koff = RET ? 1024 + h * 256 : 1024 + dir * 1024 + h * 128;
        const int goff = RET ? 0 : 5120 + dir * 1024 + h * 128;
        const int voff = RET ? 2048 + h * 512 + dvs * 128 : 3072 + h * 128;
        const int ooff = RET ? h * 512 + dvs * 128 : h * 128;
        bf16_t* O = (bf16_t*)(ws + WS_R2 + (dir ? R2_HALF : 0));
        float lg = 0.f;
        if (RET) lg = log2f(1.0f - exp2f(-5.0f - 0.5f * (float)(2 * h + dir)));
#define V3_ROWBASE(st_) (((st_) < NCTX) ? (NLAT + b * 256 + (dir ? 256 - C - C * (st_) : C * (st_))) : (b * 2048 + (dir ? 2048 - C - C * ((st_) - NCTX) : C * ((st_) - NCTX))))
        if (cons) {
            f32x4 S[2][2 * NS];
#pragma unroll
            for (int n = 0; n < 2; ++n)
#pragma unroll
                for (int i = 0; i < 2 * NS; ++i) S[n][i] = (f32x4){0.f, 0.f, 0.f, 0.f};
            __syncthreads(); __syncthreads();
#pragma unroll (RET ? 1 : 2)
            for (int st = 0; st < NSTEP; ++st) {
                LAS unsigned char* B = lds + (st & 1) * BUF;
                const bool wr_out = ctx_out || st >= NCTX;
                const int mm = st & (RN - 1);
                for (int rep_ = 0; rep_ < (((PROBE_SCAN & 2) && !RET) ? 2 : 1); ++rep_)
                if (wr_out) {
                    const int rowbase = V3_ROWBASE(st);
                    f32x4 OT[2][2];
#pragma unroll
                    for (int n = 0; n < 2; ++n)
#pragma unroll
                        for (int m = 0; m < 2; ++m) OT[n][m] = (f32x4){0.f, 0.f, 0.f, 0.f};
#pragma unroll
                    for (int s = 0; s < NS; ++s) {
                        s16x8 sa[2];
#pragma unroll
                        for (int n = 0; n < 2; ++n) { u32x4 sp; sp.x = pk_bf16(S[n][2 * s][0], S[n][2 * s][1]); sp.y = pk_bf16(S[n][2 * s][2], S[n][2 * s][3]); sp.z = pk_bf16(S[n][2 * s + 1][0], S[n][2 * s + 1][1]); sp.w = pk_bf16(S[n][2 * s + 1][2], S[n][2 * s + 1][3]); sa[n] = __builtin_bit_cast(s16x8, sp); }
#pragma unroll
                        for (int m = 0; m < 2; ++m) {
                            const s16x8 qb = *(const LAS s16x8*)(B + TQ + (s >> 2) * (C * 256) + offb(l15 + 16 * m, 4 * (s & 3) + g4));
#pragma unroll
                            for (int n = 0; n < 2; ++n) OT[n][m] = MFMA16(sa[n], qb, OT[n][m]);
                        }
                    }
                    if (RET) {
#pragma unroll
                        for (int m = 0; m < 2; ++m) { const float fo = exp2f((float)(C * mm + 16 * m + l15 + 1) * lg);
#pragma unroll
                            for (int n = 0; n < 2; ++n) OT[n][m] *= fo; }
                    }
#pragma unroll
                    for (int n = 0; n < 2; ++n) {
                        const int cc = 2 * w + n;
                        const s16x4 t0 = trread(B + TV + offb(8 * g4 + tq_, 2 * cc + (tp_ >> 1)) + 8 * (tp_ & 1));
                        const s16x4 t1 = trread(B + TV + offb(8 * g4 + 4 + tq_, 2 * cc + (tp_ >> 1)) + 8 * (tp_ & 1));
                        const s16x8 vf = cat8(t0, t1);
#pragma unroll
                        for (int m = 0; m < 2; ++m) {
                            const s16x8 pb = *(const LAS s16x8*)(B + TP + (16 * m + l15) * 80 + 16 * g4);
                            OT[n][m] = MFMA16(vf, pb, OT[n][m]);
                        }
                    }
#pragma unroll
                    for (int n = 0; n < 2; ++n)
#pragma unroll
                        for (int m = 0; m < 2; ++m) {
                            const int i_ = 16 * m + l15;
                            u32x2 o; o.x = pk_bf16(OT[n][m][0], OT[n][m][1]); o.y = pk_bf16(OT[n][m][2], OT[n][m][3]);
                            *(u32x2*)(O + (size_t)(rowbase + (dir ? C - 1 - i_ : i_)) * HD + ooff + 32 * w + 16 * n + 4 * g4) = o;
                        }
                }
                __syncthreads();
                if ((PROBE_SCAN & 4) && !RET) { __syncthreads(); __syncthreads(); }
                {
                    s16x8 vb[2];
#pragma unroll
                    for (int n = 0; n < 2; ++n) {
                        const int cc = 2 * w + n;
                        const s16x4 t0 = trread(B + (RET ? TV2 : TV) + offb(8 * g4 + tq_, 2 * cc + (tp_ >> 1)) + 8 * (tp_ & 1));
                        const s16x4 t1 = trread(B + (RET ? TV2 : TV) + offb(8 * g4 + 4 + tq_, 2 * cc + (tp_ >> 1)) + 8 * (tp_ & 1));
                        vb[n] = cat8(t0, t1);
                    }
#pragma unroll
                    for (int s = 0; s < NS; ++s)
#pragma unroll
                        for (int u2 = 0; u2 < 2; ++u2) {
                            const s16x4 a0 = trread(B + TK + (s >> 2) * (C * 256) + offb(8 * g4 + tq_, 4 * (s & 3) + tp_) + 8 * u2);
                            const s16x4 a1 = trread(B + TK + (s >> 2) * (C * 256) + offb(8 * g4 + 4 + tq_, 4 * (s & 3) + tp_) + 8 * u2);
                            const s16x8 ka = cat8(a0, a1);
#pragma unroll
                            for (int n = 0; n < 2; ++n) S[n][2 * s + u2] = MFMA16(ka, vb[n], S[n][2 * s + u2]);
                            if ((PROBE_SCAN & 8) && !RET) { const s16x4 b0 = trread(B + TK + (s >> 2) * (C * 256) + offb(8 * g4 + tq_, 4 * (s & 3) + tp_) + 8 * u2); const s16x4 b1 = trread(B + TK + (s >> 2) * (C * 256) + offb(8 * g4 + 4 + tq_, 4 * (s & 3) + tp_) + 8 * u2);
                                f32x4 dmy = (f32x4){0.f, 0.f, 0.f, 0.f}; dmy = MFMA16(cat8(b0, b1), vb[0], dmy); dmy = MFMA16(cat8(b0, b1), vb[1], dmy); asm volatile("" :: "v"(dmy)); }
                            if (!RET) { const f32x4 ev = *(const LAS f32x4*)(B + TE + (32 * s + 8 * g4 + 4 * u2) * 4);
#pragma unroll
                                for (int n = 0; n < 2; ++n) S[n][2 * s + u2] *= ev; }
                        }
                    if (RET && mm == RN - 1) {
                        const float er = exp2f((float)(C * RN) * lg);
#pragma unroll
                        for (int n = 0; n < 2; ++n)
#pragma unroll
                            for (int i = 0; i < 2 * NS; ++i) S[n][i] *= er;
                    }
                }
                __syncthreads();
            }
        } else {
            constexpr int NQ = RET ? 4 : 2;
            u32x4 rq[2][NQ], rk[2][NQ], rgv[2][2], rv[2][2];
            const int c4 = lane & 3, rg = lane >> 2;
#define V3_LOAD(set_, st_) do { const int rb_ = V3_ROWBASE(st_); \
                if (RET) { _Pragma("unroll") for (int j = 0; j < 4; ++j) { const int id = ptid + 256 * j, i_ = id >> 5, ch = id & 31; const bf16_t* gp = P + (size_t)(rb_ + (dir ? C - 1 - i_ : i_)) * PITCH + 8 * ch; \
                        rq[set_][j] = *(const u32x4*)(gp + qoff); rk[set_][j] = *(const u32x4*)(gp + koff); } \
                    _Pragma("unroll") for (int j = 0; j < 2; ++j) { const int id = ptid + 256 * j, i_ = id >> 4, ch = id & 15; rv[set_][j] = *(const u32x4*)(P + (size_t)(rb_ + (dir ? C - 1 - i_ : i_)) * PITCH + voff + 8 * ch); } } \
                else { _Pragma("unroll") for (int j = 0; j < 2; ++j) { const int i_ = 2 * rg + j; const bf16_t* gp = P + (size_t)(rb_ + (dir ? C - 1 - i_ : i_)) * PITCH + 8 * (4 * pw + c4); \
                        rq[set_][j] = *(const u32x4*)(gp + qoff); rk[set_][j] = *(const u32x4*)(gp + koff); rgv[set_][j] = *(const u32x4*)(gp + goff); rv[set_][j] = *(const u32x4*)(gp + voff); } } } while (0)
#define V3_STAGE(set_, st_) do { LAS unsigned char* Bn = lds + ((st_) & 1) * BUF; \
                if (RET) { const int mmn = (st_) & (RN - 1); \
                    _Pragma("unroll") for (int j = 0; j < 4; ++j) { const int id = ptid + 256 * j, i_ = id >> 5, ch = id & 31; \
                        *(LAS u32x4*)(Bn + TQ + (ch >> 4) * (C * 256) + offb(i_, ch & 15)) = rq[set_][j]; *(LAS u32x4*)(Bn + TK + (ch >> 4) * (C * 256) + offb(i_, ch & 15)) = rk[set_][j]; } \
                    _Pragma("unroll") for (int j = 0; j < 2; ++j) { const int id = ptid + 256 * j, i_ = id >> 4, ch = id & 15; \
                        *(LAS u32x4*)(Bn + TV + offb(i_, ch)) = rv[set_][j]; *(LAS u32x4*)(Bn + TV2 + offb(i_, ch)) = scale8(rv[set_][j], exp2f(-(float)(C * mmn + i_ + 1) * lg)); } } \
                else { float g0[8], g1[8], q0[8], q1[8], k0[8], k1[8], ee[8]; unpack8(rgv[set_][0], g0); unpack8(rgv[set_][1], g1); \
                    unpack8(rq[set_][0], q0); unpack8(rq[set_][1], q1); unpack8(rk[set_][0], k0); unpack8(rk[set_][1], k1); \
                    _Pragma("unroll") for (int c = 0; c < 8; ++c) { float t = g0[c] + g1[c]; float x = __shfl_up(t, 4); t += (lane >= 4) ? x : 0.f; x = __shfl_up(t, 8); t += (lane >= 8) ? x : 0.f; \
                        x = __shfl_up(t, 16); t += (lane >= 16) ? x : 0.f; x = __shfl_up(t, 32); t += (lane >= 32) ? x : 0.f; \
                        const float b0 = t - g1[c], b1 = t; const float e0 = __expf(b0), e1 = __expf(b1); \
                        q0[c] *= e0; q1[c] *= e1; k0[c] *= __builtin_amdgcn_rcpf(e0); k1[c] *= __builtin_amdgcn_rcpf(e1); ee[c] = e1; } \
                    const int cch = 4 * pw + c4; \
                    *(LAS u32x4*)(Bn + TQ + offb(2 * rg, cch)) = pack8(q0); *(LAS u32x4*)(Bn + TQ + offb(2 * rg + 1, cch)) = pack8(q1); \
                    *(LAS u32x4*)(Bn + TK + offb(2 * rg, cch)) = pack8(k0); *(LAS u32x4*)(Bn + TK + offb(2 * rg + 1, cch)) = pack8(k1); \
                    *(LAS u32x4*)(Bn + TV + offb(2 * rg, cch)) = rv[set_][0]; *(LAS u32x4*)(Bn + TV + offb(2 * rg + 1, cch)) = rv[set_][1]; \
                    if (rg == 15) { *(LAS f32x4*)(Bn + TE + (8 * cch) * 4) = (f32x4){ee[0], ee[1], ee[2], ee[3]}; *(LAS f32x4*)(Bn + TE + (8 * cch + 4) * 4) = (f32x4){ee[4], ee[5], ee[6], ee[7]}; } } } while (0)
            const int mi = pw >> 1, nj = pw & 1;
            float pf[4];
#pragma unroll
            for (int r = 0; r < 4; ++r) pf[r] = RET ? exp2f((float)(16 * (mi - nj) + l15 - 4 * g4 - r) * lg) : 1.0f;
#define V3_PTILE(st_) do { LAS unsigned char* Bn = lds + ((st_) & 1) * BUF; f32x4 pa = (f32x4){0.f, 0.f, 0.f, 0.f}; \
                if (nj <= mi) { _Pragma("unroll") for (int s = 0; s < NS; ++s) { \
                        const s16x8 ka = *(const LAS s16x8*)(Bn + TK + (s >> 2) * (C * 256) + offb(l15 + 16 * nj, 4 * (s & 3) + g4)); \
                        const s16x8 qb = *(const LAS s16x8*)(Bn + TQ + (s >> 2) * (C * 256) + offb(l15 + 16 * mi, 4 * (s & 3) + g4)); \
                        pa = MFMA16(ka, qb, pa); } \
                    _Pragma("unroll") for (int r = 0; r < 4; ++r) pa[r] = (16 * nj + 4 * g4 + r > 16 * mi + l15) ? 0.f : pa[r] * pf[r]; } \
                u32x2 pk; pk.x = pk_bf16(pa[0], pa[1]); pk.y = pk_bf16(pa[2], pa[3]); \
                *(LAS u32x2*)(Bn + TP + (16 * mi + l15) * 80 + 2 * (16 * nj + 4 * g4)) = pk; } while (0)
            V3_LOAD(0, 0); V3_LOAD(1, 1);
            V3_STAGE(0, 0);
            V3_LOAD(0, 2);
            __syncthreads();
            if (ctx_out || 0 >= NCTX) V3_PTILE(0);
            __syncthreads();
            for (int st = 0; st < NSTEP; st += 2) {
                if (st + 1 < NSTEP) V3_STAGE(1, st + 1);
                if ((PROBE_SCAN & 1) && !RET && st + 1 < NSTEP) V3_STAGE(1, st + 1);
                { const int sl_ = st + 3 < NSTEP ? st + 3 : NSTEP - 1; V3_LOAD(1, sl_); }
                __syncthreads();
                if ((PROBE_SCAN & 4) && !RET) { __syncthreads(); __syncthreads(); }
                if (st + 1 < NSTEP && (ctx_out || st + 1 >= NCTX)) V3_PTILE(st + 1);
                __syncthreads();
                if (st + 2 < NSTEP) V3_STAGE(0, st + 2);
                if ((PROBE_SCAN & 1) && !RET && st + 2 < NSTEP) V3_STAGE(0, st + 2);
                { const int sl_ = st + 4 < NSTEP ? st + 4 : NSTEP - 1; V3_LOAD(0, sl_); }
                __syncthreads();
                if ((PROBE_SCAN & 4) && !RET) { __syncthreads(); __syncthreads(); }
                if (st + 2 < NSTEP && (ctx_out || st + 2 >= NCTX)) V3_PTILE(st + 2);
                __syncthreads();
            }
#undef V3_LOAD
#undef V3_STAGE
#undef V3_PTILE
        }
        __syncthreads();
#undef V3_ROWBASE
    }
}

constexpr int NPHASES = 20;
#ifndef GEMM_STAGGER_TICKS
#define GEMM_STAGGER_TICKS 0
#endif
#ifndef SCAN_IMPL
#define SCAN_IMPL scan_v3_phase
#endif
template <class Epi, bool F8 = false>
DI void run_gemm(LAS unsigned char* lds, const bf16_t* Aop, const bf16_t* Bt, int M, int N, int K, int pmg, size_t bgs, const Epi& E, int G = -1, int c = -1, int rb = 0, int re = 1 << 30) {
    pg8::Gemm g{Aop, Bt, M, N, K, pmg, bgs};
    if (G < 0) { G = (int)gridDim.x; c = (int)blockIdx.x; }
    pg8::StaticOrder S; S.init(M, N, G, c, (pmg < 64) ? pmg : 8); S.ib = rb; S.ie = re;
    if (GEMM_STAGGER_TICKS > 0 && (M / 256) * (N / 256) >= 4 * (int)gridDim.x) {
        const unsigned long long t0 = __builtin_amdgcn_s_memrealtime(), dl = (unsigned long long)((blockIdx.x & 7u) * GEMM_STAGGER_TICKS);
        while (__builtin_amdgcn_s_memrealtime() - t0 < dl) __builtin_amdgcn_s_sleep(8);
    }
    pg8::gemm_phase<Epi, pg8::StaticOrder, false, F8>((PG8_LAS unsigned char*)lds, g, S, E, nullptr);
}

template <class Epi, bool F8 = false>
DI void run_gemm_cvt(const Args& A, LAS unsigned char* lds, const bf16_t* Aop, const bf16_t* Bt, int M, int N, int K, int pmg, size_t bgs, const Epi& E, int base, int count) {
    const int G = (int)gridDim.x, c = (int)blockIdx.x, nwg = (M / 256) * (N / 256), R = (nwg + G - 1) / G;
    const int sp = ((c & 7) % R) + 1;
    run_gemm<Epi, F8>(lds, Aop, Bt, M, N, K, pmg, bgs, E, -1, -1, 0, sp);
    __syncthreads();
    convert_range_fast(A, lds, base, count, c, G);
    __syncthreads();
    run_gemm<Epi, F8>(lds, Aop, Bt, M, N, K, pmg, bgs, E, -1, -1, sp, 1 << 30);
}

__global__ void __launch_bounds__(NTHREADS, 2) mk_fwd(Args A) {
    extern __shared__ __attribute__((aligned(16))) unsigned char lds_raw[];
    LAS unsigned char* lds = (LAS unsigned char*)lds_raw;
    unsigned char* ws = A.ws;
    const int lo = A.ph_lo, hi = A.ph_hi;
    XcdBarrier bar; bar.bar = (unsigned*)(ws + WS_BAR); bar.x = 0; bar.st = nullptr;
    if (hi - lo > 1) {
        volatile LAS unsigned* st = (volatile LAS unsigned*)(lds + MISC_OFF);
        if (threadIdx.x == 0) { st[0] = 0u; st[1] = 0u; st[2] = 0u; st[3] = 0u; }
        __syncthreads();
        bar = xcd_barrier_post((unsigned*)(ws + WS_BAR), st);
    }
#ifndef REP_MASK
#define REP_MASK 0
#endif
#ifdef ONLY_PHASE
#define IN(k) ((k) == ONLY_PHASE && lo <= (k) && (k) < hi)
#else
#define IN(k) (lo <= (k) && (k) < hi)
#endif
#define SEAM(k) do { if (IN(k) && IN((k) + 1)) xcd_barrier(bar); } while (0)
    const float* MOD0 = (const float*)(ws + WS_MOD); const float* MOD1 = MOD0 + 9 * 6144;
    bf16_t* X = (bf16_t*)(ws + WS_X); bf16_t* H = (bf16_t*)(ws + WS_H); bf16_t* PROJ = (bf16_t*)(ws + WS_R1); bf16_t* A2 = (bf16_t*)(ws + WS_A2);
    const bf16_t* XE = (const bf16_t*)(ws + WS_R2); bf16_t* Y = (bf16_t*)(ws + WS_R2 + R2_HALF); unsigned char* ACT = ws + WS_R1;

    if (IN(0)) { p0_prologue(A, lds); if (REP_MASK >> 0 & 1) { __syncthreads(); p0_prologue(A, lds); } }
    SEAM(0);
    if (IN(1)) { row_phase<0, 3>(A, lds, NTOK, A.in[I_X], A.in[I_CTX], A.in[I_NMIX], MOD0, 0, 1024, nullptr, 0, nullptr); if (REP_MASK >> 1 & 1) { __syncthreads(); row_phase<0, 3>(A, lds, NTOK, A.in[I_X], A.in[I_CTX], A.in[I_NMIX], MOD0, 0, 1024, nullptr, 0, nullptr); } }
    SEAM(1);
    if (IN(2)) { { EpiRetIn E{PROJ, (const f32x2*)(ws + WS_ROPE), (const f32x2*)(ws + WS_ROPE) + 2048}; run_gemm_cvt(A, lds, H, (const bf16_t*)(ws + WS_WRI), NTOK, RET_IN, 1024, 1 << 20, 0, E, I2_B, I2_N); } if (REP_MASK >> 2 & 1) { __syncthreads(); { EpiRetIn E{PROJ, (const f32x2*)(ws + WS_ROPE), (const f32x2*)(ws + WS_ROPE) + 2048}; run_gemm(lds, H, (const bf16_t*)(ws + WS_WRI), NTOK, RET_IN, 1024, 1 << 20, 0, E); } } }
    if (IN(2)) { tail_convert(A, lds, (NTOK / 256) * (RET_IN / 256), T2_B, T2_N); tail_convert(A, lds, (NTOK / 256) * (RET_IN / 256), T2X_B, T2X_N); }
    SEAM(2);
    if (IN(3)) { SCAN_IMPL<true>(A, lds, true); if (REP_MASK >> 3 & 1) { __syncthreads(); SCAN_IMPL<true>(A, lds, true); } }
    SEAM(3);
    if (IN(4)) { readout_phase<true>(A, NTOK); if (REP_MASK >> 4 & 1) { __syncthreads(); readout_phase<true>(A, NTOK); } }
    SEAM(4);
    if (IN(5)) { { EpiResidT<false> E{A.in[I_X], A.in[I_CTX], X, MOD0, 2048}; run_gemm<EpiResidT<false>, true>(lds, A2, (const bf16_t*)(ws + WS_WRO), NTOK, 1024, 1024, 1 << 20, 0, E); } if (REP_MASK >> 5 & 1) { __syncthreads(); { EpiResidT<false> E{A.in[I_X], A.in[I_CTX], X, MOD0, 2048}; run_gemm<EpiResidT<false>, true>(lds, A2, (const bf16_t*)(ws + WS_WRO), NTOK, 1024, 1024, 1 << 20, 0, E); } } }
    if (IN(5)) tail_convert(A, lds, (NTOK / 256) * 4, T5_B, T5_N);
    SEAM(5);
    if (IN(6)) { row_phase<2, 3>(A, lds, NTOK, nullptr, nullptr, A.in[I_NFFN], MOD0, 3 * 1024, 4 * 1024, nullptr, 0, A.in[I_ROUTER]); if (REP_MASK >> 6 & 1) { __syncthreads(); row_phase<2, 3>(A, lds, NTOK, nullptr, nullptr, A.in[I_NFFN], MOD0, 3 * 1024, 4 * 1024, nullptr, 0, A.in[I_ROUTER]); } }
    SEAM(6);
    if (IN(7)) { topk_phase(A, lds, 256, MPER0); if (REP_MASK >> 7 & 1) { __syncthreads(); topk_phase(A, lds, 256, MPER0); } }
    if (IN(7) && (int)gridDim.x > 128) { __syncthreads(); if ((int)blockIdx.x >= 128) convert_range_fast(A, lds, T7_B, T7_N, (int)blockIdx.x - 128, (int)gridDim.x - 128); }
    else if (IN(7)) { __syncthreads(); convert_range_fast(A, lds, T7_B, T7_N, (int)blockIdx.x, (int)gridDim.x); }
    SEAM(7);
    if (IN(8)) { { EpiMoe1 E{ACT}; run_gemm_cvt<EpiMoe1, true>(A, lds, XE, (const bf16_t*)(ws + WS_WM1), NE * MPER0, N1, 512, MPER0 / 256, (size_t)N1 * 1024, E, I8_B, I8_N); } if (REP_MASK >> 8 & 1) { __syncthreads(); { EpiMoe1 E{ACT}; run_gemm<EpiMoe1, true>(lds, XE, (const bf16_t*)(ws + WS_WM1), NE * MPER0, N1, 512, MPER0 / 256, (size_t)N1 * 1024, E); } } }
    if (IN(8)) tail_convert(A, lds, (NE * MPER0 / 256) * (N1 / 256), T8_B, T8_N);
    SEAM(8);
    if (IN(9)) { { EpiPlainF8 E{(unsigned char*)Y, 1024, Y_SCALE}; run_gemm<EpiPlainF8, true>(lds, (const bf16_t*)ACT, (const bf16_t*)(ws + WS_WM2), NE * MPER0, 1024, FF / 2, MPER0 / 256, (size_t)1024 * FF, E); } if (REP_MASK >> 9 & 1) { __syncthreads(); { EpiPlainF8 E{(unsigned char*)Y, 1024, Y_SCALE}; run_gemm<EpiPlainF8, true>(lds, (const bf16_t*)ACT, (const bf16_t*)(ws + WS_WM2), NE * MPER0, 1024, FF / 2, MPER0 / 256, (size_t)1024 * FF, E); } } }
    if (IN(9)) tail_convert(A, lds, (NE * MPER0 / 256) * 4, T9_B, T9_N);
    SEAM(9);
    if (IN(10)) { row_phase<1, 3>(A, lds, NTOK, nullptr, nullptr, A.in[I_NMIX] + 1024, MOD1, 0, 1024, MOD0, MPER0, nullptr); if (REP_MASK >> 10 & 1) { __syncthreads(); row_phase<1, 3>(A, lds, NTOK, nullptr, nullptr, A.in[I_NMIX] + 1024, MOD1, 0, 1024, MOD0, MPER0, nullptr); } }
    SEAM(10);
    if (IN(11)) { { EpiHgIn E{PROJ, (const float*)(ws + WS_LB), 0}; run_gemm(lds, H, (const bf16_t*)(ws + WS_WHI), NTOK, HG_IN - 1024, 1024, 1 << 20, 0, E); } if (REP_MASK >> 11 & 1) { __syncthreads(); { EpiHgIn E{PROJ, (const float*)(ws + WS_LB), 0}; run_gemm(lds, H, (const bf16_t*)(ws + WS_WHI), NTOK, HG_IN - 1024, 1024, 1 << 20, 0, E); } } }
    if (IN(11)) tail_convert(A, lds, (NTOK / 256) * ((HG_IN - 1024) / 256), T11_B, T11_N);
    SEAM(11);
    if (IN(12)) {
        const int G = (int)gridDim.x;
        EpiHgIn Eg{PROJ, (const float*)(ws + WS_LB), 16};
        if (G > 128) { if ((int)blockIdx.x >= 128) {
                           const int cb = (int)blockIdx.x - 128; const bool cvt_first = (cb & 4) != 0;
                           convert_range_fast(A, lds, T12B_B, cvt_first ? T12B_N : 0, cb, G - 128);
                           __syncthreads();
                           run_gemm(lds, H, (const bf16_t*)(ws + WS_WHI) + (size_t)4096 * 1024, NLAT, 1024, 1024, 1 << 20, 0, Eg, G - 128, cb);
                           __syncthreads();
                           convert_range_fast(A, lds, T12A_B, T12A_N, cb, G - 128); convert_range_fast(A, lds, T12B_B, cvt_first ? 0 : T12B_N, cb, G - 128); }
                       else { SCAN_IMPL<false>(A, lds, false); if (REP_MASK >> 12 & 1) SCAN_IMPL<false>(A, lds, false); } }
        else { SCAN_IMPL<false>(A, lds, false); __syncthreads(); run_gemm(lds, H, (const bf16_t*)(ws + WS_WHI) + (size_t)4096 * 1024, NLAT, 1024, 1024, 1 << 20, 0, Eg);
               __syncthreads(); convert_range_fast(A, lds, T12A_B, T12A_N, (int)blockIdx.x, G); convert_range_fast(A, lds, T12B_B, T12B_N, (int)blockIdx.x, G); }
    }
    SEAM(12);
    if (IN(13)) { readout_phase<false>(A, NLAT); if (REP_MASK >> 13 & 1) { __syncthreads(); readout_phase<false>(A, NLAT); } }
    SEAM(13);
    if (IN(14)) { { EpiResidT<true> E{nullptr, nullptr, X, MOD1, 2048}; run_gemm(lds, A2, (const bf16_t*)(ws + WS_WHO), NLAT, 1024, 1024, 1 << 20, 0, E); } if (REP_MASK >> 14 & 1) { __syncthreads(); { EpiResidT<true> E{nullptr, nullptr, X, MOD1, 2048}; run_gemm(lds, A2, (const bf16_t*)(ws + WS_WHO), NLAT, 1024, 1024, 1 << 20, 0, E); } } }
    SEAM(14);
    if (IN(15)) { row_phase<2, 4>(A, lds, NLAT, nullptr, nullptr, A.in[I_NFFN] + 1024, MOD1, 3 * 1024, 4 * 1024, nullptr, 0, A.in[I_ROUTER] + 1024 * 16); if (REP_MASK >> 15 & 1) { __syncthreads(); row_phase<2, 4>(A, lds, NLAT, nullptr, nullptr, A.in[I_NFFN] + 1024, MOD1, 3 * 1024, 4 * 1024, nullptr, 0, A.in[I_ROUTER] + 1024 * 16); } }
    SEAM(15);
    if (IN(16)) { topk_phase(A, lds, 128, MPER1); if (REP_MASK >> 16 & 1) { __syncthreads(); topk_phase(A, lds, 128, MPER1); } }
    if (IN(16) && (int)gridDim.x > 128) { __syncthreads(); if ((int)blockIdx.x >= 128) convert_range_fast(A, lds, T16_B, T16_N, (int)blockIdx.x - 128, (int)gridDim.x - 128); }
    else if (IN(16)) { __syncthreads(); convert_range_fast(A, lds, T16_B, T16_N, (int)blockIdx.x, (int)gridDim.x); }
    SEAM(16);
    if (IN(17)) { { EpiMoe1 E{ACT}; run_gemm<EpiMoe1, true>(lds, XE, (const bf16_t*)(ws + WS_WM1 + (size_t)16 * N1 * 1024), NE * MPER1, N1, 512, MPER1 / 256, (size_t)N1 * 1024, E); } if (REP_MASK >> 17 & 1) { __syncthreads(); { EpiMoe1 E{ACT}; run_gemm<EpiMoe1, true>(lds, XE, (const bf16_t*)(ws + WS_WM1 + (size_t)16 * N1 * 1024), NE * MPER1, N1, 512, MPER1 / 256, (size_t)N1 * 1024, E); } } }
    SEAM(17);
    if (IN(18)) { { EpiPlainF8 E{(unsigned char*)Y, 1024, Y_SCALE}; run_gemm<EpiPlainF8, true>(lds, (const bf16_t*)ACT, (const bf16_t*)(ws + WS_WM2 + (size_t)16 * 1024 * FF), NE * MPER1, 1024, FF / 2, MPER1 / 256, (size_t)1024 * FF, E); } if (REP_MASK >> 18 & 1) { __syncthreads(); { EpiPlainF8 E{(unsigned char*)Y, 1024, Y_SCALE}; run_gemm<EpiPlainF8, true>(lds, (const bf16_t*)ACT, (const bf16_t*)(ws + WS_WM2 + (size_t)16 * 1024 * FF), NE * MPER1, 1024, FF / 2, MPER1 / 256, (size_t)1024 * FF, E); } } }
    SEAM(18);
    if (IN(19)) { row_phase<5>(A, lds, NLAT, nullptr, nullptr, A.in[I_NFIN], nullptr, 0, 0, MOD1, MPER1, nullptr); if (REP_MASK >> 19 & 1) { __syncthreads(); row_phase<5>(A, lds, NLAT, nullptr, nullptr, A.in[I_NFIN], nullptr, 0, 0, MOD1, MPER1, nullptr); } }
#undef IN
#undef SEAM
}

extern "C" void kernel_launch(void* const* d_in, const int* in_sizes, int n_in, void* d_out, int out_size, void* d_ws, size_t ws_size, hipStream_t stream) {
    static int grid = 0;
    if (grid == 0) {
        if (n_in != 19 || out_size != NLAT * D || ws_size < WS_END) { fprintf(stderr, "kernel_launch: unexpected shapes (n_in %d, out %d, ws %zu < %zu)\n", n_in, out_size, ws_size, (size_t)WS_END); grid = -1; return; }
        int dev = 0, cus = 0, per_cu = 0;
        if (hipGetDevice(&dev) != hipSuccess || hipDeviceGetAttribute(&cus, hipDeviceAttributeMultiprocessorCount, dev) != hipSuccess) { grid = -1; return; }
        if (hipFuncSetAttribute((const void*)mk_fwd, hipFuncAttributeMaxDynamicSharedMemorySize, LDS_BYTES) != hipSuccess) { fprintf(stderr, "kernel_launch: hipFuncSetAttribute failed\n"); grid = -1; return; }
        if (hipOccupancyMaxActiveBlocksPerMultiprocessor(&per_cu, (const void*)mk_fwd, NTHREADS, LDS_BYTES) != hipSuccess || per_cu < 1) { fprintf(stderr, "kernel_launch: occupancy query says %d\n", per_cu); }
        (void)hipGetLastError();
        grid = cus;
    }
    if (grid < 0) return;
    (void)hipMemsetAsync((char*)d_ws + WS_BAR, 0, 16384, stream);
    Args a{};
    for (int i = 0; i < 19; ++i) a.in[i] = (const float*)d_in[i];
    a.out = (float*)d_out; a.ws = (unsigned char*)d_ws;
#if MK_PER_PHASE
    for (int p = 0; p < NPHASES; ++p) { a.ph_lo = p; a.ph_hi = p + 1; hipLaunchKernelGGL(mk_fwd, dim3(grid), dim3(NTHREADS), LDS_BYTES, stream, a); }
#else
    a.ph_lo = 0; a.ph_hi = NPHASES;
    hipLaunchKernelGGL(mk_fwd, dim3(grid), dim3(NTHREADS), LDS_BYTES, stream, a);
#endif
}
```
